# Optimizing an MI355X kernel written in HIP

```python
import jax, jax.numpy as jnp
from jax import lax
import numpy as np

D_MODEL = 1024
BATCH = 16
SEQ = 2048
DEPTH = 4

CTX_LEN = 256
GRID_W = 64
NA_HEADS = 8
NA_HEAD_DIM = 64
NA_WIN_R = 8
NA_WIN_C = 16
NA_WIDTH = NA_HEADS * NA_HEAD_DIM
RPB_R = 2 * NA_WIN_R - 1
RPB_C = 2 * NA_WIN_C - 1
MLA_HEADS = 8
MLA_Q_RANK = 256
MLA_KV_RANK = 128
MLA_NOPE_DIM = 64
MLA_ROPE_DIM = 32
MLA_V_DIM = 64
MLA_WIDTH = MLA_HEADS * MLA_V_DIM
ATTN_BLOCK = 128
ROPE_BASE = 10000.0
CONV_DIM = 512
CONV_WIDTH = 31
N_BRANCHES = 3
N_EXPERTS = 16
EXPERT_DIM = 1024
EC_CAPACITY_FACTOR = 2
LN_EPS = 1e-5
RMS_EPS = 1e-6
DEEPNORM_ALPHA = (2 * DEPTH) ** 0.25
DEEPNORM_BETA = (8 * DEPTH) ** -0.25
PROJ_SIZES = (NA_WIDTH, NA_WIDTH, NA_WIDTH, MLA_Q_RANK, MLA_KV_RANK, MLA_ROPE_DIM, 2 * CONV_DIM, N_BRANCHES * D_MODEL)
IN_COLS = sum(PROJ_SIZES)

kernel_name = "hybrid_na_mla_conformer_ecmoe_dit"


def _layer_norm(x, g, b):
    xf = x.astype(jnp.float32)
    mu = jnp.mean(xf, axis=-1, keepdims=True)
    var = jnp.mean(jnp.square(xf - mu), axis=-1, keepdims=True)
    return ((xf - mu) * lax.rsqrt(var + LN_EPS) * g + b).astype(x.dtype)


def _rms_norm(x, g):
    xf = x.astype(jnp.float32)
    return (xf * lax.rsqrt(jnp.mean(jnp.square(xf), axis=-1, keepdims=True) + RMS_EPS) * g).astype(x.dtype)


def _modulate(x, shift, scale):
    return x * (1 + scale) + shift


def _axial_angles(n_tokens):
    t = jnp.arange(n_tokens)
    row = (t // GRID_W).astype(jnp.float32)
    col = (t % GRID_W).astype(jnp.float32)
    n_freq = MLA_ROPE_DIM // 4
    inv_freq = ROPE_BASE ** (-jnp.arange(n_freq, dtype=jnp.float32) / n_freq)
    return row[:, None] * inv_freq, col[:, None] * inv_freq


def _rotate(x, ang):
    x1, x2 = jnp.split(x, 2, axis=-1)
    cos = jnp.cos(ang).astype(x.dtype)
    sin = jnp.sin(ang).astype(x.dtype)
    return jnp.concatenate([x1 * cos - x2 * sin, x2 * cos + x1 * sin], axis=-1)


def _rope_2d(x, ang_row, ang_col):
    xr, xc = jnp.split(x, 2, axis=-1)
    return jnp.concatenate([_rotate(xr, ang_row), _rotate(xc, ang_col)], axis=-1)


def _split_proj(p):
    offsets = np.cumsum(PROJ_SIZES)[:-1].tolist()
    return jnp.split(p, offsets, axis=-1)


def _heads(t, n_heads):
    return t.reshape(t.shape[0], t.shape[1], n_heads, t.shape[2] // n_heads)


def _dense_attention(q, k, v, scale):
    s = jnp.einsum('bqhd,bkhd->bhqk', q, k).astype(jnp.float32) * scale
    p = jax.nn.softmax(s, axis=-1).astype(v.dtype)
    o = jnp.einsum('bhqk,bkhd->bqhd', p, v)
    return o.reshape(o.shape[0], o.shape[1], -1)


def _blocked_attention(q, k, v, scale):
    B, S, H, Dq = q.shape
    nb = S // ATTN_BLOCK
    qb = q.reshape(B, nb, ATTN_BLOCK, H, Dq).transpose(1, 0, 2, 3, 4)

    def block(q_blk):
        s = jnp.einsum('bqhd,bkhd->bhqk', q_blk, k).astype(jnp.float32) * scale
        p = jax.nn.softmax(s, axis=-1).astype(v.dtype)
        return jnp.einsum('bhqk,bkhd->bqhd', p, v)

    o = lax.map(block, qb)
    return o.transpose(1, 0, 2, 3, 4).reshape(B, S, -1)


def _neighbourhood_attention(q, k, v, k_ctx, v_ctx, rpb):
    B, S, H, Dh = q.shape
    rows = S // GRID_W
    win_r = min(NA_WIN_R, rows)
    scale = Dh ** -0.5
    qg = q.reshape(B, rows, GRID_W, H, Dh)
    kg = k.reshape(B, rows, GRID_W, H, Dh)
    vg = v.reshape(B, rows, GRID_W, H, Dh)
    col = jnp.arange(GRID_W)
    c_start = jnp.clip(col - NA_WIN_C // 2, 0, GRID_W - NA_WIN_C)
    col_mask = (col[None, :] >= c_start[:, None]) & (col[None, :] < c_start[:, None] + NA_WIN_C)
    dc_idx = jnp.clip(col[None, :] - col[:, None], -(NA_WIN_C - 1), NA_WIN_C - 1) + NA_WIN_C - 1
    n_win = win_r * GRID_W

    def row_block(r):
        r_start = jnp.clip(r - win_r // 2, 0, rows - win_r)
        q_r = lax.dynamic_index_in_dim(qg, r, axis=1, keepdims=False)
        k_band = lax.dynamic_slice_in_dim(kg, r_start, win_r, axis=1)
        v_band = lax.dynamic_slice_in_dim(vg, r_start, win_r, axis=1)
        dr_idx = r_start + jnp.arange(win_r) - r + NA_WIN_R - 1
        bias = rpb[:, dr_idx[None, :, None], dc_idx[:, None, :]]
        s_win = jnp.einsum('bqhd,brkhd->bhqrk', q_r, k_band).astype(jnp.float32) * scale + bias
        s_win = jnp.where(col_mask[:, None, :], s_win, -jnp.inf).reshape(B, H, GRID_W, n_win)
        s_ctx = jnp.einsum('bqhd,bkhd->bhqk', q_r, k_ctx).astype(jnp.float32) * scale
        p = jax.nn.softmax(jnp.concatenate([s_win, s_ctx], axis=-1), axis=-1).astype(v.dtype)
        p_win = p[..., :n_win].reshape(B, H, GRID_W, win_r, GRID_W)
        p_ctx = p[..., n_win:]
        return (jnp.einsum('bhqrk,brkhd->bqhd', p_win, v_band)
                + jnp.einsum('bhqk,bkhd->bqhd', p_ctx, v_ctx))

    o = lax.map(row_block, jnp.arange(rows))
    return o.transpose(1, 0, 2, 3, 4).reshape(B, S, H * Dh)


def _mla_queries(c_q, g_q, w_uq, ang_row, ang_col):
    B, N, _ = c_q.shape
    q = (_rms_norm(c_q, g_q) @ w_uq).reshape(B, N, MLA_HEADS, MLA_NOPE_DIM + MLA_ROPE_DIM)
    if ang_row is None:
        return q
    q_rope = _rope_2d(q[..., MLA_NOPE_DIM:], ang_row[:, None, :], ang_col[:, None, :])
    return jnp.concatenate([q[..., :MLA_NOPE_DIM], q_rope], axis=-1)


def _mla_keys_values(c_kv, k_rope, g_kv, w_ukv, ang_row, ang_col):
    B, N, _ = c_kv.shape
    kv = (_rms_norm(c_kv, g_kv) @ w_ukv).reshape(B, N, MLA_HEADS, MLA_NOPE_DIM + MLA_V_DIM)
    k_nope, v = kv[..., :MLA_NOPE_DIM], kv[..., MLA_NOPE_DIM:]
    k_rope = k_rope[:, :, None, :]
    if ang_row is not None:
        k_rope = _rope_2d(k_rope, ang_row[:, None, :], ang_col[:, None, :])
    k = jnp.concatenate([k_nope, jnp.broadcast_to(k_rope, (B, N, MLA_HEADS, MLA_ROPE_DIM))], axis=-1)
    return k, v


def _conformer_conv(u2, w_dw, b_dw, g_cn, b_cn, w_pw2):
    a, gate = jnp.split(u2, 2, axis=-1)
    u = a * jax.nn.sigmoid(gate)
    u = lax.conv_general_dilated(u, w_dw[:, None, :], window_strides=(1,),
                                 padding=[(CONV_WIDTH // 2, CONV_WIDTH // 2)],
                                 dimension_numbers=('NWC', 'WIO', 'NWC'),
                                 feature_group_count=u.shape[-1]) + b_dw
    u = jax.nn.silu(_layer_norm(u, g_cn, b_cn))
    return u @ w_pw2


def _merge(y_a, y_b, y_c, gate_logits, w_oa, w_ob, w_out):
    g = jax.nn.sigmoid(gate_logits.reshape(gate_logits.shape[:-1] + (N_BRANCHES, D_MODEL)))
    m = g[..., 0, :] * (y_a @ w_oa) + g[..., 1, :] * (y_b @ w_ob) + g[..., 2, :] * y_c
    return m @ w_out


def _mixer(h_lat, h_ctx, lp, ang_row, ang_col, with_ctx_out):
    qa, ka, va, cq, ckv, krope, conv_in, gates = _split_proj(h_lat @ lp['w_in'])
    qa_c, ka_c, va_c, cq_c, ckv_c, krope_c, conv_in_c, gates_c = _split_proj(h_ctx @ lp['w_in'])
    ka_c, va_c = _heads(ka_c, NA_HEADS), _heads(va_c, NA_HEADS)
    k_bc, v_bc = _mla_keys_values(ckv_c, krope_c, lp['g_kv'], lp['w_ukv'], None, None)
    mla_scale = (MLA_NOPE_DIM + MLA_ROPE_DIM) ** -0.5
    y_a = _neighbourhood_attention(_heads(qa, NA_HEADS), _heads(ka, NA_HEADS), _heads(va, NA_HEADS),
                                   ka_c, va_c, lp['rpb'])
    q_b = _mla_queries(cq, lp['g_q'], lp['w_uq'], ang_row, ang_col)
    k_b, v_b = _mla_keys_values(ckv, krope, lp['g_kv'], lp['w_ukv'], ang_row, ang_col)
    y_b = _blocked_attention(q_b, jnp.concatenate([k_bc, k_b], axis=1), jnp.concatenate([v_bc, v_b], axis=1), mla_scale)
    y_c = _conformer_conv(conv_in, lp['w_dw'], lp['b_dw'], lp['g_cn'], lp['b_cn'], lp['w_pw2'])
    y_lat = _merge(y_a, y_b, y_c, gates, lp['w_oa'], lp['w_ob'], lp['w_out'])
    if not with_ctx_out:
        return y_lat, None
    y_a_c = _dense_attention(_heads(qa_c, NA_HEADS), ka_c, va_c, NA_HEAD_DIM ** -0.5)
    q_bc = _mla_queries(cq_c, lp['g_q'], lp['w_uq'], None, None)
    y_b_c = _dense_attention(q_bc, k_bc, v_bc, mla_scale)
    y_c_c = _conformer_conv(conv_in_c, lp['w_dw'], lp['b_dw'], lp['g_cn'], lp['b_cn'], lp['w_pw2'])
    y_ctx = _merge(y_a_c, y_b_c, y_c_c, gates_c, lp['w_oa'], lp['w_ob'], lp['w_out'])
    return y_lat, y_ctx


def _expert_choice_moe(h, w_router, w_gate, w_up, w_down):
    B, N, _ = h.shape
    cap = EC_CAPACITY_FACTOR * N // N_EXPERTS
    aff = jax.nn.softmax((h @ w_router).astype(jnp.float32), axis=-1)
    top_aff, top_idx = lax.top_k(aff.transpose(0, 2, 1), cap)
    b_idx = jnp.arange(B)[:, None, None]
    xg = h[b_idx, top_idx]
    hid = jax.nn.silu(jnp.einsum('becd,edf->becf', xg, w_gate)) * jnp.einsum('becd,edf->becf', xg, w_up)
    y = jnp.einsum('becf,efd->becd', hid, w_down) * top_aff[..., None].astype(h.dtype)
    return jnp.zeros_like(h).at[b_idx, top_idx].add(y)


def setup_inputs(seed: int = 0) -> dict:
    key = jax.random.key(seed)
    ks = iter(jax.random.split(key, 32))

    def nrm(shape, scale):
        return jax.random.normal(next(ks), shape, jnp.float32) * scale

    def gain(shape):
        return 1.0 + nrm(shape, 0.01)

    L, D = DEPTH, D_MODEL
    return {
        "x": nrm((BATCH, SEQ, D), 1.0),
        "c": nrm((BATCH, D), 1.0),
        "ctx": nrm((BATCH, CTX_LEN, D), 1.0),
        "c_ctx": nrm((D,), 1.0),
        "w_ada": nrm((L, D, 6 * D), 0.5 * D ** -0.5),
        "b_ada": nrm((L, 6 * D), 0.01),
        "w_in": nrm((L, D, IN_COLS), D ** -0.5),
        "g_q": gain((L, MLA_Q_RANK)),
        "w_uq": nrm((L, MLA_Q_RANK, MLA_HEADS * (MLA_NOPE_DIM + MLA_ROPE_DIM)), MLA_Q_RANK ** -0.5),
        "g_kv": gain((L, MLA_KV_RANK)),
        "w_ukv": nrm((L, MLA_KV_RANK, MLA_HEADS * (MLA_NOPE_DIM + MLA_V_DIM)), MLA_KV_RANK ** -0.5),
        "rpb": nrm((L, NA_HEADS, RPB_R, RPB_C), 0.1),
        "w_dw": nrm((L, CONV_WIDTH, CONV_DIM), CONV_WIDTH ** -0.5),
        "b_dw": nrm((L, CONV_DIM), 0.01),
        "g_cn": gain((L, CONV_DIM)),
        "b_cn": nrm((L, CONV_DIM), 0.01),
        "w_pw2": nrm((L, CONV_DIM, D), CONV_DIM ** -0.5),
        "w_oa": nrm((L, NA_WIDTH, D), NA_WIDTH ** -0.5),
        "w_ob": nrm((L, MLA_WIDTH, D), MLA_WIDTH ** -0.5),
        "w_out": nrm((L, D, D), DEEPNORM_BETA * D ** -0.5),
        "ln1_g": gain((L, D)),
        "ln1_b": nrm((L, D), 0.01),
        "w_router": nrm((L, D, N_EXPERTS), D ** -0.5),
        "w_gate": nrm((L, N_EXPERTS, D, EXPERT_DIM), D ** -0.5),
        "w_up": nrm((L, N_EXPERTS, D, EXPERT_DIM), D ** -0.5),
        "w_down": nrm((L, N_EXPERTS, EXPERT_DIM, D), DEEPNORM_BETA * EXPERT_DIM ** -0.5),
        "ln2_g": gain((L, D)),
        "ln2_b": nrm((L, D), 0.01),
    }


def reference(x, c, ctx, c_ctx, w_ada, b_ada, w_in, g_q, w_uq, g_kv, w_ukv, rpb, w_dw, b_dw, g_cn, b_cn,
              w_pw2, w_oa, w_ob, w_out, ln1_g, ln1_b, w_router, w_gate, w_up, w_down, ln2_g, ln2_b):
    ang_row, ang_col = _axial_angles(x.shape[1])
    for l in range(DEPTH):
        with_ctx_out = l < DEPTH - 1
        lp = dict(w_in=w_in[l], g_q=g_q[l], w_uq=w_uq[l], g_kv=g_kv[l], w_ukv=w_ukv[l], rpb=rpb[l],
                  w_dw=w_dw[l], b_dw=b_dw[l], g_cn=g_cn[l], b_cn=b_cn[l], w_pw2=w_pw2[l],
                  w_oa=w_oa[l], w_ob=w_ob[l], w_out=w_out[l])
        sh1, sc1, g1, sh2, sc2, g2 = jnp.split((jax.nn.silu(c) @ w_ada[l] + b_ada[l])[:, None, :], 6, axis=-1)
        sh1c, sc1c, g1c, sh2c, sc2c, g2c = jnp.split(jax.nn.silu(c_ctx) @ w_ada[l] + b_ada[l], 6, axis=-1)
        y_lat, y_ctx = _mixer(_modulate(x, sh1, sc1), _modulate(ctx, sh1c, sc1c), lp, ang_row, ang_col, with_ctx_out)
        x = _layer_norm(DEEPNORM_ALPHA * x + g1 * y_lat, ln1_g[l], ln1_b[l])
        x = _layer_norm(DEEPNORM_ALPHA * x + g2 * _expert_choice_moe(_modulate(x, sh2, sc2), w_router[l], w_gate[l], w_up[l], w_down[l]),
                        ln2_g[l], ln2_b[l])
        if with_ctx_out:
            ctx = _layer_norm(DEEPNORM_ALPHA * ctx + g1c * y_ctx, ln1_g[l], ln1_b[l])
            ctx = _layer_norm(DEEPNORM_ALPHA * ctx + g2c * _expert_choice_moe(_modulate(ctx, sh2c, sc2c), w_router[l], w_gate[l], w_up[l], w_down[l]),
                              ln2_g[l], ln2_b[l])
    return x
```

```cpp
#include <hip/hip_runtime.h>
#include <cstdio>
#include <cstdint>
#include <utility>

#ifndef MK_ONE_LAUNCH
#define MK_ONE_LAUNCH 0
#endif

#define GAS __attribute__((address_space(1)))
#define LAS __attribute__((address_space(3)))
typedef unsigned short bf16;
typedef unsigned v4u __attribute__((ext_vector_type(4)));
typedef unsigned v2u __attribute__((ext_vector_type(2)));
typedef float f32x4 __attribute__((ext_vector_type(4)));
typedef float f32x2 __attribute__((ext_vector_type(2)));
typedef short bf16x8 __attribute__((ext_vector_type(8)));

constexpr int NL = 4, DM = 1024, NBATCH = 16, SQ = 2048, CL = 256;
constexpr int ML = NBATCH * SQ, MC = NBATCH * CL, MT = ML + MC;
constexpr int NIN = 6144;
constexpr int NP = 3072;
constexpr int C_QA = 0, C_KA = 512, C_VA = 1024, C_CQ = 1536, C_CKV = 1792, C_KR = 1920, C_CIN = 2048, C_GT = 3072;
constexpr int NE = 16, CAPL = 256, CAPC = 32, ROWS_E = NBATCH * CAPL + NBATCH * CAPC, MG = NE * ROWS_E;
constexpr float LN_EPS = 1e-5f, RMS_EPS = 1e-6f, DN_ALPHA = 1.681792830507429f;
constexpr int NWAVES = 8, NTHREADS = 512;

constexpr size_t MiB = 1u << 20;
constexpr size_t WS_CTL = 0, CTL_ZERO_BYTES = 1 * MiB;
constexpr size_t WS_MODS = 1 * MiB;
constexpr size_t WS_TAB = 3 * MiB;
constexpr size_t WS_AFF = 4 * MiB;
constexpr size_t WS_SEL = 7 * MiB;
constexpr size_t WS_IDX = 10 * MiB;
constexpr size_t WS_KR = 11 * MiB;
constexpr size_t WS_WIN = 14 * MiB;
constexpr size_t WS_WUQ = 26 * MiB;
constexpr size_t WS_WUKV = 26 * MiB + 512 * 1024;
constexpr size_t WS_WOA = 27 * MiB, WS_WOB = 28 * MiB, WS_WPW2 = 29 * MiB;
constexpr size_t WS_WOUT = 30 * MiB;
constexpr size_t WS_WGU = 32 * MiB;
constexpr size_t WS_WD = 96 * MiB;
constexpr size_t WS_X = 128 * MiB;
constexpr size_t WS_HB = 272 * MiB;
constexpr size_t WS_QB = 344 * MiB;
constexpr size_t WS_KVB = 398 * MiB;
constexpr size_t WS_U = 542 * MiB;
constexpr size_t WS_YA = 470 * MiB;
constexpr size_t WS_YB = 506 * MiB;
constexpr size_t WS_CQN = WS_YB, WS_CKVN = WS_YB + 18 * MiB;
constexpr size_t WS_R = 578 * MiB;
constexpr size_t WS_GT = WS_R + 216 * MiB;
constexpr size_t WS_XG = WS_R, WS_HID = WS_R + 144 * MiB, WS_Y = WS_R + 288 * MiB;
constexpr size_t WS_WSET = 996 * MiB;
constexpr size_t WS_END = WS_R + 432 * MiB + 114 * MiB;

constexpr int RING_BYTES = 131072, LDSCTL_OFF = RING_BYTES, MISC_OFF = LDSCTL_OFF + 320, LIDX_OFF = RING_BYTES + 1024, LDS_BYTES = 147456;

#define LDS_WAIT() asm volatile("s_waitcnt lgkmcnt(0)" ::: "memory")
#define VM_WAIT() asm volatile("s_waitcnt vmcnt(0)" ::: "memory")
__device__ __forceinline__ int lane_id() { int r; asm volatile("v_mbcnt_lo_u32_b32 %0, -1, 0\n\tv_mbcnt_hi_u32_b32 %0, -1, %0" : "=v"(r)); return r; }
__device__ __forceinline__ unsigned f2bf(float f) { unsigned u = __builtin_bit_cast(unsigned, f); return (u + 0x7fffu + ((u >> 16) & 1u)) >> 16; }
__device__ __forceinline__ unsigned pk2(float lo, float hi) { unsigned r; asm("v_cvt_pk_bf16_f32 %0, %1, %2" : "=v"(r) : "v"(lo), "v"(hi)); return r; }
__device__ __forceinline__ float bflo(unsigned w) { return __uint_as_float(w << 16); }
__device__ __forceinline__ float bfhi(unsigned w) { return __uint_as_float(w & 0xffff0000u); }
__device__ __forceinline__ float bf2f(bf16 v) { return __uint_as_float(((unsigned)v) << 16); }
template <int O> __device__ __forceinline__ unsigned xshfl_u(unsigned v) {
    if constexpr (O == 32) { const auto t = __builtin_amdgcn_permlane32_swap(v, v, false, false); return (lane_id() & 32) ? t[0] : t[1]; }
    else return (unsigned)__builtin_amdgcn_ds_swizzle((int)v, (O << 10) | 0x1f);
}
template <int O> __device__ __forceinline__ float xshfl(float v) { return __uint_as_float(xshfl_u<O>(__float_as_uint(v))); }
template <int CTRL> __device__ __forceinline__ float dppf(float x) { return __builtin_bit_cast(float, __builtin_amdgcn_mov_dpp(__builtin_bit_cast(int, x), CTRL, 0xf, 0xf, true)); }
__device__ __forceinline__ float wave_sum(float x) {
    x += dppf<0xB1>(x); x += dppf<0x4E>(x); x += dppf<0x141>(x); x += dppf<0x128>(x);
    const auto s = __builtin_amdgcn_permlane16_swap(__float_as_uint(x), __float_as_uint(x), false, false); x = __uint_as_float(s[0]) + __uint_as_float(s[1]);
    const auto t = __builtin_amdgcn_permlane32_swap(__float_as_uint(x), __float_as_uint(x), false, false); return __uint_as_float(t[0]) + __uint_as_float(t[1]);
}
__device__ __forceinline__ float pair32_max(float x) { const auto t = __builtin_amdgcn_permlane32_swap(__float_as_uint(x), __float_as_uint(x), false, false); return fmaxf(__uint_as_float(t[0]), __uint_as_float(t[1])); }
__device__ __forceinline__ float pair32_sum(float x) { const auto t = __builtin_amdgcn_permlane32_swap(__float_as_uint(x), __float_as_uint(x), false, false); return __uint_as_float(t[0]) + __uint_as_float(t[1]); }
__device__ __forceinline__ float sigmoidf_(float x) { return 1.f / (1.f + __expf(-x)); }

namespace pg8 {
constexpr int BM = 256, BK = 64, HALF = 128, HTB = HALF * BK * 2, STAGE_BYTES = 8 * HTB, NXCD = 8, WGM = 8;
__host__ __device__ __forceinline__ int lds_byte(int r, int c) { const int st = (r >> 4) * 2 + (c >> 5), rr = r & 15, cc = c & 31, ob = rr * 64 + cc * 2; return st * 1024 + (ob ^ (((ob >> 9) & 1) << 5)); }
__host__ __device__ __forceinline__ void stage_rc(int b, int& R, int& C) { const int st = b / 1024, sb = b % 1024, swz = sb ^ (((sb >> 9) & 1) << 5); R = (st >> 1) * 16 + swz / 64; C = (st & 1) * 32 + (swz % 64) / 2; }

__host__ __device__ __forceinline__ int perm32(int rho) { const int n = rho >> 4, i = rho & 15; return 8 * (i >> 2) + 4 * n + (i & 3); }
struct Unit { int pm, pn, sg; };

template <int SEG> struct Order {
    int nM, nN, nwg, G, c, md;
    __device__ __forceinline__ void init(int nM_, int nN_, int G_, int c_, int md_ = 0) { nM = nM_; nN = nN_; nwg = nM * nN; G = G_; c = c_; md = md_; }
    __device__ __forceinline__ bool next(int i, Unit& u) const {
        const int it = i / SEG; u.sg = i - it * SEG;
        const long L = (long)it * G + c; if (L >= nwg) return false;
        int wgid = (int)L; { const int q = nwg / NXCD, r = nwg % NXCD, xcd = wgid % NXCD, off = wgid / NXCD; wgid = (xcd < r ? xcd * (q + 1) : r * (q + 1) + (xcd - r) * q) + off; }
        const int nig = WGM * nN, gid = wgid / nig, fm = gid * WGM, gsz = (nM - fm) < WGM ? (nM - fm) : WGM;
        u.pm = fm + ((wgid % nig) % gsz); u.pn = (wgid % nig) / gsz;
        if (md > 0) u.pm = (u.pm / md) * 18 + (u.pm % md);
        return true;
    }
};

template <class Prob, class Epi, class Sched>
__device__ __forceinline__ void gemm_phase(LAS unsigned char* lds, const Prob& P, const Sched& S, const Epi& E, int wid) {
    int lane_ = lane_id(); asm volatile("" : "+v"(lane_));
    const int lane = lane_, tid = wid * 64 + lane, wr = wid >> 2, wc = wid & 3, fr = lane & 15, fq = lane >> 4;
    const int K = P.K, nt = K / BK;
    unsigned voffA[2][2], voffN[2][2], voffB[2]; int stR[2], stC[2];
#pragma unroll
    for (int i = 0; i < 2; ++i) { stage_rc(tid * 16 + i * 8192, stR[i], stC[i]); const int Rb = (stR[i] & ~31) + perm32(stR[i] & 31); voffB[i] = (unsigned)(Rb * P.ldb + stC[i]) * 2u; }
    const size_t kstep = (size_t)(BK * 2);
    const size_t hstepB = (size_t)HALF * P.ldb * 2;
#define PG8_AOFF(dst, u) do { _Pragma("unroll") for (int h_ = 0; h_ < 2; ++h_) _Pragma("unroll") for (int i_ = 0; i_ < 2; ++i_) \
        dst[h_][i_] = (unsigned)(P.arow(u, h_ * HALF + stR[i_]) * P.lda + stC[i_]) * 2u; } while (0)
    const unsigned ldsw = (unsigned)wid * 1024u;
    const int aoff = lds_byte(wr * 64 + fr, fq * 8), boff = lds_byte(wc * 32 + fr, fq * 8);
#define PG8_SA(b, h) (((b) * 2 + (h)) * HTB)
#define PG8_SB(b, h) ((4 + (b) * 2 + (h)) * HTB)
#define PG8_STAGE(bufoff, gbase, voff) do { _Pragma("unroll") for (int _i = 0; _i < 2; ++_i) \
        __builtin_amdgcn_global_load_lds((const unsigned*)((const char*)(gbase) + (voff)[_i]), (LAS unsigned*)(lds + (bufoff) + ldsw + _i * 8192), 16, 0, 0); } while (0)
#define PG8_LDA(dst, b, h) do { _Pragma("unroll") for (int m = 0; m < 4; ++m) _Pragma("unroll") for (int k = 0; k < 2; ++k) dst[m][k] = *(const LAS bf16x8*)(lds + PG8_SA(b, h) + aoff + m * 2048 + k * 1024); } while (0)
#define PG8_LDB(dst, b, h) do { _Pragma("unroll") for (int n = 0; n < 2; ++n) _Pragma("unroll") for (int k = 0; k < 2; ++k) dst[n][k] = *(const LAS bf16x8*)(lds + PG8_SB(b, h) + boff + n * 2048 + k * 1024); } while (0)
#define PG8_MMA(ai, bj, At, Bt) do { __builtin_amdgcn_s_setprio(1); _Pragma("unroll") for (int m = 0; m < 4; ++m) _Pragma("unroll") for (int n = 0; n < 2; ++n) _Pragma("unroll") for (int k = 0; k < 2; ++k) \
        acc[ai][bj][m][n] = __builtin_amdgcn_mfma_f32_16x16x32_bf16(Bt[n][k], At[m][k], acc[ai][bj][m][n], 0, 0, 0); __builtin_amdgcn_s_setprio(0); } while (0)
#define PG8_WAIT_V(n) asm volatile("s_waitcnt vmcnt(" #n ")" ::: "memory")
#define PG8_WAIT_L(n) asm volatile("s_waitcnt lgkmcnt(" #n ")" ::: "memory")
#define PG8_BAR __builtin_amdgcn_s_barrier()
#define PG8_SCHED __builtin_amdgcn_sched_barrier(0)
    Unit cur, nxt; int ui = 0;
    if (!S.next(0, cur)) return;
    f32x4 acc[2][2][4][2];
#pragma unroll
    for (int a = 0; a < 2; ++a)
#pragma unroll
        for (int b = 0; b < 2; ++b)
#pragma unroll
            for (int m = 0; m < 4; ++m)
#pragma unroll
                for (int n = 0; n < 2; ++n) acc[a][b][m][n] = (f32x4){0.f, 0.f, 0.f, 0.f};
    bf16x8 At[4][2], B0[2][2], B1[2][2];
    const char* cA = P.ap(cur); const char* cB = P.bp(cur);
    PG8_AOFF(voffA, cur);
    PG8_STAGE(PG8_SB(0, 0), cB, voffB); PG8_STAGE(PG8_SB(0, 1), cB + hstepB, voffB); PG8_STAGE(PG8_SA(0, 0), cA, voffA[0]); PG8_STAGE(PG8_SA(0, 1), cA, voffA[1]);
    if (wr == 1) PG8_BAR;
    PG8_WAIT_V(2); PG8_BAR;
    PG8_STAGE(PG8_SB(1, 0), cB + kstep, voffB); PG8_STAGE(PG8_SA(1, 0), cA + kstep, voffA[0]); PG8_STAGE(PG8_SB(1, 1), cB + hstepB + kstep, voffB);
    PG8_WAIT_V(6); PG8_BAR;
    for (;;) {
        const bool has_next = S.next(ui + 1, nxt);
        const char* nA = has_next ? P.ap(nxt) : cA; const char* nB = has_next ? P.bp(nxt) : cB;
        if constexpr (Prob::GATHER) { if (has_next) PG8_AOFF(voffN, nxt); else { _Pragma("unroll") for (int h_ = 0; h_ < 2; ++h_) _Pragma("unroll") for (int i_ = 0; i_ < 2; ++i_) voffN[h_][i_] = voffA[h_][i_]; } }
        for (int t = 0; t < nt; t += 2) {
            const bool last = (t == nt - 2);
            const char* a1 = cA + (size_t)(t + 1) * kstep;
            const char* a2 = last ? nA : cA + (size_t)(t + 2) * kstep; const char* b2 = last ? nB : cB + (size_t)(t + 2) * kstep;
            const char* a3 = a2 + kstep; const char* b3 = b2 + kstep;
            unsigned vo2[2][2];
#pragma unroll
            for (int h_ = 0; h_ < 2; ++h_)
#pragma unroll
                for (int i_ = 0; i_ < 2; ++i_) vo2[h_][i_] = (Prob::GATHER && last) ? voffN[h_][i_] : voffA[h_][i_];
            PG8_LDB(B0, 0, 0); PG8_LDB(B1, 0, 1); PG8_SCHED; PG8_LDA(At, 0, 0); PG8_STAGE(PG8_SA(1, 1), a1, voffA[1]);
            PG8_WAIT_V(8); PG8_WAIT_L(0); PG8_BAR; PG8_MMA(0, 0, At, B0); PG8_MMA(0, 1, At, B1); PG8_BAR; PG8_SCHED;
            PG8_LDA(At, 0, 1); PG8_STAGE(PG8_SB(0, 0), b2, voffB); PG8_STAGE(PG8_SB(0, 1), b2 + hstepB, voffB); PG8_STAGE(PG8_SA(0, 0), a2, vo2[0]);
            PG8_WAIT_V(8); PG8_WAIT_L(0); PG8_BAR; PG8_MMA(1, 0, At, B0); PG8_MMA(1, 1, At, B1); PG8_BAR; PG8_SCHED;
            PG8_LDB(B0, 1, 0); PG8_LDB(B1, 1, 1); PG8_SCHED; PG8_LDA(At, 1, 0); PG8_STAGE(PG8_SA(0, 1), a2, vo2[1]);
            PG8_WAIT_V(8); PG8_WAIT_L(0); PG8_BAR; PG8_MMA(0, 0, At, B0); PG8_MMA(0, 1, At, B1); PG8_BAR; PG8_SCHED;
            PG8_LDA(At, 1, 1); PG8_STAGE(PG8_SB(1, 0), b3, voffB); PG8_STAGE(PG8_SB(1, 1), b3 + hstepB, voffB); PG8_STAGE(PG8_SA(1, 0), a3, vo2[0]);
            PG8_WAIT_V(8); PG8_WAIT_L(0); PG8_BAR; PG8_MMA(1, 0, At, B0); PG8_MMA(1, 1, At, B1); PG8_BAR; PG8_SCHED;
        }
        if (wr == 0) PG8_BAR;
        const bool z = E(acc, cur, wr, wc, fr, fq);
        if (!has_next) break;
        if (z) {
#pragma unroll
            for (int a = 0; a < 2; ++a)
#pragma unroll
                for (int b = 0; b < 2; ++b)
#pragma unroll
                    for (int m = 0; m < 4; ++m)
#pragma unroll
                        for (int n = 0; n < 2; ++n) acc[a][b][m][n] = (f32x4){0.f, 0.f, 0.f, 0.f};
        }
        cur = nxt; cA = nA; cB = nB; ++ui;
        if constexpr (Prob::GATHER) { _Pragma("unroll") for (int h_ = 0; h_ < 2; ++h_) _Pragma("unroll") for (int i_ = 0; i_ < 2; ++i_) voffA[h_][i_] = voffN[h_][i_]; }
        if (wr == 1) PG8_BAR;
    }
    PG8_WAIT_V(0);
    PG8_BAR;
#undef PG8_AOFF
#undef PG8_SA
#undef PG8_SB
#undef PG8_STAGE
#undef PG8_LDA
#undef PG8_LDB
#undef PG8_MMA
#undef PG8_WAIT_V
#undef PG8_WAIT_L
#undef PG8_BAR
#undef PG8_SCHED
}

struct ProbPlain { static constexpr bool GATHER = false; const bf16* A; const bf16* B; int K, lda, ldb;
    __device__ __forceinline__ const char* ap(const Unit& u) const { return (const char*)(A + (size_t)u.pm * 256 * lda); }
    __device__ __forceinline__ int arow(const Unit&, int rr) const { return rr; }
    __device__ __forceinline__ const char* bp(const Unit& u) const { return (const char*)(B + (size_t)u.pn * 256 * ldb); } };
struct ProbSeg3 { static constexpr bool GATHER = false; const bf16* A; const bf16* B; int K, lda, ldb; size_t sA, sB;
    __device__ __forceinline__ const char* ap(const Unit& u) const { return (const char*)(A + (size_t)u.sg * sA + (size_t)u.pm * 256 * lda); }
    __device__ __forceinline__ int arow(const Unit&, int rr) const { return rr; }
    __device__ __forceinline__ const char* bp(const Unit& u) const { return (const char*)(B + (size_t)u.sg * sB + (size_t)u.pn * 256 * ldb); } };
struct ProbUp2 { static constexpr bool GATHER = false; const bf16* A0; const bf16* A1; const bf16* B0; const bf16* B1; int K, lda, ldb;
    __device__ __forceinline__ const char* ap(const Unit& u) const { return (const char*)((u.sg ? A1 : A0) + (size_t)u.pm * 256 * lda); }
    __device__ __forceinline__ int arow(const Unit&, int rr) const { return rr; }
    __device__ __forceinline__ const char* bp(const Unit& u) const { return (const char*)((u.sg ? B1 : B0) + (size_t)u.pn * 256 * ldb); } };
struct OrderUp2 { int n0, nwg, G, c, nM0;
    __device__ __forceinline__ void init(int nM0_, int G_, int c_) { nM0 = nM0_; n0 = nM0_ * 3; nwg = n0 + (MT / 256) * 4; G = G_; c = c_; }
    __device__ __forceinline__ bool next(int i, Unit& u) const { const int L = i * G + c; if (L >= nwg) return false;
        if (L < n0) { u.sg = 0; u.pm = L / 3; u.pn = L - u.pm * 3; } else { const int r = L - n0; u.sg = 1; u.pm = r >> 2; u.pn = r & 3; } return true; } };
struct OrderWinLast { int G, c;
    __device__ __forceinline__ void init(int G_, int c_) { G = G_; c = c_; }
    __device__ __forceinline__ bool next(int i, Unit& u) const { const int L = i * G + c; u.sg = 0; if (L >= 128 * 24 + 16 * 5) return false;
        if (L < 128 * 24) { const int g = L / (8 * 24), q = L - g * 8 * 24; u.pm = g * 8 + (q & 7); u.pn = q >> 3; }
        else { const int r = L - 128 * 24, t = r % 5; u.pm = 128 + r / 5; u.pn = t < 4 ? 2 + t : 7; } return true; } };
struct ProbMoE { static constexpr bool GATHER = false; const bf16* A; const bf16* B; int K, lda, ldb; int nrowsB;
    __device__ __forceinline__ const char* ap(const Unit& u) const { return (const char*)(A + (size_t)u.pm * 256 * lda); }
    __device__ __forceinline__ int arow(const Unit&, int rr) const { return rr; }
    __device__ __forceinline__ const char* bp(const Unit& u) const { return (const char*)(B + ((size_t)(u.pm / 18) * nrowsB + (size_t)u.pn * 256) * ldb); } };
struct ProbMoEGather { static constexpr bool GATHER = true; const bf16* A; const bf16* B; const LAS int* lidx; int K, lda, ldb; int nrowsB;
    __device__ __forceinline__ const char* ap(const Unit&) const { return (const char*)A; }
    __device__ __forceinline__ int arow(const Unit& u, int rr) const { return lidx[u.sg * 256 + rr]; }
    __device__ __forceinline__ const char* bp(const Unit& u) const { return (const char*)(B + ((size_t)(u.pm / 18) * nrowsB + (size_t)u.pn * 256) * ldb); } };
struct OrderOrd { Order<1> o;
    __device__ __forceinline__ bool next(int i, Unit& u) const { const bool r = o.next(i, u); u.sg = i; return r; } };

#define EPI_ROWS(...) _Pragma("unroll") for (int ai = 0; ai < 2; ++ai) _Pragma("unroll") for (int m = 0; m < 4; ++m) { const int row = u.pm * 256 + ai * 128 + wr * 64 + m * 16 + fr; __VA_ARGS__ }
#define EPI_COLS8(...) _Pragma("unroll") for (int bj = 0; bj < 2; ++bj) { const int col = u.pn * 256 + bj * 128 + wc * 32 + 8 * fq; __VA_ARGS__ }
#define EPI_LANE() int t_ = lane_id(); asm volatile("" : "+v"(t_)); const int fr = t_ & 15, fq = t_ >> 4
__device__ __forceinline__ v4u pack8(const f32x4& a, const f32x4& b) { v4u w; w.x = pk2(a[0], a[1]); w.y = pk2(a[2], a[3]); w.z = pk2(b[0], b[1]); w.w = pk2(b[2], b[3]); return w; }
__device__ __forceinline__ f32x4 unpack4(v2u w) { return (f32x4){bflo(w.x), bfhi(w.x), bflo(w.y), bfhi(w.y)}; }
struct EpiBf16 { bf16* O; int ldc;
    __device__ __forceinline__ bool operator()(f32x4 (&acc)[2][2][4][2], const Unit& u, int wr, int wc, int fr_, int fq_) const {
        EPI_LANE();
        EPI_ROWS( bf16* rp = O + (size_t)row * ldc; EPI_COLS8( *(v4u*)(rp + col) = pack8(acc[ai][bj][m][0], acc[ai][bj][m][1]); ) )
        return true; } };
__device__ __forceinline__ f32x4 sigmoid4(const f32x4& v) { return (f32x4){__builtin_amdgcn_rcpf(1.f + __expf(-v[0])), __builtin_amdgcn_rcpf(1.f + __expf(-v[1])), __builtin_amdgcn_rcpf(1.f + __expf(-v[2])), __builtin_amdgcn_rcpf(1.f + __expf(-v[3]))}; }
struct EpiUp2 { bf16* O0; bf16* O1;
    __device__ __forceinline__ bool operator()(f32x4 (&acc)[2][2][4][2], const Unit& u, int wr, int wc, int fr_, int fq_) const {
        EPI_LANE();
        bf16* O = u.sg ? O1 : O0; const int ldc = u.sg ? 1024 : 768;
        EPI_ROWS( bf16* rp = O + (size_t)row * ldc; EPI_COLS8( *(v4u*)(rp + col) = pack8(acc[ai][bj][m][0], acc[ai][bj][m][1]); ) )
        return true; } };
__device__ __forceinline__ size_t gtile_off(int pm, int gt  , int ai, int m, int bj, int wave, int lane) {
    return ((size_t)(pm * 12 + gt) * 16 + ((ai * 4 + m) * 2 + bj)) * 4096 + (size_t)(wave * 64 + lane) * 8; }
struct EpiWin { bf16* O; bf16* GT;
    __device__ __forceinline__ bool operator()(f32x4 (&acc)[2][2][4][2], const Unit& u, int wr, int wc, int fr_, int fq_) const {
        EPI_LANE();
        const bool sg = u.pn >= 10, gtile = u.pn >= 12; const int wave = wr * 4 + wc, gti = gtile ? u.pn - 12 : 0;
        _Pragma("unroll") for (int ai = 0; ai < 2; ++ai) _Pragma("unroll") for (int m = 0; m < 4; ++m) { const int row = u.pm * 256 + ai * 128 + wr * 64 + m * 16 + fr;
            _Pragma("unroll") for (int bj = 0; bj < 2; ++bj) { const int col = u.pn * 256 + bj * 128 + wc * 32 + 8 * fq;
                f32x4 v0 = acc[ai][bj][m][0], v1 = acc[ai][bj][m][1];
                if (sg) { v0 = sigmoid4(v0); v1 = sigmoid4(v1); }
                bf16* dst = gtile ? GT + gtile_off(u.pm, gti, ai, m, bj, wave, t_) : O + (size_t)row * NP + col;
                *(v4u*)dst = pack8(v0, v1); } }
        return true; } };
__device__ __forceinline__ f32x4 gate_ratio(v2u a, v2u b, bool fin) { const f32x4 x = unpack4(a), y = unpack4(b);
    return (f32x4){x[0] * (fin ? 1.f : __builtin_amdgcn_rcpf(fmaxf(y[0], 1e-20f))), x[1] * (fin ? 1.f : __builtin_amdgcn_rcpf(fmaxf(y[1], 1e-20f))), x[2] * (fin ? 1.f : __builtin_amdgcn_rcpf(fmaxf(y[2], 1e-20f))), x[3] * (fin ? 1.f : __builtin_amdgcn_rcpf(fmaxf(y[3], 1e-20f)))}; }
struct EpiMerge { const bf16* GT; bf16* O;
    __device__ __forceinline__ bool operator()(f32x4 (&acc)[2][2][4][2], const Unit& u, int wr, int wc, int fr_, int fq_) const {
        EPI_LANE();
        const int sg = u.sg; const bool fin = sg == 2; const int sgb = fin ? 2 : sg + 1; const int wave = wr * 4 + wc;
        _Pragma("unroll") for (int ai = 0; ai < 2; ++ai) {
            _Pragma("unroll") for (int m = 0; m < 4; ++m) { const int row = u.pm * 256 + ai * 128 + wr * 64 + m * 16 + fr; bf16* rp = O + (size_t)row * DM;
                EPI_COLS8( const v4u ga = *(const v4u*)(GT + gtile_off(u.pm, sg * 4 + u.pn, ai, m, bj, wave, t_)), gb = *(const v4u*)(GT + gtile_off(u.pm, sgb * 4 + u.pn, ai, m, bj, wave, t_));
                    const f32x4 v0 = acc[ai][bj][m][0] * gate_ratio((v2u){ga.x, ga.y}, (v2u){gb.x, gb.y}, fin), v1 = acc[ai][bj][m][1] * gate_ratio((v2u){ga.z, ga.w}, (v2u){gb.z, gb.w}, fin);
                    acc[ai][bj][m][0] = v0; acc[ai][bj][m][1] = v1;
                    if (fin) *(v4u*)(rp + col) = pack8(v0, v1); ) }
            asm volatile("" ::: "memory"); }
        return fin; } };
struct EpiSwiGLU { bf16* HID;
    __device__ __forceinline__ bool operator()(f32x4 (&acc)[2][2][4][2], const Unit& u, int wr, int wc, int fr_, int fq_) const {
        EPI_LANE();
        EPI_ROWS( bf16* rp = HID + (size_t)row * 1024 + u.pn * 128 + wc * 32 + 8 * fq; f32x4 h[2];
            _Pragma("unroll") for (int n = 0; n < 2; ++n) { const f32x4 g = acc[ai][0][m][n], up = acc[ai][1][m][n];
                h[n] = (f32x4){g[0] * __builtin_amdgcn_rcpf(1.f + __expf(-g[0])) * up[0], g[1] * __builtin_amdgcn_rcpf(1.f + __expf(-g[1])) * up[1], g[2] * __builtin_amdgcn_rcpf(1.f + __expf(-g[2])) * up[2], g[3] * __builtin_amdgcn_rcpf(1.f + __expf(-g[3])) * up[3]}; }
            *(v4u*)rp = pack8(h[0], h[1]); )
        return true; } };
}

#define XB_TMO      128
#define XB_XCNT(j)  (256  + 64 * (j))
#define XB_XSUB(j)  (1280 + 64 * (j))
#define XB_XGEN(j)  (2304 + 64 * (j))
#define XB_TOP      3328
#define XB_TOPGEN   3392
#define XCD_BAR_WORDS 3456
#define XB_SPIN_CAP (1u << 22)
__device__ __forceinline__ unsigned xb_ld(unsigned* p)              { return __hip_atomic_load(p, __ATOMIC_RELAXED, __HIP_MEMORY_SCOPE_AGENT); }
__device__ __forceinline__ unsigned xb_add(unsigned* p, unsigned v) { return __hip_atomic_fetch_add(p, v, __ATOMIC_RELAXED, __HIP_MEMORY_SCOPE_AGENT); }
__device__ __forceinline__ unsigned xb_xcc_id() { return (unsigned)__builtin_amdgcn_s_getreg((3 << 11) | 20) & 0xFu; }
#define XB_SPIN(cond, bar) do { unsigned _sp = 0; while (cond) { __builtin_amdgcn_s_sleep(1); \
    if ((++_sp & 255u) == 0u) { if (xb_ld(&(bar)[XB_TMO])) break; if (_sp > XB_SPIN_CAP) { atomicAdd(&(bar)[XB_TMO], 1u); break; } } } } while (0)
struct XcdBarrier { unsigned* bar; unsigned x; volatile LAS unsigned* st; int wv; };
__device__ __forceinline__ XcdBarrier xcd_barrier_post(unsigned* bar, volatile LAS unsigned* st, int wv) {
    XcdBarrier b; b.bar = bar; b.x = xb_xcc_id(); b.st = st; b.wv = wv;
    if (wv == 0 && lane_id() == 0) (void)xb_add(&bar[XB_XCNT(b.x)], 1u);
    return b;
}
__device__ __forceinline__ void xcd_barrier_complete(unsigned* bar, unsigned x, unsigned& nloc, unsigned& nx) {
    const unsigned G = gridDim.x * gridDim.y * gridDim.z;
    unsigned sum, cnt, mine, sp = 0u;
    for (;;) {
        sum = 0u; cnt = 0u; mine = 0u;
#pragma unroll
        for (unsigned j = 0; j < 16; ++j) { const unsigned c = xb_ld(&bar[XB_XCNT(j)]); sum += c; cnt += (c > 0u) ? 1u : 0u; mine = (j == x) ? c : mine; }
        if (sum == G) break;
        __builtin_amdgcn_s_sleep(1);
        if ((++sp & 255u) == 0u) { if (xb_ld(&bar[XB_TMO])) break; if (sp > XB_SPIN_CAP) { atomicAdd(&bar[XB_TMO], 1u); break; } }
    }
    nloc = mine > 0u ? mine : 1u; nx = cnt > 0u ? cnt : 1u;
}
__device__ __forceinline__ void xcd_barrier(const XcdBarrier& b) {
    asm volatile("s_waitcnt vmcnt(0)" ::: "memory");
    __syncthreads();
    if (b.wv == 0 && lane_id() == 0) {
        unsigned* bar = b.bar; unsigned bx_ = b.x; asm volatile("" : "+s"(bx_)); asm volatile("" : "+s"(bar));
        __builtin_amdgcn_s_waitcnt(0);
        unsigned nloc = b.st[0], nx = b.st[1];
        if (nloc == 0u) { xcd_barrier_complete(bar, bx_, nloc, nx); b.st[0] = nloc; b.st[1] = nx; }
        const unsigned old = xb_add(&bar[XB_XSUB(bx_)], 1u);
        const unsigned gen = old / nloc;
        if (old + 1u == (gen + 1u) * nloc) {
            __builtin_amdgcn_fence(__ATOMIC_RELEASE, "agent");
            asm volatile("s_waitcnt vmcnt(0)" ::: "memory");
            const unsigned og = xb_add(&bar[XB_TOP], 1u);
            const unsigned tg = og / nx;
            if (og + 1u == (tg + 1u) * nx) xb_add(&bar[XB_TOPGEN], 1u);
            else XB_SPIN(xb_ld(&bar[XB_TOPGEN]) == tg, bar);
            __builtin_amdgcn_fence(__ATOMIC_ACQUIRE, "agent");
            xb_add(&bar[XB_XGEN(bx_)], 1u);
            asm volatile("s_waitcnt vmcnt(0)" ::: "memory");
        } else {
            XB_SPIN(xb_ld(&bar[XB_XGEN(bx_)]) == gen, bar);
            __builtin_amdgcn_fence(__ATOMIC_ACQUIRE, "agent");
            asm volatile("s_waitcnt vmcnt(0)" ::: "memory");
        }
    }
    __syncthreads();
}

struct Args { const float* in[28]; float* out; unsigned char* ws; };
enum { I_X = 0, I_C, I_CTX, I_CCTX, I_WADA, I_BADA, I_WIN, I_GQ, I_WUQ, I_GKV, I_WUKV, I_RPB, I_WDW, I_BDW, I_GCN, I_BCN, I_WPW2, I_WOA, I_WOB, I_WOUT, I_LN1G, I_LN1B, I_WROUTER, I_WGATE, I_WUP, I_WDOWN, I_LN2G, I_LN2B };

#define OPAQUE(v) asm volatile("" : "+v"(v))
struct Ctx {
    LAS unsigned char* lds;
    int tid, lane, wave, G, bid;
    const float* const* in;
    unsigned char* ws;
    float* out;
};
#define WSP(T, off) ((T*)(C.ws + (off)))
#define WSW(T, off, l) ((T*)(C.ws + (off) + (size_t)((l) & 1) * WS_WSET))

template <class RowPtr>
__device__ __forceinline__ void tr_item(const float* W, int N, int k0, int n0, const RowPtr& rp, LAS float* scr, int lane) {
#pragma unroll
    for (int i = 0; i < 8; ++i) { const int kk = 8 * i + (lane >> 3), nn = (lane & 7) * 4; const f32x4 v = *(const f32x4*)(W + (size_t)(k0 + kk) * N + n0 + nn);
        scr[kk * 33 + nn] = v[0]; scr[kk * 33 + nn + 1] = v[1]; scr[kk * 33 + nn + 2] = v[2]; scr[kk * 33 + nn + 3] = v[3]; }
    LDS_WAIT(); asm volatile("" ::: "memory");
    const int c = lane & 7;
#pragma unroll
    for (int j = 0; j < 4; ++j) { const int n = (lane >> 3) + 8 * j; const LAS float* s = scr + (8 * c) * 33 + n;
        v4u o; o.x = pk2(s[0 * 33], s[1 * 33]); o.y = pk2(s[2 * 33], s[3 * 33]); o.z = pk2(s[4 * 33], s[5 * 33]); o.w = pk2(s[6 * 33], s[7 * 33]);
        *(v4u*)(rp(n0 + n) + k0 + 8 * c) = o; }
    LDS_WAIT(); asm volatile("" ::: "memory");
}
struct RpPlain { bf16* base; int ld; __device__ __forceinline__ bf16* operator()(int n) const { return base + (size_t)n * ld; } };
struct RpWin { bf16* base; __device__ __forceinline__ bf16* operator()(int n) const { return base + (size_t)(n < 1952 ? n : n + 96) * 1024; } };
struct RpGU { bf16* base; int add; __device__ __forceinline__ bf16* operator()(int n) const { return base + (size_t)((n >> 7) * 256 + (n & 127) + add) * 1024; } };

__device__ __forceinline__ void conv_weights(const Ctx& Cc, int l, int f0, int f1, int wg0, int nwg) {
    Ctx C = Cc; OPAQUE(C.lane); OPAQUE(C.tid);
    LAS float* scr = (LAS float*)(C.lds + C.wave * 16384);
    if (C.bid < wg0) return;
    const int gw = (C.bid - wg0) * NWAVES + C.wave, NGW = nwg * NWAVES;
    constexpr int I_IN = 16 * 189, I_UQ = 4 * 24, I_UKV = 2 * 32, I_PW = 8 * 32, I_OUT = 16 * 32, I_EX = 16 * 32;
    constexpr int NITEMS = I_IN + I_UQ + I_UKV + 3 * I_PW + I_OUT + 48 * I_EX;
    bf16* WinT = WSW(bf16, WS_WIN, l);
    const int it0 = (int)((long)NITEMS * f0 / 100), it1 = (int)((long)NITEMS * f1 / 100);
    for (int it = it0 + gw; it < it1; it += NGW) {
        int r = it;
        if (r < I_IN) { const int kb = r / 189, nb = r % 189; tr_item(C.in[I_WIN] + (size_t)l * 1024 * 6048, 6048, kb * 64, nb * 32, RpWin{WinT}, scr, C.lane); continue; } r -= I_IN;
        if (r < I_UQ) { const int kb = r / 24, nb = r % 24; tr_item(C.in[I_WUQ] + (size_t)l * 256 * 768, 768, kb * 64, nb * 32, RpPlain{WSW(bf16, WS_WUQ, l), 256}, scr, C.lane); continue; } r -= I_UQ;
        if (r < I_UKV) { const int kb = r / 32, nb = r % 32; tr_item(C.in[I_WUKV] + (size_t)l * 128 * 1024, 1024, kb * 64, nb * 32, RpPlain{WSW(bf16, WS_WUKV, l), 256}, scr, C.lane); continue; } r -= I_UKV;
        if (r < 3 * I_PW) { const int w = r / I_PW, q = r % I_PW, kb = q / 32, nb = q % 32;
            const float* src = (w == 0 ? C.in[I_WPW2] : (w == 1 ? C.in[I_WOA] : C.in[I_WOB])) + (size_t)l * 512 * 1024;
            bf16* dst = WSW(bf16, w == 0 ? WS_WPW2 : (w == 1 ? WS_WOA : WS_WOB), l);
            tr_item(src, 1024, kb * 64, nb * 32, RpPlain{dst, 512}, scr, C.lane); continue; } r -= 3 * I_PW;
        if (r < I_OUT) { const int kb = r / 32, nb = r % 32; tr_item(C.in[I_WOUT] + (size_t)l * 1024 * 1024, 1024, kb * 64, nb * 32, RpPlain{WSW(bf16, WS_WOUT, l), 1024}, scr, C.lane); continue; } r -= I_OUT;
        { const int mat = r / I_EX, q = r % I_EX, kb = q / 32, nb = q % 32, w = mat / 16, e = mat % 16;
          const float* src = (w == 0 ? C.in[I_WGATE] : (w == 1 ? C.in[I_WUP] : C.in[I_WDOWN])) + ((size_t)l * 16 + e) * 1024 * 1024;
          if (w < 2) tr_item(src, 1024, kb * 64, nb * 32, RpGU{WSW(bf16, WS_WGU, l) + (size_t)e * 2048 * 1024, w * 128}, scr, C.lane);
          else tr_item(src, 1024, kb * 64, nb * 32, RpPlain{WSW(bf16, WS_WD, l) + (size_t)e * 1024 * 1024, 1024}, scr, C.lane); }
    }
    if (f0 != 0) return;
    const int gt = (C.bid - wg0) * NTHREADS + C.tid, NGT = nwg * NTHREADS;
    unsigned zz_ = 0u; asm volatile("" : "+v"(zz_)); const v4u z = (v4u){zz_, zz_, zz_, zz_};
    for (int i = gt; i < 96 * 128; i += NGT) *((v4u*)(WinT + (size_t)1952 * 1024) + i) = z;
    for (int i = gt; i < 1024 * 16; i += NGT) { const int n = i >> 4, c = i & 15; *((v4u*)(WSW(bf16, WS_WUKV, l) + (size_t)n * 256 + 128) + c) = z; }
}

__device__ __forceinline__ void phase_mods(const Ctx& Cc) {
    Ctx C = Cc; OPAQUE(C.lane); OPAQUE(C.tid);
    LAS float* sc = (LAS float*)C.lds;
    LAS float* red = (LAS float*)(C.lds + 69632);
    for (int idx = C.tid; idx < 17 * 1024; idx += NTHREADS) { const int r = idx >> 10, k = idx & 1023; const float v = r < 16 ? C.in[I_C][r * 1024 + k] : C.in[I_CCTX][k]; sc[idx] = v / (1.f + __expf(-v)); }
    __syncthreads();
    float* MODS = WSP(float, WS_MODS);
    for (int item = C.bid; item < NL * 96; item += C.G) {
        const int l = item / 96, cb = item % 96, col = cb * 64 + C.lane;
        const float* W = C.in[I_WADA] + (size_t)l * 1024 * 6144;
        float acc[17];
#pragma unroll
        for (int r = 0; r < 17; ++r) acc[r] = 0.f;
        for (int k = C.wave * 128; k < C.wave * 128 + 128; k += 4) { const float w0 = W[(size_t)k * 6144 + col], w1 = W[(size_t)(k + 1) * 6144 + col], w2 = W[(size_t)(k + 2) * 6144 + col], w3 = W[(size_t)(k + 3) * 6144 + col];
#pragma unroll
            for (int r = 0; r < 17; ++r) { const f32x4 sv = *(const LAS f32x4*)(sc + r * 1024 + k); acc[r] += (sv[0] * w0 + sv[1] * w1) + (sv[2] * w2 + sv[3] * w3); } }
#pragma unroll
        for (int r = 0; r < 17; ++r) red[(C.wave * 17 + r) * 64 + C.lane] = acc[r];
        __syncthreads();
        for (int o = C.tid; o < 17 * 64; o += NTHREADS) { const int r = o >> 6, cl = o & 63; float s = C.in[I_BADA][l * 6144 + cb * 64 + cl];
#pragma unroll
            for (int w = 0; w < 8; ++w) s += red[(w * 17 + r) * 64 + cl];
            MODS[((size_t)l * 17 + r) * 6144 + cb * 64 + cl] = s; }
        __syncthreads();
    }
    float* TAB = WSP(float, WS_TAB);
    const int gt = C.bid * NTHREADS + C.tid, NGT = C.G * NTHREADS;
    for (int idx = gt; idx < 2048 * 16; idx += NGT) { const int t = idx >> 4, j = idx & 15, which = j >> 3, i = j & 7;
        const float pos = (float)(which ? (t & 63) : (t >> 6)), invf = exp2f(-(float)i * (13.287712379549449f / 8.f)), ang = pos * invf;
        TAB[t * 32 + which * 16 + i] = __cosf(ang); TAB[t * 32 + which * 16 + 8 + i] = __sinf(ang); }
}

__device__ __forceinline__ void phase_mod0(const Ctx& Cc) {
    Ctx C = Cc; OPAQUE(C.lane);
    const int gw = C.bid * NWAVES + C.wave, NGW = C.G * NWAVES;
    const float* MODS = WSP(float, WS_MODS); float* X = WSP(float, WS_X); bf16* H = WSP(bf16, WS_HB);
    for (int row = gw; row < MT; row += NGW) {
        const float* src = row < ML ? C.in[I_X] + (size_t)row * DM : C.in[I_CTX] + (size_t)(row - ML) * DM;
        const int mr = row < ML ? (row >> 11) : 16; const float* md = MODS + (size_t)mr * 6144;
#pragma unroll
        for (int j = 0; j < 2; ++j) { const int c0 = 8 * (C.lane + 64 * j); f32x4 h[2];
#pragma unroll
            for (int q = 0; q < 2; ++q) { const int c = c0 + 4 * q; const f32x4 xv = *(const f32x4*)(src + c), sh = *(const f32x4*)(md + c), scl = *(const f32x4*)(md + 1024 + c);
                *(f32x4*)(X + (size_t)row * DM + c) = xv; h[q] = xv * (scl + 1.f) + sh; }
            *(v4u*)(H + (size_t)row * DM + c0) = pg8::pack8(h[0], h[1]); }
    }
}

__device__ __forceinline__ void phase_prep(const Ctx& C, int l) {
    int lane = C.lane; OPAQUE(lane); const int gw = C.bid * NWAVES + C.wave, NGW = C.G * NWAVES;
    const bf16* PROJ = WSP(bf16, WS_R); bf16* CQN = WSP(bf16, WS_CQN); bf16* CKVN = WSP(bf16, WS_CKVN); bf16* KR = WSP(bf16, WS_KR);
    const float* TAB = WSP(float, WS_TAB);
    const f32x4 gq = *(const f32x4*)(C.in[I_GQ] + l * 256 + 4 * lane); const f32x2 gkv = *(const f32x2*)(C.in[I_GKV] + l * 128 + 2 * lane);
    for (int row = gw; row < MT; row += NGW) {
        const bf16* p = PROJ + (size_t)row * NP;
        { const v2u w = *(const v2u*)(p + C_CQ + 4 * lane); const float x0 = bflo(w.x), x1 = bfhi(w.x), x2 = bflo(w.y), x3 = bfhi(w.y);
          const float ss = wave_sum(x0 * x0 + x1 * x1 + x2 * x2 + x3 * x3), r = 1.f / sqrtf(ss * (1.f / 256.f) + RMS_EPS);
          v2u o; o.x = pk2(x0 * r * gq[0], x1 * r * gq[1]); o.y = pk2(x2 * r * gq[2], x3 * r * gq[3]); *(v2u*)(CQN + (size_t)row * 256 + 4 * lane) = o; }
        { const unsigned w = *(const unsigned*)(p + C_CKV + 2 * lane); const float x0 = bflo(w), x1 = bfhi(w);
          const float ss = wave_sum(x0 * x0 + x1 * x1), r = 1.f / sqrtf(ss * (1.f / 128.f) + RMS_EPS);
          *(unsigned*)(CKVN + (size_t)row * 256 + 2 * lane) = pk2(x0 * r * gkv[0], x1 * r * gkv[1]); *(unsigned*)(CKVN + (size_t)row * 256 + 128 + 2 * lane) = 0u; }
        if (lane < 16) { const int gi = lane >> 3, i = lane & 7; const float x1 = bf2f(p[C_KR + gi * 16 + i]), x2 = bf2f(p[C_KR + gi * 16 + 8 + i]); float o1 = x1, o2 = x2;
          if (row < ML) { const int t = row & 2047; const float cs = TAB[t * 32 + gi * 16 + i], sn = TAB[t * 32 + gi * 16 + 8 + i]; o1 = x1 * cs - x2 * sn; o2 = x2 * cs + x1 * sn; }
          KR[(size_t)row * 32 + gi * 16 + i] = (bf16)f2bf(o1); KR[(size_t)row * 32 + gi * 16 + 8 + i] = (bf16)f2bf(o2); }
    }
}

__device__ __forceinline__ void phase_conv(const Ctx& C, int l) {
    int tid = C.tid; OPAQUE(tid); const int lane = tid & 63, w = C.wave;
    LAS float* Wt = (LAS float*)C.lds;
    LAS unsigned char* Xt = C.lds + 63488;
    const bf16* PROJ = WSP(bf16, WS_R); bf16* U = WSP(bf16, WS_U);
    { const float* wdw = C.in[I_WDW] + (size_t)l * 31 * 512;
      for (int i = tid; i < 31 * 128; i += NTHREADS) { const int j = i >> 7, c4 = i & 127, ln = c4 >> 1, hf = c4 & 1; *(LAS f32x4*)(Wt + ((j * 2 + hf) * 64 + ln) * 4) = *(const f32x4*)(wdw + j * 512 + 4 * c4); } }
    const f32x4 bd0 = *(const f32x4*)(C.in[I_BDW] + l * 512 + 8 * lane), bd1 = *(const f32x4*)(C.in[I_BDW] + l * 512 + 8 * lane + 4);
    const f32x4 gc0 = *(const f32x4*)(C.in[I_GCN] + l * 512 + 8 * lane), gc1 = *(const f32x4*)(C.in[I_GCN] + l * 512 + 8 * lane + 4);
    const f32x4 bc0 = *(const f32x4*)(C.in[I_BCN] + l * 512 + 8 * lane), bc1 = *(const f32x4*)(C.in[I_BCN] + l * 512 + 8 * lane + 4);
    const int ntile = (l == NL - 1 ? ML : MT) / 32;
    for (int tile = C.bid; tile < ntile; tile += C.G) {
        const int r0 = tile * 32, t0 = r0 < ML ? (r0 & 2047) : ((r0 - ML) & 255), L = r0 < ML ? 2048 : 256;
#pragma unroll
        for (int it = 0; it < 8; ++it) { const int idx = tid + 512 * it, rr = idx >> 6, ch = idx & 63, tt = t0 - 15 + rr;
            if (rr < 62) { v4u o = (v4u){0u, 0u, 0u, 0u};
                if (tt >= 0 && tt < L) { const bf16* p = PROJ + (size_t)(r0 - 15 + rr) * NP + C_CIN + 8 * ch; const v4u a = *(const v4u*)p, g = *(const v4u*)(p + 512);
                    o.x = pk2(bflo(a.x) * bflo(g.x), bfhi(a.x) * bfhi(g.x)); o.y = pk2(bflo(a.y) * bflo(g.y), bfhi(a.y) * bfhi(g.y));
                    o.z = pk2(bflo(a.z) * bflo(g.z), bfhi(a.z) * bfhi(g.z)); o.w = pk2(bflo(a.w) * bflo(g.w), bfhi(a.w) * bfhi(g.w)); }
                *(LAS v4u*)(Xt + rr * 1024 + ch * 16) = o; } }
        __syncthreads();
        f32x4 a0[4], a1[4];
#pragma unroll
        for (int tk = 0; tk < 4; ++tk) { a0[tk] = bd0; a1[tk] = bd1; }
        f32x4 wq0[4], wq1[4];
#pragma unroll
        for (int d = 0; d < 4; ++d) { wq0[d] = (f32x4){0.f, 0.f, 0.f, 0.f}; wq1[d] = (f32x4){0.f, 0.f, 0.f, 0.f}; }
#pragma unroll
        for (int rr = 0; rr < 34; ++rr) {
            if (rr <= 30) { wq0[0] = *(const LAS f32x4*)(Wt + ((rr * 2 + 0) * 64 + lane) * 4); wq1[0] = *(const LAS f32x4*)(Wt + ((rr * 2 + 1) * 64 + lane) * 4); }
            else { wq0[0] = (f32x4){0.f, 0.f, 0.f, 0.f}; wq1[0] = (f32x4){0.f, 0.f, 0.f, 0.f}; }
            const v4u g = *(const LAS v4u*)(Xt + (4 * w + rr) * 1024 + lane * 16);
            const f32x4 x0 = (f32x4){bflo(g.x), bfhi(g.x), bflo(g.y), bfhi(g.y)}, x1 = (f32x4){bflo(g.z), bfhi(g.z), bflo(g.w), bfhi(g.w)};
#pragma unroll
            for (int tk = 0; tk < 4; ++tk) { const int j = rr - tk; if (j >= 0 && j <= 30) { a0[tk] = a0[tk] + x0 * wq0[tk]; a1[tk] = a1[tk] + x1 * wq1[tk]; } }
            wq0[3] = wq0[2]; wq0[2] = wq0[1]; wq0[1] = wq0[0]; wq1[3] = wq1[2]; wq1[2] = wq1[1]; wq1[1] = wq1[0];
        }
#pragma unroll
        for (int tk = 0; tk < 4; ++tk) { f32x4 x0 = a0[tk], x1 = a1[tk];
            const float mean = wave_sum((x0[0] + x0[1]) + (x0[2] + x0[3]) + (x1[0] + x1[1]) + (x1[2] + x1[3])) * (1.f / 512.f);
            x0 = x0 - mean; x1 = x1 - mean;
            const float var = wave_sum((x0[0] * x0[0] + x0[1] * x0[1]) + (x0[2] * x0[2] + x0[3] * x0[3]) + (x1[0] * x1[0] + x1[1] * x1[1]) + (x1[2] * x1[2] + x1[3] * x1[3])) * (1.f / 512.f);
            const float rstd = 1.f / sqrtf(var + LN_EPS);
            f32x4 y0 = x0 * rstd * gc0 + bc0, y1 = x1 * rstd * gc1 + bc1;
#pragma unroll
            for (int q = 0; q < 4; ++q) { y0[q] = y0[q] / (1.f + __expf(-y0[q])); y1[q] = y1[q] / (1.f + __expf(-y1[q])); }
            v4u o; o.x = pk2(y0[0], y0[1]); o.y = pk2(y0[2], y0[3]); o.z = pk2(y1[0], y1[1]); o.w = pk2(y1[2], y1[3]);
            *(v4u*)(U + (size_t)(r0 + 4 * w + tk) * 512 + 8 * lane) = o; }
        __syncthreads();
    }
}

typedef float f32x16 __attribute__((ext_vector_type(16)));
typedef short v4i16 __attribute__((ext_vector_type(4)));
#define MFMA32(a, b, c) __builtin_amdgcn_mfma_f32_32x32x16_bf16(a, b, c, 0, 0, 0)
constexpr int AT_KBUF = 13312, AT_VBUF = 8192;
constexpr int AT_K0 = 0, AT_V0 = 3 * AT_KBUF, AT_RPB = AT_V0 + 3 * AT_VBUF, AT_QR = AT_RPB + 15 * 128 * 4, AT_END = AT_QR + 8 * 4096;
static_assert(AT_END <= RING_BYTES, "attention LDS map");
template <int MODE> __device__ __forceinline__ void attn_unit(const Ctx& C, int l, int unit) {
    constexpr bool MLA = MODE < 2; constexpr int DQK = MLA ? 96 : 64, KC = DQK / 8, KS = DQK / 16, RS = DQK * 2 + 16, NCH = 64 * KC + 512;
    constexpr int QT = (MODE == 0 || MODE == 2) ? 2 : 1;
    const int w = C.wave, lane = lane_id(), tid = w * 64 + lane, r = lane & 31, hh = lane >> 5;
    const bf16* PROJ = WSP(bf16, WS_R); const bf16* QB = WSP(bf16, WS_QB); const bf16* KVB = WSP(bf16, WS_KVB); const bf16* KR = WSP(bf16, WS_KR); const float* TAB = WSP(float, WS_TAB);
    bf16* Yo = WSP(bf16, MLA ? WS_YB : WS_YA);
    LAS unsigned char* lds = C.lds;
    int b, hd, q0, T, NB = 0, rs_min = 0, gi = 0;
    if (MODE == 0) { hd = unit & 7; const int qb = (unit >> 3) & 3; b = unit >> 5; q0 = b * 2048 + qb * 512; T = 36; }
    else if (MODE == 2) { hd = unit & 7; const int ib = (unit >> 3) & 3; b = unit >> 5; q0 = b * 2048 + ib * 512; gi = ib * 8 + w;
        rs_min = min(max(ib * 8 - 4, 0), 24); const int rs_max = min(max(ib * 8 + 3, 0), 24); NB = rs_max - rs_min + 8; T = NB + 4; }
    else { hd = unit & 7; b = unit >> 3; q0 = ML + b * 256; T = 4; }
    const int qrow0 = q0 + 32 * QT * w + r;
    constexpr int NKQ = (64 * (KC + 1)) / 64, NQ = NKQ + 8;
    auto tile_row0 = [&](int t) -> int {
        if (MODE == 0) return t < 4 ? ML + b * 256 + 64 * t : b * 2048 + 64 * (t - 4);
        if (MODE == 2) return t < NB ? b * 2048 + (rs_min + t) * 64 : ML + b * 256 + 64 * (t - NB);
        return ML + b * 256 + 64 * t; };
    int goff[3]; bool gkr[3]; int dblk[3]; bool dk[3];
#pragma unroll
    for (int j = 0; j < 3; ++j) { int q_ = w + 8 * j; if (q_ >= NQ) q_ -= 8; gkr[j] = false; dk[j] = q_ < NKQ; dblk[j] = (q_ < NKQ ? q_ : q_ - NKQ) * 1024;
        if (q_ < NKQ) { const int p_ = 64 * q_ + lane, key_ = p_ / (KC + 1), kc0_ = p_ - key_ * (KC + 1), kc_ = kc0_ == KC ? 0 : kc0_;
            if (MLA) { if (kc_ < 8) goff[j] = key_ * 1024 + hd * 128 + 8 * kc_; else { goff[j] = key_ * 32 + 8 * (kc_ - 8); gkr[j] = true; } } else goff[j] = key_ * NP + C_KA + hd * 64 + 8 * kc_; }
        else { const int p_ = 64 * (q_ - NKQ) + lane, dh_ = p_ >> 8, key_ = (p_ >> 2) & 63, vc_ = dh_ * 4 + (p_ & 3);
            goff[j] = MLA ? key_ * 1024 + hd * 128 + 64 + 8 * vc_ : key_ * NP + C_VA + hd * 64 + 8 * vc_; } }
#define AT_ISSUE(t, slot) do { const int row0_ = tile_row0(t); const bf16* bm_ = MLA ? KVB + (size_t)row0_ * 1024 : PROJ + (size_t)row0_ * NP; const bf16* br_ = KR + (size_t)row0_ * 32; \
        _Pragma("unroll") for (int j = 0; j < 3; ++j) { const bf16* g_ = ((MLA && gkr[j]) ? br_ : bm_) + goff[j]; \
            LAS unsigned char* d_ = lds + (dk[j] ? AT_K0 + (slot) * AT_KBUF : AT_V0 + (slot) * AT_VBUF) + dblk[j]; \
            __builtin_amdgcn_global_load_lds((const unsigned*)g_, (LAS unsigned*)d_, 16, 0, 0); } } while (0)
    constexpr int KSR = (MODE == 0) ? 4 : KS;
    bf16x8 qf[QT][KSR];
    LAS unsigned char* qrl = lds + AT_QR + w * 4096 + lane * 16;
#pragma unroll
    for (int qt = 0; qt < QT; ++qt) { const int qrow = qrow0 + 32 * qt;
        const bf16* qp = MLA ? QB + (size_t)qrow * 768 + hd * 96 : PROJ + (size_t)qrow * NP + C_QA + hd * 64;
#pragma unroll
        for (int ks = 0; ks < KSR; ++ks) qf[qt][ks] = *(const bf16x8*)(qp + 16 * ks + 8 * hh);
        if (MODE == 0) {
            const float* tb = TAB + (size_t)(qrow & 2047) * 32;
#pragma unroll
            for (int g = 0; g < 2; ++g) { const v4u own = *(const v4u*)(qp + 16 * (4 + g) + 8 * hh); v4u oth; oth.x = xshfl_u<32>(own.x); oth.y = xshfl_u<32>(own.y); oth.z = xshfl_u<32>(own.z); oth.w = xshfl_u<32>(own.w);
                const f32x4 c0 = *(const f32x4*)(tb + g * 16), c1 = *(const f32x4*)(tb + g * 16 + 4), s0 = *(const f32x4*)(tb + g * 16 + 8), s1 = *(const f32x4*)(tb + g * 16 + 12);
                const float sg = hh ? 1.f : -1.f; v4u nw;
                nw.x = pk2(bflo(own.x) * c0[0] + sg * bflo(oth.x) * s0[0], bfhi(own.x) * c0[1] + sg * bfhi(oth.x) * s0[1]); nw.y = pk2(bflo(own.y) * c0[2] + sg * bflo(oth.y) * s0[2], bfhi(own.y) * c0[3] + sg * bfhi(oth.y) * s0[3]);
                nw.z = pk2(bflo(own.z) * c1[0] + sg * bflo(oth.z) * s1[0], bfhi(own.z) * c1[1] + sg * bfhi(oth.z) * s1[1]); nw.w = pk2(bflo(own.w) * c1[2] + sg * bflo(oth.w) * s1[2], bfhi(own.w) * c1[3] + sg * bfhi(oth.w) * s1[3]);
                *(LAS v4u*)(qrl + (qt * 2 + g) * 1024) = nw; }
        } }
    if (MODE == 2) {
        LAS float* rt = (LAS float*)(lds + AT_RPB); const float* rpb = C.in[I_RPB] + ((size_t)l * 8 + hd) * 15 * 31;
        for (int i = tid; i < 15 * 128; i += NTHREADS) { const int dr = i >> 7, dc = (i & 127) - 64; rt[i] = (dc >= -15 && dc <= 15) ? rpb[dr * 31 + dc + 15] * 1.4426950408889634f : 0.f; }
        asm volatile("s_waitcnt vmcnt(0) lgkmcnt(0)" ::: "memory");
    }
    constexpr float C2 = (MLA ? 0.10206207261596577f : 0.125f) * 1.4426950408889634f;
    f32x16 o[QT][2]; float m_[QT], l_[QT];
#pragma unroll
    for (int qt = 0; qt < QT; ++qt) { m_[qt] = -1e30f; l_[qt] = 0.f;
#pragma unroll
        for (int i = 0; i < 16; ++i) { o[qt][0][i] = 0.f; o[qt][1][i] = 0.f; } }
    const int rs_w = min(max(gi - 4, 0), 24);
    const int kroff = r * RS + hh * 16;
    const int vroff = ((lane >> 4) & 1) * 32 + ((lane & 15) >> 2) * 64 + (lane & 3) * 8 + hh * 4 * 64;
    AT_ISSUE(0, 0); AT_ISSUE(1, 1);
    int buf = 0, nbuf = 2;
    for (int t = 0; t < T; ++t) {
        if (t + 1 < T) asm volatile("s_waitcnt vmcnt(3)" ::: "memory"); else asm volatile("s_waitcnt vmcnt(0)" ::: "memory");
        __builtin_amdgcn_s_barrier(); asm volatile("" ::: "memory");
        if (t + 2 < T) AT_ISSUE(t + 2, nbuf);
        bool active = true; int kr = 0;
        if (MODE == 2 && t < NB) { kr = rs_min + t; active = (kr >= rs_w) && (kr < rs_w + 8); }
        if (active) {
            const LAS unsigned char* kb = lds + AT_K0 + buf * AT_KBUF + kroff; const LAS unsigned char* vb = lds + AT_V0 + buf * AT_VBUF + vroff;
            const bool band = (MODE == 2) && (t < NB);
#pragma unroll
            for (int kt = 0; kt < 2; ++kt) {
                if constexpr (QT == 2) { if (!band) {
                    const LAS unsigned char* kbt = kb + kt * 32 * RS;
                    auto qfrag = [&](int qt, int ks) -> bf16x8 { if (ks < KSR) return qf[qt][ks < KSR ? ks : 0]; return *(const LAS bf16x8*)(qrl + (qt * 2 + (ks - 4)) * 1024); };
                    auto softmax_nb = [&](f32x16& sv, int qt, bf16x8 (&pfo)[2], float& alpha) {
                        float mx = -1e30f, ps = 0.f;
#pragma unroll
                        for (int i = 0; i < 16; ++i) mx = fmaxf(mx, sv[i]);
                        mx = pair32_max(mx) * C2;
                        const float mn = fmaxf(m_[qt], mx); alpha = __builtin_amdgcn_exp2f(m_[qt] - mn); m_[qt] = mn;
#pragma unroll
                        for (int sx = 0; sx < 2; ++sx) { unsigned a[4];
#pragma unroll
                            for (int jj = 0; jj < 4; ++jj) { const int i = 8 * sx + 2 * jj;
                                const float p0 = __builtin_amdgcn_exp2f(fmaf(sv[i], C2, -mn)), p1 = __builtin_amdgcn_exp2f(fmaf(sv[i + 1], C2, -mn));
                                ps += p0 + p1; a[jj] = pk2(p0, p1); }
                            pfo[sx] = __builtin_bit_cast(bf16x8, (v4u){a[0], a[1], a[2], a[3]}); }
                        l_[qt] = l_[qt] * alpha + ps; };
                    f32x16 sA, sB;
#pragma unroll
                    for (int i = 0; i < 16; ++i) { sA[i] = 0.f; sB[i] = 0.f; }
                    bf16x8 kfr[KS];
#pragma unroll
                    for (int ks = 0; ks < KS; ++ks) { kfr[ks & 3] = *(const LAS bf16x8*)(kbt + ks * 32); sA = MFMA32(kfr[ks & 3], qfrag(0, ks), sA); }
                    __builtin_amdgcn_sched_barrier(0);
                    bf16x8 pfA[2], pfB[2]; float alA, alB;
                    bf16x8 kq[KS]; bf16x8 qq[KS];
#pragma unroll
                    for (int ks = 0; ks < KS; ++ks) { kq[ks] = *(const LAS bf16x8*)(kbt + ks * 32); qq[ks] = qfrag(1, ks); }
                    __builtin_amdgcn_sched_barrier(0);
#pragma unroll
                    for (int ks = 0; ks < KS; ++ks) sB = MFMA32(kq[ks], qq[ks], sB);
                    softmax_nb(sA, 0, pfA, alA);
#pragma unroll
                    for (int g = 0; g < KS; ++g) { __builtin_amdgcn_sched_group_barrier(0x008, 1, 0); __builtin_amdgcn_sched_group_barrier(0x002, 14, 0); }
                    __builtin_amdgcn_sched_barrier(0);
                    if (!__all(alA == 1.f)) {
#pragma unroll
                        for (int i = 0; i < 16; ++i) { o[0][0][i] *= alA; o[0][1][i] *= alA; } }
                    bf16x8 va[2], vc[2];
#pragma unroll
                    for (int sx = 0; sx < 2; ++sx) { const int rowb = (32 * kt + 16 * sx) * 64;
                        const v4i16 a00 = __builtin_amdgcn_ds_read_tr16_b64_v4i16((LAS v4i16*)(vb + rowb)), a01 = __builtin_amdgcn_ds_read_tr16_b64_v4i16((LAS v4i16*)(vb + rowb + 8 * 64));
                        const v4i16 a10 = __builtin_amdgcn_ds_read_tr16_b64_v4i16((LAS v4i16*)(vb + 4096 + rowb)), a11 = __builtin_amdgcn_ds_read_tr16_b64_v4i16((LAS v4i16*)(vb + 4096 + rowb + 8 * 64));
                        va[sx] = __builtin_shufflevector(a00, a01, 0, 1, 2, 3, 4, 5, 6, 7); vc[sx] = __builtin_shufflevector(a10, a11, 0, 1, 2, 3, 4, 5, 6, 7); }
                    __builtin_amdgcn_sched_barrier(0);
#pragma unroll
                    for (int sx = 0; sx < 2; ++sx) { o[0][0] = MFMA32(va[sx], pfA[sx], o[0][0]); o[0][1] = MFMA32(vc[sx], pfA[sx], o[0][1]); }
                    softmax_nb(sB, 1, pfB, alB);
#pragma unroll
                    for (int g = 0; g < 4; ++g) { __builtin_amdgcn_sched_group_barrier(0x008, 1, 0); __builtin_amdgcn_sched_group_barrier(0x002, 20, 0); }
                    __builtin_amdgcn_sched_barrier(0);
                    if (!__all(alB == 1.f)) {
#pragma unroll
                        for (int i = 0; i < 16; ++i) { o[1][0][i] *= alB; o[1][1][i] *= alB; } }
#pragma unroll
                    for (int sx = 0; sx < 2; ++sx) { o[1][0] = MFMA32(va[sx], pfB[sx], o[1][0]); o[1][1] = MFMA32(vc[sx], pfB[sx], o[1][1]); }
                    continue;
                } }
                f32x16 sc[QT];
#pragma unroll
                for (int qt = 0; qt < QT; ++qt)
#pragma unroll
                    for (int i = 0; i < 16; ++i) sc[qt][i] = 0.f;
#pragma unroll
                for (int ks = 0; ks < KS; ++ks) { const bf16x8 ka = *(const LAS bf16x8*)(kb + kt * 32 * RS + ks * 32);
#pragma unroll
                    for (int qt = 0; qt < QT; ++qt) { bf16x8 qb_; if (ks < KSR) qb_ = qf[qt][ks < KSR ? ks : 0]; else qb_ = *(const LAS bf16x8*)(qrl + (qt * 2 + (ks - 4)) * 1024);
                        sc[qt] = MFMA32(ka, qb_, sc[qt]); } }
                bf16x8 pf[QT][2];
#pragma unroll
                for (int qt = 0; qt < QT; ++qt) {
                    f32x16& s0 = sc[qt]; float mx = -1e30f, ps = 0.f, alpha;
                    if ((MODE == 2) && band) {
                        const bool part = qt != kt;
                        const int ilo = part ? (qt == 0 ? 0 : 12) : 0, ihi = part ? ilo + 4 : 16, sxv = qt == 0 ? 0 : 1;
                        const int ccol = 32 * qt + r; int cs = min(max(ccol - 8, 0), 48); asm volatile("" : "+v"(cs));
                        const LAS float* rt = (const LAS float*)(lds + AT_RPB) + (kr - gi + 7) * 128 + 64 - ccol + 32 * kt;
#pragma unroll
                        for (int i = 0; i < 16; ++i) if (i >= ilo && i < ihi) { const int k0 = 32 * kt + (i & 3) + 8 * (i >> 2) + 4 * hh; const bool v0 = (k0 >= cs) && (k0 < cs + 16);
                            s0[i] = v0 ? s0[i] * C2 + rt[(i & 3) + 8 * (i >> 2) + 4 * hh] : -1e30f; mx = fmaxf(mx, s0[i]); }
                        mx = pair32_max(mx);
                        const float mn = fmaxf(m_[qt], mx); alpha = __builtin_amdgcn_exp2f(m_[qt] - mn); m_[qt] = mn;
#pragma unroll
                        for (int sx = 0; sx < 2; ++sx) { if (part && sx != sxv) continue;
                            unsigned a[4];
#pragma unroll
                            for (int jj = 0; jj < 4; ++jj) { const int i = 8 * sx + 2 * jj;
                                if (!(i >= ilo && i < ihi)) { a[jj] = 0u; continue; }
                                float p0 = __builtin_amdgcn_exp2f(s0[i] - mn), p1 = __builtin_amdgcn_exp2f(s0[i + 1] - mn);
                                p0 = s0[i] > -1e29f ? p0 : 0.f; p1 = s0[i + 1] > -1e29f ? p1 : 0.f;
                                ps += p0 + p1; a[jj] = pk2(p0, p1); }
                            pf[qt][sx] = __builtin_bit_cast(bf16x8, (v4u){a[0], a[1], a[2], a[3]}); }
                    } else {
#pragma unroll
                        for (int i = 0; i < 16; ++i) mx = fmaxf(mx, s0[i]);
                        mx = pair32_max(mx) * C2;
                        const float mn = fmaxf(m_[qt], mx); alpha = __builtin_amdgcn_exp2f(m_[qt] - mn); m_[qt] = mn;
#pragma unroll
                        for (int sx = 0; sx < 2; ++sx) { unsigned a[4];
#pragma unroll
                            for (int jj = 0; jj < 4; ++jj) { const int i = 8 * sx + 2 * jj;
                                const float p0 = __builtin_amdgcn_exp2f(fmaf(s0[i], C2, -mn)), p1 = __builtin_amdgcn_exp2f(fmaf(s0[i + 1], C2, -mn));
                                ps += p0 + p1; a[jj] = pk2(p0, p1); }
                            pf[qt][sx] = __builtin_bit_cast(bf16x8, (v4u){a[0], a[1], a[2], a[3]}); }
                    }
                    l_[qt] = l_[qt] * alpha + ps;
                    if (!__all(alpha == 1.f)) {
#pragma unroll
                        for (int i = 0; i < 16; ++i) { o[qt][0][i] *= alpha; o[qt][1][i] *= alpha; } }
                }
#pragma unroll
                for (int sx = 0; sx < 2; ++sx) {
                    const int rowb = (32 * kt + 16 * sx) * 64;
                    const v4i16 a00 = __builtin_amdgcn_ds_read_tr16_b64_v4i16((LAS v4i16*)(vb + rowb)), a01 = __builtin_amdgcn_ds_read_tr16_b64_v4i16((LAS v4i16*)(vb + rowb + 8 * 64));
                    const v4i16 a10 = __builtin_amdgcn_ds_read_tr16_b64_v4i16((LAS v4i16*)(vb + 4096 + rowb)), a11 = __builtin_amdgcn_ds_read_tr16_b64_v4i16((LAS v4i16*)(vb + 4096 + rowb + 8 * 64));
                    const bf16x8 va = __builtin_shufflevector(a00, a01, 0, 1, 2, 3, 4, 5, 6, 7), vc = __builtin_shufflevector(a10, a11, 0, 1, 2, 3, 4, 5, 6, 7);
#pragma unroll
                    for (int qt = 0; qt < QT; ++qt) { if ((MODE == 2) && band && (qt != kt) && sx != (qt == 0 ? 0 : 1)) continue;
                        o[qt][0] = MFMA32(va, pf[qt][sx], o[qt][0]); o[qt][1] = MFMA32(vc, pf[qt][sx], o[qt][1]); } }
            }
        }
        buf = buf == 2 ? 0 : buf + 1; nbuf = nbuf == 2 ? 0 : nbuf + 1;
    }
#pragma unroll
    for (int qt = 0; qt < QT; ++qt) {
        const float lt = pair32_sum(l_[qt]), inv = 1.f / lt;
        bf16* op = Yo + (size_t)(qrow0 + 32 * qt) * 512 + hd * 64 + 4 * hh;
#pragma unroll
        for (int g4 = 0; g4 < 4; ++g4) { v2u w0, w1; w0.x = pk2(o[qt][0][4 * g4] * inv, o[qt][0][4 * g4 + 1] * inv); w0.y = pk2(o[qt][0][4 * g4 + 2] * inv, o[qt][0][4 * g4 + 3] * inv);
            w1.x = pk2(o[qt][1][4 * g4] * inv, o[qt][1][4 * g4 + 1] * inv); w1.y = pk2(o[qt][1][4 * g4 + 2] * inv, o[qt][1][4 * g4 + 3] * inv);
            *(v2u*)(op + 8 * g4) = w0; *(v2u*)(op + 32 + 8 * g4) = w1; } }
    __syncthreads();
#undef AT_ISSUE
}
__device__ __forceinline__ void phase_attn(const Ctx& C, int l) {
    for (int u = C.bid; u < 512; u += C.G) attn_unit<0>(C, l, u);
    for (int u = C.bid; u < 512; u += C.G) attn_unit<2>(C, l, u);
    if (l < NL - 1) for (int u = C.bid; u < 256; u += C.G) { if (u < 128) attn_unit<1>(C, l, u); else attn_unit<3>(C, l, u - 128); }
}

__device__ __forceinline__ float reduce16(float (&v)[16], int lane) {
#pragma unroll
    for (int i = 0; i < 8; ++i) { const bool hi = lane & 32; const float keep = hi ? v[i + 8] : v[i], send = hi ? v[i] : v[i + 8]; v[i] = keep + xshfl<32>(send); }
#pragma unroll
    for (int i = 0; i < 4; ++i) { const bool hi = lane & 16; const float keep = hi ? v[i + 4] : v[i], send = hi ? v[i] : v[i + 4]; v[i] = keep + xshfl<16>(send); }
#pragma unroll
    for (int i = 0; i < 2; ++i) { const bool hi = lane & 8; const float keep = hi ? v[i + 2] : v[i], send = hi ? v[i] : v[i + 2]; v[i] = keep + xshfl<8>(send); }
    { const bool hi = lane & 4; const float keep = hi ? v[1] : v[0], send = hi ? v[0] : v[1]; v[0] = keep + xshfl<4>(send); }
    v[0] += xshfl<2>(v[0]); v[0] += xshfl<1>(v[0]);
    return v[0];
}
__device__ __forceinline__ void phase_ln1(const Ctx& C, int l) {
    int lane = C.lane; OPAQUE(lane); const int gw = C.bid * NWAVES + C.wave, NGW = C.G * NWAVES;
    LAS float* Wr = (LAS float*)C.lds;
    const float* wr = C.in[I_WROUTER] + (size_t)l * 1024 * 16;
    for (int idx = C.tid; idx < 16384; idx += NTHREADS) { const int c = idx >> 4, e = idx & 15; Wr[e * 1024 + c] = wr[idx]; }
    __syncthreads();
    const bf16* Yb = WSP(bf16, WS_Y); float* X = WSP(float, WS_X); bf16* H2 = WSP(bf16, WS_HB); float* AFF = WSP(float, WS_AFF);
    const float* MODS = WSP(float, WS_MODS) + (size_t)l * 17 * 6144;
    const float* lg = C.in[I_LN1G] + l * 1024; const float* lb = C.in[I_LN1B] + l * 1024;
    const int myexp = ((lane >> 5) & 1) * 8 + ((lane >> 4) & 1) * 4 + ((lane >> 3) & 1) * 2 + ((lane >> 2) & 1);
    const int nrp = (l == NL - 1 ? ML : MT) / 2;
    f32x4 nx[2][4]; v4u ny[2][2];
#define LN1_LOAD(rp_) do { const int r_ = 2 * (rp_); _Pragma("unroll") for (int j = 0; j < 2; ++j) { const int c = 8 * (lane + 64 * j); \
        nx[0][2 * j] = *(const f32x4*)(X + (size_t)r_ * DM + c); nx[0][2 * j + 1] = *(const f32x4*)(X + (size_t)r_ * DM + c + 4); nx[1][2 * j] = *(const f32x4*)(X + (size_t)(r_ + 1) * DM + c); nx[1][2 * j + 1] = *(const f32x4*)(X + (size_t)(r_ + 1) * DM + c + 4); \
        ny[0][j] = *(const v4u*)(Yb + (size_t)r_ * DM + c); ny[1][j] = *(const v4u*)(Yb + (size_t)(r_ + 1) * DM + c); } } while (0)
    if (gw < nrp) LN1_LOAD(gw);
    for (int rp = gw; rp < nrp; rp += NGW) {
        const int row = 2 * rp; const int mr = row < ML ? (row >> 11) : 16; const float* md = MODS + (size_t)mr * 6144;
        f32x4 v[2][4]; float sa = 0.f, sb = 0.f;
#pragma unroll
        for (int j = 0; j < 2; ++j) { const int c = 8 * (lane + 64 * j); const f32x4 g1a = *(const f32x4*)(md + 2048 + c), g1b = *(const f32x4*)(md + 2048 + c + 4);
            v[0][2 * j] = nx[0][2 * j] * DN_ALPHA + g1a * pg8::unpack4((v2u){ny[0][j].x, ny[0][j].y}); v[0][2 * j + 1] = nx[0][2 * j + 1] * DN_ALPHA + g1b * pg8::unpack4((v2u){ny[0][j].z, ny[0][j].w});
            v[1][2 * j] = nx[1][2 * j] * DN_ALPHA + g1a * pg8::unpack4((v2u){ny[1][j].x, ny[1][j].y}); v[1][2 * j + 1] = nx[1][2 * j + 1] * DN_ALPHA + g1b * pg8::unpack4((v2u){ny[1][j].z, ny[1][j].w}); }
        if (rp + NGW < nrp) LN1_LOAD(rp + NGW);
#pragma unroll
        for (int j = 0; j < 4; ++j) { sa += (v[0][j][0] + v[0][j][1]) + (v[0][j][2] + v[0][j][3]); sb += (v[1][j][0] + v[1][j][1]) + (v[1][j][2] + v[1][j][3]); }
        const float mean0 = wave_sum(sa) * (1.f / 1024.f), mean1 = wave_sum(sb) * (1.f / 1024.f); float qa = 0.f, qb = 0.f;
#pragma unroll
        for (int j = 0; j < 4; ++j) { v[0][j] = v[0][j] - mean0; v[1][j] = v[1][j] - mean1;
            qa += (v[0][j][0] * v[0][j][0] + v[0][j][1] * v[0][j][1]) + (v[0][j][2] * v[0][j][2] + v[0][j][3] * v[0][j][3]);
            qb += (v[1][j][0] * v[1][j][0] + v[1][j][1] * v[1][j][1]) + (v[1][j][2] * v[1][j][2] + v[1][j][3] * v[1][j][3]); }
        const float rstd0 = 1.f / sqrtf(wave_sum(qa) * (1.f / 1024.f) + LN_EPS), rstd1 = 1.f / sqrtf(wave_sum(qb) * (1.f / 1024.f) + LN_EPS);
        float lg0[16], lg1[16];
#pragma unroll
        for (int e = 0; e < 16; ++e) { lg0[e] = 0.f; lg1[e] = 0.f; }
#pragma unroll
        for (int j = 0; j < 2; ++j) { const int c0 = 8 * (lane + 64 * j); f32x4 ha[2], hb[2];
#pragma unroll
            for (int h = 0; h < 2; ++h) { const int c = c0 + 4 * h;
                const f32x4 gg = *(const f32x4*)(lg + c), bb = *(const f32x4*)(lb + c), scl = *(const f32x4*)(md + 4096 + c) + 1.f, shf = *(const f32x4*)(md + 3072 + c);
                const f32x4 xa = v[0][2 * j + h] * rstd0 * gg + bb, xb = v[1][2 * j + h] * rstd1 * gg + bb;
                *(f32x4*)(X + (size_t)row * DM + c) = xa; *(f32x4*)(X + (size_t)(row + 1) * DM + c) = xb;
                ha[h] = xa * scl + shf; hb[h] = xb * scl + shf; }
            *(v4u*)(H2 + (size_t)row * DM + c0) = pg8::pack8(ha[0], ha[1]); *(v4u*)(H2 + (size_t)(row + 1) * DM + c0) = pg8::pack8(hb[0], hb[1]);
#pragma unroll
            for (int h = 0; h < 2; ++h) {
#pragma unroll
                for (int e = 0; e < 16; ++e) { const f32x4 wv = *(const LAS f32x4*)(Wr + e * 1024 + c0 + 4 * h);
                    lg0[e] += (ha[h][0] * wv[0] + ha[h][1] * wv[1]) + (ha[h][2] * wv[2] + ha[h][3] * wv[3]); lg1[e] += (hb[h][0] * wv[0] + hb[h][1] * wv[1]) + (hb[h][2] * wv[2] + hb[h][3] * wv[3]); }
                asm volatile("" ::: "memory"); } }
        const float t0 = reduce16(lg0, lane), t1 = reduce16(lg1, lane);
        float m0 = t0, m1 = t1;
        m0 = fmaxf(m0, xshfl<4>(m0)); m1 = fmaxf(m1, xshfl<4>(m1)); m0 = fmaxf(m0, xshfl<8>(m0)); m1 = fmaxf(m1, xshfl<8>(m1)); m0 = fmaxf(m0, xshfl<16>(m0)); m1 = fmaxf(m1, xshfl<16>(m1)); m0 = pair32_max(m0); m1 = pair32_max(m1);
        const float p0 = expf(t0 - m0), p1 = expf(t1 - m1); float d0 = p0, d1 = p1;
        d0 += xshfl<4>(d0); d1 += xshfl<4>(d1); d0 += xshfl<8>(d0); d1 += xshfl<8>(d1); d0 += xshfl<16>(d0); d1 += xshfl<16>(d1); d0 = pair32_sum(d0); d1 = pair32_sum(d1);
        if ((lane & 3) == 0) { AFF[(size_t)row * 16 + myexp] = p0 / d0; AFF[(size_t)(row + 1) * 16 + myexp] = p1 / d1; }
    }
#undef LN1_LOAD
}

__device__ __forceinline__ void phase_topk(const Ctx& Cc, int l) {
    Ctx C = Cc; OPAQUE(C.tid);
    LAS unsigned long long* a = (LAS unsigned long long*)C.lds;
    const float* AFF = WSP(float, WS_AFF); int* SEL = WSP(int, WS_SEL); int* IDX = WSP(int, WS_IDX);
    const int nitem = l == NL - 1 ? 256 : 512;
    for (int item = C.bid; item < nitem; item += C.G) {
        const bool lat = item < 256; const int it = lat ? item : item - 256, b = it >> 4, e = it & 15;
        const int N = lat ? 2048 : 256, cap = lat ? CAPL : CAPC, base = lat ? b * 2048 : ML + b * 256, slotbase = lat ? b * CAPL : NBATCH * CAPL + b * CAPC;
        for (int t = C.tid; t < N; t += NTHREADS) a[t] = ((unsigned long long)__float_as_uint(AFF[(size_t)(base + t) * 16 + e]) << 32) | (unsigned long long)(0xFFFFFFFFu - (unsigned)t);
        __syncthreads();
        for (int k = 2; k <= N; k <<= 1)
            for (int j = k >> 1; j > 0; j >>= 1) {
                for (int p = C.tid; p < N / 2; p += NTHREADS) {
                    const int i = ((p & ~(j - 1)) << 1) | (p & (j - 1)), ij = i | j;
                    const unsigned long long x = a[i], y = a[ij];
                    const bool desc = (i & k) == 0;
                    if (desc ? (x < y) : (x > y)) { a[i] = y; a[ij] = x; }
                }
                __syncthreads();
            }
        for (int p = C.tid; p < N; p += NTHREADS) { const int tok = (int)(0xFFFFFFFFu - (unsigned)a[p]);
            SEL[(size_t)(base + tok) * 16 + e] = p < cap ? p : -1;
            if (p < cap) IDX[e * ROWS_E + slotbase + p] = base + tok; }
        __syncthreads();
    }
}

__device__ __forceinline__ void phase_gather(const Ctx& C) {
    int lane = C.lane; OPAQUE(lane); const int gw = C.bid * NWAVES + C.wave, NGW = C.G * NWAVES;
    const int* IDX = WSP(int, WS_IDX); const bf16* H2 = WSP(bf16, WS_HB); bf16* XG = WSP(bf16, WS_XG);
    for (int r = gw; r < MG; r += NGW) { const int src = IDX[r]; const v4u* s = (const v4u*)(H2 + (size_t)src * DM); v4u* d = (v4u*)(XG + (size_t)r * DM);
        const v4u a = s[lane], b = s[lane + 64]; d[lane] = a; d[lane + 64] = b; }
}

__device__ __forceinline__ void phase_combine(const Ctx& C, int l) {
    int lane = C.lane; OPAQUE(lane); const int gw = C.bid * NWAVES + C.wave, NGW = C.G * NWAVES;
    const bf16* Y = WSP(bf16, WS_Y); float* X = WSP(float, WS_X); bf16* H = WSP(bf16, WS_HB); const float* AFF = WSP(float, WS_AFF); const int* SEL = WSP(int, WS_SEL);
    const float* MODS = WSP(float, WS_MODS) + (size_t)l * 17 * 6144; const float* MODN = MODS + 17 * 6144;
    const float* lg = C.in[I_LN2G] + l * 1024; const float* lb = C.in[I_LN2B] + l * 1024;
    const int nrp = (l == NL - 1 ? ML : MT) / 2;
    f32x4 nxa[4], nxb[4]; int nsel = 0; float naff = 0.f;
#define CMB_LOAD(rp_) do { const int r_ = 2 * (rp_); nsel = SEL[(size_t)r_ * 16 + (lane & 31)]; naff = AFF[(size_t)r_ * 16 + (lane & 31)]; \
        _Pragma("unroll") for (int j = 0; j < 2; ++j) _Pragma("unroll") for (int h = 0; h < 2; ++h) { const int c = 8 * (lane + 64 * j) + 4 * h; nxa[2 * j + h] = *(const f32x4*)(X + (size_t)r_ * DM + c); nxb[2 * j + h] = *(const f32x4*)(X + (size_t)(r_ + 1) * DM + c); } } while (0)
    if (gw < nrp) CMB_LOAD(gw);
    for (int rp = gw; rp < nrp; rp += NGW) {
        const int row = 2 * rp; const bool lat = row < ML; const int mr = lat ? (row >> 11) : 16; const float* md = MODS + (size_t)mr * 6144;
        const int rb = lat ? (row >> 11) * CAPL : NBATCH * CAPL + ((row - ML) >> 8) * CAPC;
        const int selv = nsel; const float affv = naff;
        f32x4 xa[4], xb[4];
#pragma unroll
        for (int j = 0; j < 4; ++j) { xa[j] = nxa[j]; xb[j] = nxb[j]; }
        if (rp + NGW < nrp) CMB_LOAD(rp + NGW);
        unsigned long long bal = __ballot(selv >= 0);
        unsigned ma = (unsigned)(bal & 0xffffu), mb = (unsigned)((bal >> 16) & 0xffffu);
        f32x4 acca[4], accb[4];
#pragma unroll
        for (int j = 0; j < 4; ++j) { acca[j] = (f32x4){0.f, 0.f, 0.f, 0.f}; accb[j] = (f32x4){0.f, 0.f, 0.f, 0.f}; }
        while (ma | mb) {
            const int ea = ma ? __builtin_ctz(ma) : 0, eb = mb ? __builtin_ctz(mb) : 0;
            const int sa = __builtin_amdgcn_readlane(selv, ea), sb = __builtin_amdgcn_readlane(selv, 16 + eb); float fa = __uint_as_float(__builtin_amdgcn_readlane(__float_as_uint(affv), ea)), fb = __uint_as_float(__builtin_amdgcn_readlane(__float_as_uint(affv), 16 + eb));
            if (!ma) fa = 0.f; if (!mb) fb = 0.f;
            const bf16* ya = Y + ((size_t)ea * ROWS_E + rb + (ma ? sa : 0)) * DM; const bf16* yb = Y + ((size_t)eb * ROWS_E + rb + (mb ? sb : 0)) * DM;
            v4u wa[2], wb[2];
#pragma unroll
            for (int j = 0; j < 2; ++j) { wa[j] = *(const v4u*)(ya + 8 * (lane + 64 * j)); wb[j] = *(const v4u*)(yb + 8 * (lane + 64 * j)); }
#pragma unroll
            for (int j = 0; j < 2; ++j) { acca[2 * j] = acca[2 * j] + pg8::unpack4((v2u){wa[j].x, wa[j].y}) * fa; acca[2 * j + 1] = acca[2 * j + 1] + pg8::unpack4((v2u){wa[j].z, wa[j].w}) * fa;
                accb[2 * j] = accb[2 * j] + pg8::unpack4((v2u){wb[j].x, wb[j].y}) * fb; accb[2 * j + 1] = accb[2 * j + 1] + pg8::unpack4((v2u){wb[j].z, wb[j].w}) * fb; }
            ma &= ma - 1; mb &= mb - 1;
        }
        float sma = 0.f, smb = 0.f;
#pragma unroll
        for (int j = 0; j < 2; ++j)
#pragma unroll
            for (int h = 0; h < 2; ++h) { const int q = 2 * j + h; const f32x4 g2 = *(const f32x4*)(md + 5120 + 8 * (lane + 64 * j) + 4 * h); xa[q] = xa[q] * DN_ALPHA + g2 * acca[q]; xb[q] = xb[q] * DN_ALPHA + g2 * accb[q];
                sma += (xa[q][0] + xa[q][1]) + (xa[q][2] + xa[q][3]); smb += (xb[q][0] + xb[q][1]) + (xb[q][2] + xb[q][3]); }
        const float mean0 = wave_sum(sma) * (1.f / 1024.f), mean1 = wave_sum(smb) * (1.f / 1024.f); float qa = 0.f, qb = 0.f;
#pragma unroll
        for (int j = 0; j < 4; ++j) { xa[j] = xa[j] - mean0; xb[j] = xb[j] - mean1;
            qa += (xa[j][0] * xa[j][0] + xa[j][1] * xa[j][1]) + (xa[j][2] * xa[j][2] + xa[j][3] * xa[j][3]); qb += (xb[j][0] * xb[j][0] + xb[j][1] * xb[j][1]) + (xb[j][2] * xb[j][2] + xb[j][3] * xb[j][3]); }
        const float rstd0 = 1.f / sqrtf(wave_sum(qa) * (1.f / 1024.f) + LN_EPS), rstd1 = 1.f / sqrtf(wave_sum(qb) * (1.f / 1024.f) + LN_EPS);
#pragma unroll
        for (int j = 0; j < 2; ++j) { const int c0 = 8 * (lane + 64 * j); f32x4 ya[2], yb[2];
#pragma unroll
            for (int h = 0; h < 2; ++h) { const int c = c0 + 4 * h; const f32x4 gg = *(const f32x4*)(lg + c), bb = *(const f32x4*)(lb + c);
                ya[h] = xa[2 * j + h] * rstd0 * gg + bb; yb[h] = xb[2 * j + h] * rstd1 * gg + bb; }
            if (l < NL - 1) { const float* mn = MODN + (size_t)mr * 6144; f32x4 ha[2], hb[2];
#pragma unroll
                for (int h = 0; h < 2; ++h) { const int c = c0 + 4 * h; *(f32x4*)(X + (size_t)row * DM + c) = ya[h]; *(f32x4*)(X + (size_t)(row + 1) * DM + c) = yb[h];
                    const f32x4 scl = *(const f32x4*)(mn + 1024 + c) + 1.f, shf = *(const f32x4*)(mn + c); ha[h] = ya[h] * scl + shf; hb[h] = yb[h] * scl + shf; }
                *(v4u*)(H + (size_t)row * DM + c0) = pg8::pack8(ha[0], ha[1]); *(v4u*)(H + (size_t)(row + 1) * DM + c0) = pg8::pack8(hb[0], hb[1]); }
            else if (lat) {
#pragma unroll
                for (int h = 0; h < 2; ++h) { const int c = c0 + 4 * h; *(f32x4*)(C.out + (size_t)row * DM + c) = ya[h]; *(f32x4*)(C.out + (size_t)(row + 1) * DM + c) = yb[h]; } } }
    }
#undef CMB_LOAD
}

enum { PH_MODS = 0, PH_MOD0, PH_WIN, PH_PREP, PH_CONV, PH_UQ, PH_UKV, PH_ATTN, PH_MERGE, PH_WOUT, PH_LN1, PH_TOPK, PH_GATHER, PH_GU, PH_DOWN, PH_COMB, PH_COUNT };
template <int PH> __device__ __forceinline__ void run_phase(const Ctx& C, int l) {
    if constexpr (PH == PH_MODS) { phase_mods(C); __syncthreads(); conv_weights(C, 0, 0, 100, 0, C.G); }
    if constexpr (PH == PH_MOD0) { phase_mod0(C); }
    if constexpr (PH == PH_WIN) { pg8::ProbPlain P{WSP(bf16, WS_HB), WSW(bf16, WS_WIN, l), 1024, 1024, 1024}; pg8::EpiWin E{WSP(bf16, WS_R), WSP(bf16, WS_GT)};
        if (l == NL - 1) { pg8::OrderWinLast S; S.init(C.G, C.bid); pg8::gemm_phase(C.lds, P, S, E, C.wave); }
        else { pg8::Order<1> S; S.init(MT / 256, NIN / 256, C.G, C.bid); pg8::gemm_phase(C.lds, P, S, E, C.wave); }
        if (l < NL - 1) { const int rem = (MT / 256 * (NIN / 256)) % C.G; __syncthreads(); conv_weights(C, l + 1, 0, 20, rem, C.G - rem); } }
    if constexpr (PH == PH_PREP) { phase_prep(C, l); }
    if constexpr (PH == PH_CONV) { phase_conv(C, l); }
    if constexpr (PH == PH_UQ) { pg8::ProbUp2 P{WSP(bf16, WS_CQN), WSP(bf16, WS_CKVN), WSW(bf16, WS_WUQ, l), WSW(bf16, WS_WUKV, l), 256, 256, 256};
        pg8::OrderUp2 S; S.init((l == NL - 1 ? ML : MT) / 256, C.G, C.bid); pg8::EpiUp2 E{WSP(bf16, WS_QB), WSP(bf16, WS_KVB)}; pg8::gemm_phase(C.lds, P, S, E, C.wave); }
    if constexpr (PH == PH_ATTN) { phase_attn(C, l); }
    if constexpr (PH == PH_MERGE) { pg8::ProbSeg3 P{WSP(bf16, WS_YA), WSW(bf16, WS_WOA, l), 512, 512, 512, (size_t)(36 * MiB / 2), (size_t)(1 * MiB / 2)};
        pg8::Order<3> S; S.init((l == NL - 1 ? ML : MT) / 256, 4, C.G, C.bid); pg8::EpiMerge E{WSP(bf16, WS_GT), WSP(bf16, WS_HB)}; pg8::gemm_phase(C.lds, P, S, E, C.wave);
        if (l < NL - 1) { const int rem = (MT / 256 * 4) % C.G; __syncthreads(); conv_weights(C, l + 1, 20, 56, rem, C.G - rem); } }
    if constexpr (PH == PH_WOUT) { pg8::ProbPlain P{WSP(bf16, WS_HB), WSW(bf16, WS_WOUT, l), 1024, 1024, 1024}; pg8::Order<1> S; S.init((l == NL - 1 ? ML : MT) / 256, 4, C.G, C.bid);
        pg8::EpiBf16 E{WSP(bf16, WS_Y), 1024}; pg8::gemm_phase(C.lds, P, S, E, C.wave);
        if (l < NL - 1) { const int rem = (MT / 256 * 4) % C.G; __syncthreads(); conv_weights(C, l + 1, 56, 80, rem, C.G - rem); } }
    if constexpr (PH == PH_LN1) { phase_ln1(C, l); }
    if constexpr (PH == PH_TOPK) { phase_topk(C, l); }
    if constexpr (PH == PH_GATHER) { phase_gather(C); }
    if constexpr (PH == PH_GU) { pg8::OrderOrd S; S.o.init(l == NL - 1 ? 256 : 288, 8, C.G, C.bid, l == NL - 1 ? 16 : 0);
        LAS int* lidx = (LAS int*)(C.lds + LIDX_OFF); const int* IDXg = WSP(int, WS_IDX);
        { pg8::Unit uu; for (int i = 0; i < 10 && S.next(i, uu); ++i) if (C.tid < 256) lidx[i * 256 + C.tid] = IDXg[uu.pm * 256 + C.tid]; }
        __syncthreads();
        pg8::ProbMoEGather P{WSP(bf16, WS_HB), WSW(bf16, WS_WGU, l), lidx, 1024, 1024, 1024, 2048};
        pg8::EpiSwiGLU E{WSP(bf16, WS_HID)}; pg8::gemm_phase(C.lds, P, S, E, C.wave); }
    if constexpr (PH == PH_DOWN) { pg8::ProbMoE P{WSP(bf16, WS_HID), WSW(bf16, WS_WD, l), 1024, 1024, 1024, 1024}; pg8::Order<1> S; S.init(l == NL - 1 ? 256 : 288, 4, C.G, C.bid, l == NL - 1 ? 16 : 0);
        pg8::EpiBf16 E{WSP(bf16, WS_Y), 1024}; pg8::gemm_phase(C.lds, P, S, E, C.wave);
        if (l < NL - 1) { const int rem = (288 * 4) % C.G; __syncthreads(); conv_weights(C, l + 1, 80, 100, rem, C.G - rem); } }
    if constexpr (PH == PH_COMB) { phase_combine(C, l); }
}
template <int PH> __device__ __forceinline__ void call_phase(const Ctx& Cin, int l) { Ctx C = Cin; C.lane = lane_id(); OPAQUE(C.lane); asm volatile("" : "+s"(C.wave)); C.tid = C.wave * 64 + C.lane; asm volatile("" : "+s"(l)); asm volatile("" : "+s"(C.G)); asm volatile("" : "+s"(C.bid)); { unsigned long long w_ = (unsigned long long)C.ws; unsigned lo_ = (unsigned)w_, hi_ = (unsigned)(w_ >> 32); asm volatile("" : "+s"(lo_)); asm volatile("" : "+s"(hi_)); C.ws = (unsigned char*)(((unsigned long long)hi_ << 32) | lo_); } run_phase<PH>(C, l); }
__global__ void __launch_bounds__(NTHREADS, 2) mega_fwd(Args args) {
    extern __shared__ __attribute__((aligned(16))) unsigned char lds_raw[];
    Ctx C;
    C.lds = (LAS unsigned char*)lds_raw;
    C.tid = threadIdx.x; C.lane = C.tid & 63; C.wave = __builtin_amdgcn_readfirstlane(C.tid >> 6);
    C.G = gridDim.x; C.bid = blockIdx.x;
    C.in = args.in; C.ws = args.ws; C.out = args.out;
    volatile LAS unsigned* MISC = (volatile LAS unsigned*)(C.lds + MISC_OFF);
    for (int u = C.tid; u < (LDS_BYTES - LDSCTL_OFF) / 4; u += NTHREADS) ((LAS unsigned*)(C.lds + LDSCTL_OFF))[u] = 0u;
    __syncthreads();
    XcdBarrier bar = xcd_barrier_post((unsigned*)(C.ws + WS_CTL) + 4096, MISC + 8, C.wave);
    call_phase<PH_MODS>(C, 0); xcd_barrier(bar);
    call_phase<PH_MOD0>(C, 0); xcd_barrier(bar);
    for (int l = 0; l < NL; ++l) {
        call_phase<PH_WIN>(C, l); xcd_barrier(bar);
        call_phase<PH_PREP>(C, l); xcd_barrier(bar);
        call_phase<PH_CONV>(C, l); __syncthreads(); call_phase<PH_UQ>(C, l); xcd_barrier(bar);
        call_phase<PH_ATTN>(C, l); xcd_barrier(bar);
        call_phase<PH_MERGE>(C, l); xcd_barrier(bar);
        call_phase<PH_WOUT>(C, l); xcd_barrier(bar);
        call_phase<PH_LN1>(C, l); xcd_barrier(bar);
        call_phase<PH_TOPK>(C, l); xcd_barrier(bar);
        call_phase<PH_GU>(C, l); xcd_barrier(bar);
        call_phase<PH_DOWN>(C, l); xcd_barrier(bar);
        call_phase<PH_COMB>(C, l); if (l < NL - 1) xcd_barrier(bar);
    }
}

extern "C" void kernel_launch(void* const* d_in, const int* in_sizes, int n_in, void* d_out, int out_size, void* d_ws, size_t ws_size, hipStream_t stream) {
    static int grid = 0;
    if (grid == 0) {
        if (n_in != 28 || out_size != ML * DM || ws_size < WS_END) { fprintf(stderr, "kernel_launch: unexpected shapes: n_in %d out %d ws %zu (need %zu)\n", n_in, out_size, ws_size, (size_t)WS_END); grid = -1; return; }
        int dev = 0, cus = 0, per_cu = 0;
        if (hipGetDevice(&dev) != hipSuccess || hipDeviceGetAttribute(&cus, hipDeviceAttributeMultiprocessorCount, dev) != hipSuccess) { grid = -1; return; }
        if (hipFuncSetAttribute((const void*)mega_fwd, hipFuncAttributeMaxDynamicSharedMemorySize, LDS_BYTES) != hipSuccess) { fprintf(stderr, "kernel_launch: hipFuncSetAttribute failed\n"); grid = -1; return; }
        if (hipOccupancyMaxActiveBlocksPerMultiprocessor(&per_cu, (const void*)mega_fwd, NTHREADS, LDS_BYTES) != hipSuccess || per_cu < 1) { fprintf(stderr, "kernel_launch: occupancy query says %d\n", per_cu); grid = -1; return; }
        (void)hipGetLastError();
        grid = cus;
    }
    if (grid < 0) return;
    (void)hipMemsetAsync((char*)d_ws + WS_CTL, 0, CTL_ZERO_BYTES, stream);
    Args a{};
    for (int i = 0; i < 28; ++i) a.in[i] = (const float*)d_in[i];
    a.out = (float*)d_out; a.ws = (unsigned char*)d_ws;
    hipLaunchKernelGGL(mega_fwd, dim3(grid), dim3(NTHREADS), LDS_BYTES, stream, a);
}
```

```cpp
#include <hip/hip_runtime.h>
#include <cstdio>
#include <cstdint>
#include <utility>

#ifndef MK_ONE_LAUNCH
#define MK_ONE_LAUNCH 0
#endif

#define GAS __attribute__((address_space(1)))
#define LAS __attribute__((address_space(3)))
typedef unsigned short bf16;
typedef unsigned v4u __attribute__((ext_vector_type(4)));
typedef unsigned v2u __attribute__((ext_vector_type(2)));
typedef float f32x4 __attribute__((ext_vector_type(4)));
typedef float f32x2 __attribute__((ext_vector_type(2)));
typedef short bf16x8 __attribute__((ext_vector_type(8)));

constexpr int NL = 4, DM = 1024, NBATCH = 16, SQ = 2048, CL = 256;
constexpr int ML = NBATCH * SQ, MC = NBATCH * CL, MT = ML + MC;
constexpr int NP = 6144;
constexpr int C_QA = 0, C_KA = 512, C_VA = 1024, C_CQ = 1536, C_CKV = 1792, C_KR = 1920, C_CIN = 2048, C_GT = 3072;
constexpr int NE = 16, CAPL = 256, CAPC = 32, ROWS_E = NBATCH * CAPL + NBATCH * CAPC, MG = NE * ROWS_E;
constexpr float LN_EPS = 1e-5f, RMS_EPS = 1e-6f, DN_ALPHA = 1.681792830507429f;
constexpr int NWAVES = 8, NTHREADS = 512;

constexpr size_t MiB = 1u << 20;
constexpr size_t WS_CTL = 0, CTL_ZERO_BYTES = 1 * MiB;
constexpr size_t WS_MODS = 1 * MiB;
constexpr size_t WS_TAB = 3 * MiB;
constexpr size_t WS_AFF = 4 * MiB;
constexpr size_t WS_SEL = 7 * MiB;
constexpr size_t WS_IDX = 10 * MiB;
constexpr size_t WS_KR = 11 * MiB;
constexpr size_t WS_WIN = 14 * MiB;
constexpr size_t WS_WUQ = 26 * MiB;
constexpr size_t WS_WUKV = 26 * MiB + 512 * 1024;
constexpr size_t WS_WOA = 27 * MiB, WS_WOB = 28 * MiB, WS_WPW2 = 29 * MiB;
constexpr size_t WS_WOUT = 30 * MiB;
constexpr size_t WS_WGU = 32 * MiB;
constexpr size_t WS_WD = 96 * MiB;
constexpr size_t WS_X = 128 * MiB;
constexpr size_t WS_HB = 272 * MiB;
constexpr size_t WS_QB = 344 * MiB;
constexpr size_t WS_KVB = 398 * MiB;
constexpr size_t WS_U = 542 * MiB;
constexpr size_t WS_YA = 470 * MiB;
constexpr size_t WS_YB = 506 * MiB;
constexpr size_t WS_CQN = WS_YB, WS_CKVN = WS_YB + 18 * MiB;
constexpr size_t WS_R = 578 * MiB;
constexpr size_t WS_XG = WS_R, WS_HID = WS_R + 144 * MiB, WS_Y = WS_R + 288 * MiB;
constexpr size_t WS_WSET = 996 * MiB;
constexpr size_t WS_END = WS_R + 432 * MiB + 114 * MiB;

constexpr int RING_BYTES = 131072, LDSCTL_OFF = RING_BYTES, MISC_OFF = LDSCTL_OFF + 320, LIDX_OFF = RING_BYTES + 1024, LDS_BYTES = 147456;

#define LDS_WAIT() asm volatile("s_waitcnt lgkmcnt(0)" ::: "memory")
#define VM_WAIT() asm volatile("s_waitcnt vmcnt(0)" ::: "memory")
__device__ __forceinline__ int lane_id() { int r; asm volatile("v_mbcnt_lo_u32_b32 %0, -1, 0\n\tv_mbcnt_hi_u32_b32 %0, -1, %0" : "=v"(r)); return r; }
__device__ __forceinline__ unsigned f2bf(float f) { unsigned u = __builtin_bit_cast(unsigned, f); return (u + 0x7fffu + ((u >> 16) & 1u)) >> 16; }
__device__ __forceinline__ unsigned pk2(float lo, float hi) { unsigned r; asm("v_cvt_pk_bf16_f32 %0, %1, %2" : "=v"(r) : "v"(lo), "v"(hi)); return r; }
__device__ __forceinline__ float bflo(unsigned w) { return __uint_as_float(w << 16); }
__device__ __forceinline__ float bfhi(unsigned w) { return __uint_as_float(w & 0xffff0000u); }
__device__ __forceinline__ float bf2f(bf16 v) { return __uint_as_float(((unsigned)v) << 16); }
template <int O> __device__ __forceinline__ unsigned xshfl_u(unsigned v) {
    if constexpr (O == 32) { const auto t = __builtin_amdgcn_permlane32_swap(v, v, false, false); return (lane_id() & 32) ? t[0] : t[1]; }
    else return (unsigned)__builtin_amdgcn_ds_swizzle((int)v, (O << 10) | 0x1f);
}
template <int O> __device__ __forceinline__ float xshfl(float v) { return __uint_as_float(xshfl_u<O>(__float_as_uint(v))); }
template <int CTRL> __device__ __forceinline__ float dppf(float x) { return __builtin_bit_cast(float, __builtin_amdgcn_mov_dpp(__builtin_bit_cast(int, x), CTRL, 0xf, 0xf, true)); }
__device__ __forceinline__ float wave_sum(float x) {
    x += dppf<0xB1>(x); x += dppf<0x4E>(x); x += dppf<0x141>(x); x += dppf<0x128>(x);
    const auto s = __builtin_amdgcn_permlane16_swap(__float_as_uint(x), __float_as_uint(x), false, false); x = __uint_as_float(s[0]) + __uint_as_float(s[1]);
    const auto t = __builtin_amdgcn_permlane32_swap(__float_as_uint(x), __float_as_uint(x), false, false); return __uint_as_float(t[0]) + __uint_as_float(t[1]);
}
__device__ __forceinline__ float pair32_max(float x) { const auto t = __builtin_amdgcn_permlane32_swap(__float_as_uint(x), __float_as_uint(x), false, false); return fmaxf(__uint_as_float(t[0]), __uint_as_float(t[1])); }
__device__ __forceinline__ float pair32_sum(float x) { const auto t = __builtin_amdgcn_permlane32_swap(__float_as_uint(x), __float_as_uint(x), false, false); return __uint_as_float(t[0]) + __uint_as_float(t[1]); }
__device__ __forceinline__ float sigmoidf_(float x) { return 1.f / (1.f + __expf(-x)); }

namespace pg8 {
constexpr int BM = 256, BK = 64, HALF = 128, HTB = HALF * BK * 2, STAGE_BYTES = 8 * HTB, NXCD = 8, WGM = 8;
__host__ __device__ __forceinline__ int lds_byte(int r, int c) { const int st = (r >> 4) * 2 + (c >> 5), rr = r & 15, cc = c & 31, ob = rr * 64 + cc * 2; return st * 1024 + (ob ^ (((ob >> 9) & 1) << 5)); }
__host__ __device__ __forceinline__ void stage_rc(int b, int& R, int& C) { const int st = b / 1024, sb = b % 1024, swz = sb ^ (((sb >> 9) & 1) << 5); R = (st >> 1) * 16 + swz / 64; C = (st & 1) * 32 + (swz % 64) / 2; }

__host__ __device__ __forceinline__ int perm32(int rho) { const int n = rho >> 4, i = rho & 15; return 8 * (i >> 2) + 4 * n + (i & 3); }
struct Unit { int pm, pn, sg; };

template <int SEG> struct Order {
    int nM, nN, nwg, G, c, md;
    __device__ __forceinline__ void init(int nM_, int nN_, int G_, int c_, int md_ = 0) { nM = nM_; nN = nN_; nwg = nM * nN; G = G_; c = c_; md = md_; }
    __device__ __forceinline__ bool next(int i, Unit& u) const {
        const int it = i / SEG; u.sg = i - it * SEG;
        const long L = (long)it * G + c; if (L >= nwg) return false;
        int wgid = (int)L; { const int q = nwg / NXCD, r = nwg % NXCD, xcd = wgid % NXCD, off = wgid / NXCD; wgid = (xcd < r ? xcd * (q + 1) : r * (q + 1) + (xcd - r) * q) + off; }
        const int nig = WGM * nN, gid = wgid / nig, fm = gid * WGM, gsz = (nM - fm) < WGM ? (nM - fm) : WGM;
        u.pm = fm + ((wgid % nig) % gsz); u.pn = (wgid % nig) / gsz;
        if (md > 0) u.pm = (u.pm / md) * 18 + (u.pm % md);
        return true;
    }
};

template <class Prob, class Epi, class Sched>
__device__ __forceinline__ void gemm_phase(LAS unsigned char* lds, const Prob& P, const Sched& S, const Epi& E, int wid) {
    int lane_ = lane_id(); asm volatile("" : "+v"(lane_));
    const int lane = lane_, tid = wid * 64 + lane, wr = wid >> 2, wc = wid & 3, fr = lane & 15, fq = lane >> 4;
    const int K = P.K, nt = K / BK;
    unsigned voffA[2][2], voffN[2][2], voffB[2]; int stR[2], stC[2];
#pragma unroll
    for (int i = 0; i < 2; ++i) { stage_rc(tid * 16 + i * 8192, stR[i], stC[i]); const int Rb = (stR[i] & ~31) + perm32(stR[i] & 31); voffB[i] = (unsigned)(Rb * P.ldb + stC[i]) * 2u; }
    const size_t kstep = (size_t)(BK * 2);
    const size_t hstepB = (size_t)HALF * P.ldb * 2;
#define PG8_AOFF(dst, u) do { _Pragma("unroll") for (int h_ = 0; h_ < 2; ++h_) _Pragma("unroll") for (int i_ = 0; i_ < 2; ++i_) \
        dst[h_][i_] = (unsigned)(P.arow(u, h_ * HALF + stR[i_]) * P.lda + stC[i_]) * 2u; } while (0)
    const unsigned ldsw = (unsigned)wid * 1024u;
    const int aoff = lds_byte(wr * 64 + fr, fq * 8), boff = lds_byte(wc * 32 + fr, fq * 8);
#define PG8_SA(b, h) (((b) * 2 + (h)) * HTB)
#define PG8_SB(b, h) ((4 + (b) * 2 + (h)) * HTB)
#define PG8_STAGE(bufoff, gbase, voff) do { _Pragma("unroll") for (int _i = 0; _i < 2; ++_i) \
        __builtin_amdgcn_global_load_lds((const unsigned*)((const char*)(gbase) + (voff)[_i]), (LAS unsigned*)(lds + (bufoff) + ldsw + _i * 8192), 16, 0, 0); } while (0)
#define PG8_LDA(dst, b, h) do { _Pragma("unroll") for (int m = 0; m < 4; ++m) _Pragma("unroll") for (int k = 0; k < 2; ++k) dst[m][k] = *(const LAS bf16x8*)(lds + PG8_SA(b, h) + aoff + m * 2048 + k * 1024); } while (0)
#define PG8_LDB(dst, b, h) do { _Pragma("unroll") for (int n = 0; n < 2; ++n) _Pragma("unroll") for (int k = 0; k < 2; ++k) dst[n][k] = *(const LAS bf16x8*)(lds + PG8_SB(b, h) + boff + n * 2048 + k * 1024); } while (0)
#define PG8_MMA(ai, bj, At, Bt) do { __builtin_amdgcn_s_setprio(1); _Pragma("unroll") for (int m = 0; m < 4; ++m) _Pragma("unroll") for (int n = 0; n < 2; ++n) _Pragma("unroll") for (int k = 0; k < 2; ++k) \
        acc[ai][bj][m][n] = __builtin_amdgcn_mfma_f32_16x16x32_bf16(Bt[n][k], At[m][k], acc[ai][bj][m][n], 0, 0, 0); __builtin_amdgcn_s_setprio(0); } while (0)
#define PG8_WAIT_V(n) asm volatile("s_waitcnt vmcnt(" #n ")" ::: "memory")
#define PG8_WAIT_L(n) asm volatile("s_waitcnt lgkmcnt(" #n ")" ::: "memory")
#define PG8_BAR __builtin_amdgcn_s_barrier()
#define PG8_SCHED __builtin_amdgcn_sched_barrier(0)
    Unit cur, nxt; int ui = 0;
    if (!S.next(0, cur)) return;
    f32x4 acc[2][2][4][2];
#pragma unroll
    for (int a = 0; a < 2; ++a)
#pragma unroll
        for (int b = 0; b < 2; ++b)
#pragma unroll
            for (int m = 0; m < 4; ++m)
#pragma unroll
                for (int n = 0; n < 2; ++n) acc[a][b][m][n] = (f32x4){0.f, 0.f, 0.f, 0.f};
    bf16x8 At[4][2], B0[2][2], B1[2][2];
    const char* cA = P.ap(cur); const char* cB = P.bp(cur);
    PG8_AOFF(voffA, cur);
    PG8_STAGE(PG8_SB(0, 0), cB, voffB); PG8_STAGE(PG8_SB(0, 1), cB + hstepB, voffB); PG8_STAGE(PG8_SA(0, 0), cA, voffA[0]); PG8_STAGE(PG8_SA(0, 1), cA, voffA[1]);
    if (wr == 1) PG8_BAR;
    PG8_WAIT_V(2); PG8_BAR;
    PG8_STAGE(PG8_SB(1, 0), cB + kstep, voffB); PG8_STAGE(PG8_SA(1, 0), cA + kstep, voffA[0]); PG8_STAGE(PG8_SB(1, 1), cB + hstepB + kstep, voffB);
    PG8_WAIT_V(6); PG8_BAR;
    for (;;) {
        const bool has_next = S.next(ui + 1, nxt);
        const char* nA = has_next ? P.ap(nxt) : cA; const char* nB = has_next ? P.bp(nxt) : cB;
        if constexpr (Prob::GATHER) { if (has_next) PG8_AOFF(voffN, nxt); else { _Pragma("unroll") for (int h_ = 0; h_ < 2; ++h_) _Pragma("unroll") for (int i_ = 0; i_ < 2; ++i_) voffN[h_][i_] = voffA[h_][i_]; } }
        for (int t = 0; t < nt; t += 2) {
            const bool last = (t == nt - 2);
            const char* a1 = cA + (size_t)(t + 1) * kstep;
            const char* a2 = last ? nA : cA + (size_t)(t + 2) * kstep; const char* b2 = last ? nB : cB + (size_t)(t + 2) * kstep;
            const char* a3 = a2 + kstep; const char* b3 = b2 + kstep;
            unsigned vo2[2][2];
#pragma unroll
            for (int h_ = 0; h_ < 2; ++h_)
#pragma unroll
                for (int i_ = 0; i_ < 2; ++i_) vo2[h_][i_] = (Prob::GATHER && last) ? voffN[h_][i_] : voffA[h_][i_];
            PG8_LDB(B0, 0, 0); PG8_LDB(B1, 0, 1); PG8_SCHED; PG8_LDA(At, 0, 0); PG8_STAGE(PG8_SA(1, 1), a1, voffA[1]);
            PG8_WAIT_V(8); PG8_WAIT_L(0); PG8_BAR; PG8_MMA(0, 0, At, B0); PG8_MMA(0, 1, At, B1); PG8_BAR; PG8_SCHED;
            PG8_LDA(At, 0, 1); PG8_STAGE(PG8_SB(0, 0), b2, voffB); PG8_STAGE(PG8_SB(0, 1), b2 + hstepB, voffB); PG8_STAGE(PG8_SA(0, 0), a2, vo2[0]);
            PG8_WAIT_V(8); PG8_WAIT_L(0); PG8_BAR; PG8_MMA(1, 0, At, B0); PG8_MMA(1, 1, At, B1); PG8_BAR; PG8_SCHED;
            PG8_LDB(B0, 1, 0); PG8_LDB(B1, 1, 1); PG8_SCHED; PG8_LDA(At, 1, 0); PG8_STAGE(PG8_SA(0, 1), a2, vo2[1]);
            PG8_WAIT_V(8); PG8_WAIT_L(0); PG8_BAR; PG8_MMA(0, 0, At, B0); PG8_MMA(0, 1, At, B1); PG8_BAR; PG8_SCHED;
            PG8_LDA(At, 1, 1); PG8_STAGE(PG8_SB(1, 0), b3, voffB); PG8_STAGE(PG8_SB(1, 1), b3 + hstepB, voffB); PG8_STAGE(PG8_SA(1, 0), a3, vo2[0]);
            PG8_WAIT_V(8); PG8_WAIT_L(0); PG8_BAR; PG8_MMA(1, 0, At, B0); PG8_MMA(1, 1, At, B1); PG8_BAR; PG8_SCHED;
        }
        if (wr == 0) PG8_BAR;
        const bool z = E(acc, cur, wr, wc, fr, fq);
        if (!has_next) break;
        if (z) {
#pragma unroll
            for (int a = 0; a < 2; ++a)
#pragma unroll
                for (int b = 0; b < 2; ++b)
#pragma unroll
                    for (int m = 0; m < 4; ++m)
#pragma unroll
                        for (int n = 0; n < 2; ++n) acc[a][b][m][n] = (f32x4){0.f, 0.f, 0.f, 0.f};
        }
        cur = nxt; cA = nA; cB = nB; ++ui;
        if constexpr (Prob::GATHER) { _Pragma("unroll") for (int h_ = 0; h_ < 2; ++h_) _Pragma("unroll") for (int i_ = 0; i_ < 2; ++i_) voffA[h_][i_] = voffN[h_][i_]; }
        if (wr == 1) PG8_BAR;
    }
    PG8_WAIT_V(0);
    PG8_BAR;
#undef PG8_AOFF
#undef PG8_SA
#undef PG8_SB
#undef PG8_STAGE
#undef PG8_LDA
#undef PG8_LDB
#undef PG8_MMA
#undef PG8_WAIT_V
#undef PG8_WAIT_L
#undef PG8_BAR
#undef PG8_SCHED
}

struct ProbPlain { static constexpr bool GATHER = false; const bf16* A; const bf16* B; int K, lda, ldb;
    __device__ __forceinline__ const char* ap(const Unit& u) const { return (const char*)(A + (size_t)u.pm * 256 * lda); }
    __device__ __forceinline__ int arow(const Unit&, int rr) const { return rr; }
    __device__ __forceinline__ const char* bp(const Unit& u) const { return (const char*)(B + (size_t)u.pn * 256 * ldb); } };
struct ProbSeg3 { static constexpr bool GATHER = false; const bf16* A; const bf16* B; int K, lda, ldb; size_t sA, sB;
    __device__ __forceinline__ const char* ap(const Unit& u) const { return (const char*)(A + (size_t)u.sg * sA + (size_t)u.pm * 256 * lda); }
    __device__ __forceinline__ int arow(const Unit&, int rr) const { return rr; }
    __device__ __forceinline__ const char* bp(const Unit& u) const { return (const char*)(B + (size_t)u.sg * sB + (size_t)u.pn * 256 * ldb); } };
struct ProbUp2 { static constexpr bool GATHER = false; const bf16* A0; const bf16* A1; const bf16* B0; const bf16* B1; int K, lda, ldb;
    __device__ __forceinline__ const char* ap(const Unit& u) const { return (const char*)((u.sg ? A1 : A0) + (size_t)u.pm * 256 * lda); }
    __device__ __forceinline__ int arow(const Unit&, int rr) const { return rr; }
    __device__ __forceinline__ const char* bp(const Unit& u) const { return (const char*)((u.sg ? B1 : B0) + (size_t)u.pn * 256 * ldb); } };
struct OrderUp2 { int n0, nwg, G, c, nM0;
    __device__ __forceinline__ void init(int nM0_, int G_, int c_) { nM0 = nM0_; n0 = nM0_ * 3; nwg = n0 + (MT / 256) * 4; G = G_; c = c_; }
    __device__ __forceinline__ bool next(int i, Unit& u) const { const int L = i * G + c; if (L >= nwg) return false;
        if (L < n0) { u.sg = 0; u.pm = L / 3; u.pn = L - u.pm * 3; } else { const int r = L - n0; u.sg = 1; u.pm = r >> 2; u.pn = r & 3; } return true; } };
struct OrderWinLast { int G, c;
    __device__ __forceinline__ void init(int G_, int c_) { G = G_; c = c_; }
    __device__ __forceinline__ bool next(int i, Unit& u) const { const int L = i * G + c; u.sg = 0; if (L >= 128 * 24 + 16 * 5) return false;
        if (L < 128 * 24) { const int g = L / (8 * 24), q = L - g * 8 * 24; u.pm = g * 8 + (q & 7); u.pn = q >> 3; }
        else { const int r = L - 128 * 24, t = r % 5; u.pm = 128 + r / 5; u.pn = t < 4 ? 2 + t : 7; } return true; } };
struct ProbMoE { static constexpr bool GATHER = false; const bf16* A; const bf16* B; int K, lda, ldb; int nrowsB;
    __device__ __forceinline__ const char* ap(const Unit& u) const { return (const char*)(A + (size_t)u.pm * 256 * lda); }
    __device__ __forceinline__ int arow(const Unit&, int rr) const { return rr; }
    __device__ __forceinline__ const char* bp(const Unit& u) const { return (const char*)(B + ((size_t)(u.pm / 18) * nrowsB + (size_t)u.pn * 256) * ldb); } };
struct ProbMoEGather { static constexpr bool GATHER = true; const bf16* A; const bf16* B; const LAS int* lidx; int K, lda, ldb; int nrowsB;
    __device__ __forceinline__ const char* ap(const Unit&) const { return (const char*)A; }
    __device__ __forceinline__ int arow(const Unit& u, int rr) const { return lidx[u.sg * 256 + rr]; }
    __device__ __forceinline__ const char* bp(const Unit& u) const { return (const char*)(B + ((size_t)(u.pm / 18) * nrowsB + (size_t)u.pn * 256) * ldb); } };
struct OrderOrd { Order<1> o;
    __device__ __forceinline__ bool next(int i, Unit& u) const { const bool r = o.next(i, u); u.sg = i; return r; } };

#define EPI_ROWS(...) _Pragma("unroll") for (int ai = 0; ai < 2; ++ai) _Pragma("unroll") for (int m = 0; m < 4; ++m) { const int row = u.pm * 256 + ai * 128 + wr * 64 + m * 16 + fr; __VA_ARGS__ }
#define EPI_COLS8(...) _Pragma("unroll") for (int bj = 0; bj < 2; ++bj) { const int col = u.pn * 256 + bj * 128 + wc * 32 + 8 * fq; __VA_ARGS__ }
#define EPI_LANE() int t_ = lane_id(); asm volatile("" : "+v"(t_)); const int fr = t_ & 15, fq = t_ >> 4
__device__ __forceinline__ v4u pack8(const f32x4& a, const f32x4& b) { v4u w; w.x = pk2(a[0], a[1]); w.y = pk2(a[2], a[3]); w.z = pk2(b[0], b[1]); w.w = pk2(b[2], b[3]); return w; }
__device__ __forceinline__ f32x4 unpack4(v2u w) { return (f32x4){bflo(w.x), bfhi(w.x), bflo(w.y), bfhi(w.y)}; }
struct EpiBf16 { bf16* O; int ldc;
    __device__ __forceinline__ bool operator()(f32x4 (&acc)[2][2][4][2], const Unit& u, int wr, int wc, int fr_, int fq_) const {
        EPI_LANE();
        EPI_ROWS( bf16* rp = O + (size_t)row * ldc; EPI_COLS8( *(v4u*)(rp + col) = pack8(acc[ai][bj][m][0], acc[ai][bj][m][1]); ) )
        return true; } };
__device__ __forceinline__ f32x4 sigmoid4(const f32x4& v) { return (f32x4){__builtin_amdgcn_rcpf(1.f + __expf(-v[0])), __builtin_amdgcn_rcpf(1.f + __expf(-v[1])), __builtin_amdgcn_rcpf(1.f + __expf(-v[2])), __builtin_amdgcn_rcpf(1.f + __expf(-v[3]))}; }
struct EpiUp2 { bf16* O0; bf16* O1;
    __device__ __forceinline__ bool operator()(f32x4 (&acc)[2][2][4][2], const Unit& u, int wr, int wc, int fr_, int fq_) const {
        EPI_LANE();
        bf16* O = u.sg ? O1 : O0; const int ldc = u.sg ? 1024 : 768;
        EPI_ROWS( bf16* rp = O + (size_t)row * ldc; EPI_COLS8( *(v4u*)(rp + col) = pack8(acc[ai][bj][m][0], acc[ai][bj][m][1]); ) )
        return true; } };
struct EpiWin { bf16* O;
    __device__ __forceinline__ bool operator()(f32x4 (&acc)[2][2][4][2], const Unit& u, int wr, int wc, int fr_, int fq_) const {
        EPI_LANE();
        const bool sg = u.pn >= 10;
        EPI_ROWS( bf16* rp = O + (size_t)row * NP; EPI_COLS8( f32x4 v0 = acc[ai][bj][m][0], v1 = acc[ai][bj][m][1];
            if (sg) { v0 = sigmoid4(v0); v1 = sigmoid4(v1); }
            *(v4u*)(rp + col) = pack8(v0, v1); ) )
        return true; } };
__device__ __forceinline__ f32x4 gate_ratio(v2u a, v2u b, bool fin) { const f32x4 x = unpack4(a), y = unpack4(b);
    return (f32x4){x[0] * (fin ? 1.f : __builtin_amdgcn_rcpf(fmaxf(y[0], 1e-20f))), x[1] * (fin ? 1.f : __builtin_amdgcn_rcpf(fmaxf(y[1], 1e-20f))), x[2] * (fin ? 1.f : __builtin_amdgcn_rcpf(fmaxf(y[2], 1e-20f))), x[3] * (fin ? 1.f : __builtin_amdgcn_rcpf(fmaxf(y[3], 1e-20f)))}; }
struct EpiMerge { const bf16* PROJ; bf16* O;
    __device__ __forceinline__ bool operator()(f32x4 (&acc)[2][2][4][2], const Unit& u, int wr, int wc, int fr_, int fq_) const {
        EPI_LANE();
        const int sg = u.sg; const bool fin = sg == 2; const int sgb = fin ? 2 : sg + 1;
        _Pragma("unroll") for (int ai = 0; ai < 2; ++ai) {
            _Pragma("unroll") for (int m = 0; m < 4; ++m) { const int row = u.pm * 256 + ai * 128 + wr * 64 + m * 16 + fr;
                const bf16* gp = PROJ + (size_t)row * NP + C_GT; bf16* rp = O + (size_t)row * DM;
                EPI_COLS8( const v4u ga = *(const v4u*)(gp + sg * 1024 + col), gb = *(const v4u*)(gp + sgb * 1024 + col);
                    const f32x4 v0 = acc[ai][bj][m][0] * gate_ratio((v2u){ga.x, ga.y}, (v2u){gb.x, gb.y}, fin), v1 = acc[ai][bj][m][1] * gate_ratio((v2u){ga.z, ga.w}, (v2u){gb.z, gb.w}, fin);
                    acc[ai][bj][m][0] = v0; acc[ai][bj][m][1] = v1;
                    if (fin) *(v4u*)(rp + col) = pack8(v0, v1); ) }
            asm volatile("" ::: "memory"); }
        return fin; } };
struct EpiSwiGLU { bf16* HID;
    __device__ __forceinline__ bool operator()(f32x4 (&acc)[2][2][4][2], const Unit& u, int wr, int wc, int fr_, int fq_) const {
        EPI_LANE();
        EPI_ROWS( bf16* rp = HID + (size_t)row * 1024 + u.pn * 128 + wc * 32 + 8 * fq; f32x4 h[2];
            _Pragma("unroll") for (int n = 0; n < 2; ++n) { const f32x4 g = acc[ai][0][m][n], up = acc[ai][1][m][n];
                h[n] = (f32x4){g[0] * __builtin_amdgcn_rcpf(1.f + __expf(-g[0])) * up[0], g[1] * __builtin_amdgcn_rcpf(1.f + __expf(-g[1])) * up[1], g[2] * __builtin_amdgcn_rcpf(1.f + __expf(-g[2])) * up[2], g[3] * __builtin_amdgcn_rcpf(1.f + __expf(-g[3])) * up[3]}; }
            *(v4u*)rp = pack8(h[0], h[1]); )
        return true; } };
}

#define XB_TMO      128
#define XB_XCNT(j)  (256  + 64 * (j))
#define XB_XSUB(j)  (1280 + 64 * (j))
#define XB_XGEN(j)  (2304 + 64 * (j))
#define XB_TOP      3328
#define XB_TOPGEN   3392
#define XCD_BAR_WORDS 3456
#define XB_SPIN_CAP (1u << 22)
__device__ __forceinline__ unsigned xb_ld(unsigned* p)              { return __hip_atomic_load(p, __ATOMIC_RELAXED, __HIP_MEMORY_SCOPE_AGENT); }
__device__ __forceinline__ unsigned xb_add(unsigned* p, unsigned v) { return __hip_atomic_fetch_add(p, v, __ATOMIC_RELAXED, __HIP_MEMORY_SCOPE_AGENT); }
__device__ __forceinline__ unsigned xb_xcc_id() { return (unsigned)__builtin_amdgcn_s_getreg((3 << 11) | 20) & 0xFu; }
#define XB_SPIN(cond, bar) do { unsigned _sp = 0; while (cond) { __builtin_amdgcn_s_sleep(1); \
    if ((++_sp & 255u) == 0u) { if (xb_ld(&(bar)[XB_TMO])) break; if (_sp > XB_SPIN_CAP) { atomicAdd(&(bar)[XB_TMO], 1u); break; } } } } while (0)
struct XcdBarrier { unsigned* bar; unsigned x; volatile LAS unsigned* st; int wv; };
__device__ __forceinline__ XcdBarrier xcd_barrier_post(unsigned* bar, volatile LAS unsigned* st, int wv) {
    XcdBarrier b; b.bar = bar; b.x = xb_xcc_id(); b.st = st; b.wv = wv;
    if (wv == 0 && lane_id() == 0) (void)xb_add(&bar[XB_XCNT(b.x)], 1u);
    return b;
}
__device__ __forceinline__ void xcd_barrier_complete(unsigned* bar, unsigned x, unsigned& nloc, unsigned& nx) {
    const unsigned G = gridDim.x * gridDim.y * gridDim.z;
    unsigned sum, cnt, mine, sp = 0u;
    for (;;) {
        sum = 0u; cnt = 0u; mine = 0u;
#pragma unroll
        for (unsigned j = 0; j < 16; ++j) { const unsigned c = xb_ld(&bar[XB_XCNT(j)]); sum += c; cnt += (c > 0u) ? 1u : 0u; mine = (j == x) ? c : mine; }
        if (sum == G) break;
        __builtin_amdgcn_s_sleep(1);
        if ((++sp & 255u) == 0u) { if (xb_ld(&bar[XB_TMO])) break; if (sp > XB_SPIN_CAP) { atomicAdd(&bar[XB_TMO], 1u); break; } }
    }
    nloc = mine > 0u ? mine : 1u; nx = cnt > 0u ? cnt : 1u;
}
__device__ __forceinline__ void xcd_barrier(const XcdBarrier& b) {
    asm volatile("s_waitcnt vmcnt(0)" ::: "memory");
    __syncthreads();
    if (b.wv == 0 && lane_id() == 0) {
        unsigned* bar = b.bar; unsigned bx_ = b.x; asm volatile("" : "+s"(bx_)); asm volatile("" : "+s"(bar));
        __builtin_amdgcn_s_waitcnt(0);
        unsigned nloc = b.st[0], nx = b.st[1];
        if (nloc == 0u) { xcd_barrier_complete(bar, bx_, nloc, nx); b.st[0] = nloc; b.st[1] = nx; }
        const unsigned old = xb_add(&bar[XB_XSUB(bx_)], 1u);
        const unsigned gen = old / nloc;
        if (old + 1u == (gen + 1u) * nloc) {
            __builtin_amdgcn_fence(__ATOMIC_RELEASE, "agent");
            asm volatile("s_waitcnt vmcnt(0)" ::: "memory");
            const unsigned og = xb_add(&bar[XB_TOP], 1u);
            const unsigned tg = og / nx;
            if (og + 1u == (tg + 1u) * nx) xb_add(&bar[XB_TOPGEN], 1u);
            else XB_SPIN(xb_ld(&bar[XB_TOPGEN]) == tg, bar);
            __builtin_amdgcn_fence(__ATOMIC_ACQUIRE, "agent");
            xb_add(&bar[XB_XGEN(bx_)], 1u);
            asm volatile("s_waitcnt vmcnt(0)" ::: "memory");
        } else {
            XB_SPIN(xb_ld(&bar[XB_XGEN(bx_)]) == gen, bar);
            __builtin_amdgcn_fence(__ATOMIC_ACQUIRE, "agent");
            asm volatile("s_waitcnt vmcnt(0)" ::: "memory");
        }
    }
    __syncthreads();
}

struct Args { const float* in[28]; float* out; unsigned char* ws; };
enum { I_X = 0, I_C, I_CTX, I_CCTX, I_WADA, I_BADA, I_WIN, I_GQ, I_WUQ, I_GKV, I_WUKV, I_RPB, I_WDW, I_BDW, I_GCN, I_BCN, I_WPW2, I_WOA, I_WOB, I_WOUT, I_LN1G, I_LN1B, I_WROUTER, I_WGATE, I_WUP, I_WDOWN, I_LN2G, I_LN2B };

#define OPAQUE(v) asm volatile("" : "+v"(v))
struct Ctx {
    LAS unsigned char* lds;
    int tid, lane, wave, G, bid;
    const float* const* in;
    unsigned char* ws;
    float* out;
};
#define INP(i) ((const float*)(const GAS float*)C.in[i])
#define WSP(T, off) ((T*)(C.ws + (off)))
#define WSW(T, off, l) ((T*)(C.ws + (off) + (size_t)((l) & 1) * WS_WSET))

template <class RowPtr>
__device__ __forceinline__ void tr_item(const float* W, int N, int k0, int n0, const RowPtr& rp, LAS float* scr, int lane) {
#pragma unroll
    for (int i = 0; i < 8; ++i) { const int kk = 8 * i + (lane >> 3), nn = (lane & 7) * 4; const f32x4 v = *(const f32x4*)(W + (size_t)(k0 + kk) * N + n0 + nn);
        scr[kk * 33 + nn] = v[0]; scr[kk * 33 + nn + 1] = v[1]; scr[kk * 33 + nn + 2] = v[2]; scr[kk * 33 + nn + 3] = v[3]; }
    LDS_WAIT(); asm volatile("" ::: "memory");
    const int c = lane & 7;
#pragma unroll
    for (int j = 0; j < 4; ++j) { const int n = (lane >> 3) + 8 * j; const LAS float* s = scr + (8 * c) * 33 + n;
        v4u o; o.x = pk2(s[0 * 33], s[1 * 33]); o.y = pk2(s[2 * 33], s[3 * 33]); o.z = pk2(s[4 * 33], s[5 * 33]); o.w = pk2(s[6 * 33], s[7 * 33]);
        *(v4u*)(rp(n0 + n) + k0 + 8 * c) = o; }
    LDS_WAIT(); asm volatile("" ::: "memory");
}
struct RpPlain { bf16* base; int ld; __device__ __forceinline__ bf16* operator()(int n) const { return base + (size_t)n * ld; } };
struct RpWin { bf16* base; __device__ __forceinline__ bf16* operator()(int n) const { return base + (size_t)(n < 1952 ? n : n + 96) * 1024; } };
struct RpGU { bf16* base; int add; __device__ __forceinline__ bf16* operator()(int n) const { return base + (size_t)((n >> 7) * 256 + (n & 127) + add) * 1024; } };

__device__ __forceinline__ void conv_weights(const Ctx& Cc, int l, int f0, int f1, int wg0, int nwg) {
    Ctx C = Cc; OPAQUE(C.lane); OPAQUE(C.tid);
    LAS float* scr = (LAS float*)(C.lds + C.wave * 16384);
    if (C.bid < wg0) return;
    const int gw = (C.bid - wg0) * NWAVES + C.wave, NGW = nwg * NWAVES;
    constexpr int I_IN = 16 * 189, I_UQ = 4 * 24, I_UKV = 2 * 32, I_PW = 8 * 32, I_OUT = 16 * 32, I_EX = 16 * 32;
    constexpr int NITEMS = I_IN + I_UQ + I_UKV + 3 * I_PW + I_OUT + 48 * I_EX;
    bf16* WinT = WSW(bf16, WS_WIN, l);
    const int it0 = (int)((long)NITEMS * f0 / 100), it1 = (int)((long)NITEMS * f1 / 100);
    for (int it = it0 + gw; it < it1; it += NGW) {
        int r = it;
        if (r < I_IN) { const int kb = r / 189, nb = r % 189; tr_item(INP(I_WIN) + (size_t)l * 1024 * 6048, 6048, kb * 64, nb * 32, RpWin{WinT}, scr, C.lane); continue; } r -= I_IN;
        if (r < I_UQ) { const int kb = r / 24, nb = r % 24; tr_item(INP(I_WUQ) + (size_t)l * 256 * 768, 768, kb * 64, nb * 32, RpPlain{WSW(bf16, WS_WUQ, l), 256}, scr, C.lane); continue; } r -= I_UQ;
        if (r < I_UKV) { const int kb = r / 32, nb = r % 32; tr_item(INP(I_WUKV) + (size_t)l * 128 * 1024, 1024, kb * 64, nb * 32, RpPlain{WSW(bf16, WS_WUKV, l), 256}, scr, C.lane); continue; } r -= I_UKV;
        if (r < 3 * I_PW) { const int w = r / I_PW, q = r % I_PW, kb = q / 32, nb = q % 32;
            const float* src = (w == 0 ? INP(I_WPW2) : (w == 1 ? INP(I_WOA) : INP(I_WOB))) + (size_t)l * 512 * 1024;
            bf16* dst = WSW(bf16, w == 0 ? WS_WPW2 : (w == 1 ? WS_WOA : WS_WOB), l);
            tr_item(src, 1024, kb * 64, nb * 32, RpPlain{dst, 512}, scr, C.lane); continue; } r -= 3 * I_PW;
        if (r < I_OUT) { const int kb = r / 32, nb = r % 32; tr_item(INP(I_WOUT) + (size_t)l * 1024 * 1024, 1024, kb * 64, nb * 32, RpPlain{WSW(bf16, WS_WOUT, l), 1024}, scr, C.lane); continue; } r -= I_OUT;
        { const int mat = r / I_EX, q = r % I_EX, kb = q / 32, nb = q % 32, w = mat / 16, e = mat % 16;
          const float* src = (w == 0 ? INP(I_WGATE) : (w == 1 ? INP(I_WUP) : INP(I_WDOWN))) + ((size_t)l * 16 + e) * 1024 * 1024;
          if (w < 2) tr_item(src, 1024, kb * 64, nb * 32, RpGU{WSW(bf16, WS_WGU, l) + (size_t)e * 2048 * 1024, w * 128}, scr, C.lane);
          else tr_item(src, 1024, kb * 64, nb * 32, RpPlain{WSW(bf16, WS_WD, l) + (size_t)e * 1024 * 1024, 1024}, scr, C.lane); }
    }
    if (f0 != 0) return;
    const int gt = (C.bid - wg0) * NTHREADS + C.tid, NGT = nwg * NTHREADS;
    unsigned zz_ = 0u; asm volatile("" : "+v"(zz_)); const v4u z = (v4u){zz_, zz_, zz_, zz_};
    for (int i = gt; i < 96 * 128; i += NGT) *((v4u*)(WinT + (size_t)1952 * 1024) + i) = z;
    for (int i = gt; i < 1024 * 16; i += NGT) { const int n = i >> 4, c = i & 15; *((v4u*)(WSW(bf16, WS_WUKV, l) + (size_t)n * 256 + 128) + c) = z; }
}

__device__ __forceinline__ void phase_mods(const Ctx& Cc) {
    Ctx C = Cc; OPAQUE(C.lane); OPAQUE(C.tid);
    LAS float* sc = (LAS float*)C.lds;
    LAS float* red = (LAS float*)(C.lds + 69632);
    for (int idx = C.tid; idx < 17 * 1024; idx += NTHREADS) { const int r = idx >> 10, k = idx & 1023; const float v = r < 16 ? INP(I_C)[r * 1024 + k] : INP(I_CCTX)[k]; sc[idx] = v / (1.f + __expf(-v)); }
    __syncthreads();
    float* MODS = WSP(float, WS_MODS);
    for (int item = C.bid; item < NL * 96; item += C.G) {
        const int l = item / 96, cb = item % 96, col = cb * 64 + C.lane;
        const float* W = INP(I_WADA) + (size_t)l * 1024 * 6144;
        float acc[17];
#pragma unroll
        for (int r = 0; r < 17; ++r) acc[r] = 0.f;
        for (int k = C.wave * 128; k < C.wave * 128 + 128; k += 4) { const float w0 = W[(size_t)k * 6144 + col], w1 = W[(size_t)(k + 1) * 6144 + col], w2 = W[(size_t)(k + 2) * 6144 + col], w3 = W[(size_t)(k + 3) * 6144 + col];
#pragma unroll
            for (int r = 0; r < 17; ++r) { const f32x4 sv = *(const LAS f32x4*)(sc + r * 1024 + k); acc[r] += (sv[0] * w0 + sv[1] * w1) + (sv[2] * w2 + sv[3] * w3); } }
#pragma unroll
        for (int r = 0; r < 17; ++r) red[(C.wave * 17 + r) * 64 + C.lane] = acc[r];
        __syncthreads();
        for (int o = C.tid; o < 17 * 64; o += NTHREADS) { const int r = o >> 6, cl = o & 63; float s = INP(I_BADA)[l * 6144 + cb * 64 + cl];
#pragma unroll
            for (int w = 0; w < 8; ++w) s += red[(w * 17 + r) * 64 + cl];
            MODS[((size_t)l * 17 + r) * 6144 + cb * 64 + cl] = s; }
        __syncthreads();
    }
    float* TAB = WSP(float, WS_TAB);
    const int gt = C.bid * NTHREADS + C.tid, NGT = C.G * NTHREADS;
    for (int idx = gt; idx < 2048 * 16; idx += NGT) { const int t = idx >> 4, j = idx & 15, which = j >> 3, i = j & 7;
        const float pos = (float)(which ? (t & 63) : (t >> 6)), invf = exp2f(-(float)i * (13.287712379549449f / 8.f)), ang = pos * invf;
        TAB[t * 32 + which * 16 + i] = __cosf(ang); TAB[t * 32 + which * 16 + 8 + i] = __sinf(ang); }
}

__device__ __forceinline__ void phase_mod0(const Ctx& Cc) {
    Ctx C = Cc; OPAQUE(C.lane);
    const int gw = C.bid * NWAVES + C.wave, NGW = C.G * NWAVES;
    const float* MODS = WSP(float, WS_MODS); float* X = WSP(float, WS_X); bf16* H = WSP(bf16, WS_HB);
    for (int row = gw; row < MT; row += NGW) {
        const float* src = row < ML ? INP(I_X) + (size_t)row * DM : INP(I_CTX) + (size_t)(row - ML) * DM;
        const int mr = row < ML ? (row >> 11) : 16; const float* md = MODS + (size_t)mr * 6144;
#pragma unroll
        for (int j = 0; j < 2; ++j) { const int c0 = 8 * (C.lane + 64 * j); f32x4 h[2];
#pragma unroll
            for (int q = 0; q < 2; ++q) { const int c = c0 + 4 * q; const f32x4 xv = *(const f32x4*)(src + c), sh = *(const f32x4*)(md + c), scl = *(const f32x4*)(md + 1024 + c);
                *(f32x4*)(X + (size_t)row * DM + c) = xv; h[q] = xv * (scl + 1.f) + sh; }
            *(v4u*)(H + (size_t)row * DM + c0) = pg8::pack8(h[0], h[1]); }
    }
}

__device__ __forceinline__ void phase_prep(const Ctx& C, int l) {
    int lane = C.lane; OPAQUE(lane); const int gw = C.bid * NWAVES + C.wave, NGW = C.G * NWAVES;
    const bf16* PROJ = WSP(bf16, WS_R); bf16* CQN = WSP(bf16, WS_CQN); bf16* CKVN = WSP(bf16, WS_CKVN); bf16* KR = WSP(bf16, WS_KR);
    const float* TAB = WSP(float, WS_TAB);
    const f32x4 gq = *(const f32x4*)(INP(I_GQ) + l * 256 + 4 * lane); const f32x2 gkv = *(const f32x2*)(INP(I_GKV) + l * 128 + 2 * lane);
    for (int row = gw; row < MT; row += NGW) {
        const bf16* p = PROJ + (size_t)row * NP;
        { const v2u w = *(const v2u*)(p + C_CQ + 4 * lane); const float x0 = bflo(w.x), x1 = bfhi(w.x), x2 = bflo(w.y), x3 = bfhi(w.y);
          const float ss = wave_sum(x0 * x0 + x1 * x1 + x2 * x2 + x3 * x3), r = 1.f / sqrtf(ss * (1.f / 256.f) + RMS_EPS);
          v2u o; o.x = pk2(x0 * r * gq[0], x1 * r * gq[1]); o.y = pk2(x2 * r * gq[2], x3 * r * gq[3]); *(v2u*)(CQN + (size_t)row * 256 + 4 * lane) = o; }
        { const unsigned w = *(const unsigned*)(p + C_CKV + 2 * lane); const float x0 = bflo(w), x1 = bfhi(w);
          const float ss = wave_sum(x0 * x0 + x1 * x1), r = 1.f / sqrtf(ss * (1.f / 128.f) + RMS_EPS);
          *(unsigned*)(CKVN + (size_t)row * 256 + 2 * lane) = pk2(x0 * r * gkv[0], x1 * r * gkv[1]); *(unsigned*)(CKVN + (size_t)row * 256 + 128 + 2 * lane) = 0u; }
        if (lane < 16) { const int gi = lane >> 3, i = lane & 7; const float x1 = bf2f(p[C_KR + gi * 16 + i]), x2 = bf2f(p[C_KR + gi * 16 + 8 + i]); float o1 = x1, o2 = x2;
          if (row < ML) { const int t = row & 2047; const float cs = TAB[t * 32 + gi * 16 + i], sn = TAB[t * 32 + gi * 16 + 8 + i]; o1 = x1 * cs - x2 * sn; o2 = x2 * cs + x1 * sn; }
          KR[(size_t)row * 32 + gi * 16 + i] = (bf16)f2bf(o1); KR[(size_t)row * 32 + gi * 16 + 8 + i] = (bf16)f2bf(o2); }
    }
}

__device__ __forceinline__ void phase_conv(const Ctx& C, int l) {
    int tid = C.tid; OPAQUE(tid); const int lane = tid & 63, w = C.wave;
    LAS float* Wt = (LAS float*)C.lds;
    LAS unsigned char* Xt = C.lds + 63488;
    const bf16* PROJ = WSP(bf16, WS_R); bf16* U = WSP(bf16, WS_U);
    { const float* wdw = INP(I_WDW) + (size_t)l * 31 * 512;
      for (int i = tid; i < 31 * 128; i += NTHREADS) { const int j = i >> 7, c4 = i & 127, ln = c4 >> 1, hf = c4 & 1; *(LAS f32x4*)(Wt + ((j * 2 + hf) * 64 + ln) * 4) = *(const f32x4*)(wdw + j * 512 + 4 * c4); } }
    const f32x4 bd0 = *(const f32x4*)(INP(I_BDW) + l * 512 + 8 * lane), bd1 = *(const f32x4*)(INP(I_BDW) + l * 512 + 8 * lane + 4);
    const f32x4 gc0 = *(const f32x4*)(INP(I_GCN) + l * 512 + 8 * lane), gc1 = *(const f32x4*)(INP(I_GCN) + l * 512 + 8 * lane + 4);
    const f32x4 bc0 = *(const f32x4*)(INP(I_BCN) + l * 512 + 8 * lane), bc1 = *(const f32x4*)(INP(I_BCN) + l * 512 + 8 * lane + 4);
    const int ntile = (l == NL - 1 ? ML : MT) / 32;
    for (int tile = C.bid; tile < ntile; tile += C.G) {
        const int r0 = tile * 32, t0 = r0 < ML ? (r0 & 2047) : ((r0 - ML) & 255), L = r0 < ML ? 2048 : 256;
#pragma unroll
        for (int it = 0; it < 8; ++it) { const int idx = tid + 512 * it, rr = idx >> 6, ch = idx & 63, tt = t0 - 15 + rr;
            if (rr < 62) { v4u o = (v4u){0u, 0u, 0u, 0u};
                if (tt >= 0 && tt < L) { const bf16* p = PROJ + (size_t)(r0 - 15 + rr) * NP + C_CIN + 8 * ch; const v4u a = *(const v4u*)p, g = *(const v4u*)(p + 512);
                    o.x = pk2(bflo(a.x) * bflo(g.x), bfhi(a.x) * bfhi(g.x)); o.y = pk2(bflo(a.y) * bflo(g.y), bfhi(a.y) * bfhi(g.y));
                    o.z = pk2(bflo(a.z) * bflo(g.z), bfhi(a.z) * bfhi(g.z)); o.w = pk2(bflo(a.w) * bflo(g.w), bfhi(a.w) * bfhi(g.w)); }
                *(LAS v4u*)(Xt + rr * 1024 + ch * 16) = o; } }
        __syncthreads();
        f32x4 a0[4], a1[4];
#pragma unroll
        for (int tk = 0; tk < 4; ++tk) { a0[tk] = bd0; a1[tk] = bd1; }
        f32x4 wq0[4], wq1[4];
#pragma unroll
        for (int d = 0; d < 4; ++d) { wq0[d] = (f32x4){0.f, 0.f, 0.f, 0.f}; wq1[d] = (f32x4){0.f, 0.f, 0.f, 0.f}; }
#pragma unroll
        for (int rr = 0; rr < 34; ++rr) {
            if (rr <= 30) { wq0[0] = *(const LAS f32x4*)(Wt + ((rr * 2 + 0) * 64 + lane) * 4); wq1[0] = *(const LAS f32x4*)(Wt + ((rr * 2 + 1) * 64 + lane) * 4); }
            else { wq0[0] = (f32x4){0.f, 0.f, 0.f, 0.f}; wq1[0] = (f32x4){0.f, 0.f, 0.f, 0.f}; }
            const v4u g = *(const LAS v4u*)(Xt + (4 * w + rr) * 1024 + lane * 16);
            const f32x4 x0 = (f32x4){bflo(g.x), bfhi(g.x), bflo(g.y), bfhi(g.y)}, x1 = (f32x4){bflo(g.z), bfhi(g.z), bflo(g.w), bfhi(g.w)};
#pragma unroll
            for (int tk = 0; tk < 4; ++tk) { const int j = rr - tk; if (j >= 0 && j <= 30) { a0[tk] = a0[tk] + x0 * wq0[tk]; a1[tk] = a1[tk] + x1 * wq1[tk]; } }
            wq0[3] = wq0[2]; wq0[2] = wq0[1]; wq0[1] = wq0[0]; wq1[3] = wq1[2]; wq1[2] = wq1[1]; wq1[1] = wq1[0];
        }
#pragma unroll
        for (int tk = 0; tk < 4; ++tk) { f32x4 x0 = a0[tk], x1 = a1[tk];
            const float mean = wave_sum((x0[0] + x0[1]) + (x0[2] + x0[3]) + (x1[0] + x1[1]) + (x1[2] + x1[3])) * (1.f / 512.f);
            x0 = x0 - mean; x1 = x1 - mean;
            const float var = wave_sum((x0[0] * x0[0] + x0[1] * x0[1]) + (x0[2] * x0[2] + x0[3] * x0[3]) + (x1[0] * x1[0] + x1[1] * x1[1]) + (x1[2] * x1[2] + x1[3] * x1[3])) * (1.f / 512.f);
            const float rstd = 1.f / sqrtf(var + LN_EPS);
            f32x4 y0 = x0 * rstd * gc0 + bc0, y1 = x1 * rstd * gc1 + bc1;
#pragma unroll
            for (int q = 0; q < 4; ++q) { y0[q] = y0[q] / (1.f + __expf(-y0[q])); y1[q] = y1[q] / (1.f + __expf(-y1[q])); }
            v4u o; o.x = pk2(y0[0], y0[1]); o.y = pk2(y0[2], y0[3]); o.z = pk2(y1[0], y1[1]); o.w = pk2(y1[2], y1[3]);
            *(v4u*)(U + (size_t)(r0 + 4 * w + tk) * 512 + 8 * lane) = o; }
        __syncthreads();
    }
}

typedef float f32x16 __attribute__((ext_vector_type(16)));
typedef short v4i16 __attribute__((ext_vector_type(4)));
#define MFMA32(a, b, c) __builtin_amdgcn_mfma_f32_32x32x16_bf16(a, b, c, 0, 0, 0)
constexpr int AT_KBUF = 13312, AT_VBUF = 8192;
constexpr int AT_K0 = 0, AT_V0 = 3 * AT_KBUF, AT_RPB = AT_V0 + 3 * AT_VBUF, AT_QR = AT_RPB + 15 * 128 * 4, AT_END = AT_QR + 8 * 4096;
static_assert(AT_END <= RING_BYTES, "attention LDS map");
template <int MODE> __device__ __forceinline__ void attn_unit(const Ctx& C, int l, int unit) {
    constexpr bool MLA = MODE < 2; constexpr int DQK = MLA ? 96 : 64, KC = DQK / 8, KS = DQK / 16, RS = DQK * 2 + 16, NCH = 64 * KC + 512;
    constexpr int QT = (MODE == 0 || MODE == 2) ? 2 : 1;
    const int w = C.wave, lane = lane_id(), tid = w * 64 + lane, r = lane & 31, hh = lane >> 5;
    const bf16* PROJ = WSP(bf16, WS_R); const bf16* QB = WSP(bf16, WS_QB); const bf16* KVB = WSP(bf16, WS_KVB); const bf16* KR = WSP(bf16, WS_KR); const float* TAB = WSP(float, WS_TAB);
    bf16* Yo = WSP(bf16, MLA ? WS_YB : WS_YA);
    LAS unsigned char* lds = C.lds;
    int b, hd, q0, T, NB = 0, rs_min = 0, gi = 0;
    if (MODE == 0) { hd = unit & 7; const int qb = (unit >> 3) & 3; b = unit >> 5; q0 = b * 2048 + qb * 512; T = 36; }
    else if (MODE == 2) { hd = unit & 7; const int ib = (unit >> 3) & 3; b = unit >> 5; q0 = b * 2048 + ib * 512; gi = ib * 8 + w;
        rs_min = min(max(ib * 8 - 4, 0), 24); const int rs_max = min(max(ib * 8 + 3, 0), 24); NB = rs_max - rs_min + 8; T = NB + 4; }
    else { hd = unit & 7; b = unit >> 3; q0 = ML + b * 256; T = 4; }
    const int qrow0 = q0 + 32 * QT * w + r;
    constexpr int NKQ = (64 * (KC + 1)) / 64, NQ = NKQ + 8;
    auto tile_row0 = [&](int t) -> int {
        if (MODE == 0) return t < 4 ? ML + b * 256 + 64 * t : b * 2048 + 64 * (t - 4);
        if (MODE == 2) return t < NB ? b * 2048 + (rs_min + t) * 64 : ML + b * 256 + 64 * (t - NB);
        return ML + b * 256 + 64 * t; };
    int goff[3]; bool gkr[3]; int dblk[3]; bool dk[3];
#pragma unroll
    for (int j = 0; j < 3; ++j) { int q_ = w + 8 * j; if (q_ >= NQ) q_ -= 8; gkr[j] = false; dk[j] = q_ < NKQ; dblk[j] = (q_ < NKQ ? q_ : q_ - NKQ) * 1024;
        if (q_ < NKQ) { const int p_ = 64 * q_ + lane, key_ = p_ / (KC + 1), kc0_ = p_ - key_ * (KC + 1), kc_ = kc0_ == KC ? 0 : kc0_;
            if (MLA) { if (kc_ < 8) goff[j] = key_ * 1024 + hd * 128 + 8 * kc_; else { goff[j] = key_ * 32 + 8 * (kc_ - 8); gkr[j] = true; } } else goff[j] = key_ * NP + C_KA + hd * 64 + 8 * kc_; }
        else { const int p_ = 64 * (q_ - NKQ) + lane, dh_ = p_ >> 8, key_ = (p_ >> 2) & 63, vc_ = dh_ * 4 + (p_ & 3);
            goff[j] = MLA ? key_ * 1024 + hd * 128 + 64 + 8 * vc_ : key_ * NP + C_VA + hd * 64 + 8 * vc_; } }
#define AT_ISSUE(t, slot) do { const int row0_ = tile_row0(t); const bf16* bm_ = MLA ? KVB + (size_t)row0_ * 1024 : PROJ + (size_t)row0_ * NP; const bf16* br_ = KR + (size_t)row0_ * 32; \
        _Pragma("unroll") for (int j = 0; j < 3; ++j) { const bf16* g_ = ((MLA && gkr[j]) ? br_ : bm_) + goff[j]; \
            LAS unsigned char* d_ = lds + (dk[j] ? AT_K0 + (slot) * AT_KBUF : AT_V0 + (slot) * AT_VBUF) + dblk[j]; \
            __builtin_amdgcn_global_load_lds((const unsigned*)g_, (LAS unsigned*)d_, 16, 0, 0); } } while (0)
    constexpr int KSR = (MODE == 0) ? 4 : KS;
    bf16x8 qf[QT][KSR];
    LAS unsigned char* qrl = lds + AT_QR + w * 4096 + lane * 16;
#pragma unroll
    for (int qt = 0; qt < QT; ++qt) { const int qrow = qrow0 + 32 * qt;
        const bf16* qp = MLA ? QB + (size_t)qrow * 768 + hd * 96 : PROJ + (size_t)qrow * NP + C_QA + hd * 64;
#pragma unroll
        for (int ks = 0; ks < KSR; ++ks) qf[qt][ks] = *(const bf16x8*)(qp + 16 * ks + 8 * hh);
        if (MODE == 0) {
            const float* tb = TAB + (size_t)(qrow & 2047) * 32;
#pragma unroll
            for (int g = 0; g < 2; ++g) { const v4u own = *(const v4u*)(qp + 16 * (4 + g) + 8 * hh); v4u oth; oth.x = xshfl_u<32>(own.x); oth.y = xshfl_u<32>(own.y); oth.z = xshfl_u<32>(own.z); oth.w = xshfl_u<32>(own.w);
                const f32x4 c0 = *(const f32x4*)(tb + g * 16), c1 = *(const f32x4*)(tb + g * 16 + 4), s0 = *(const f32x4*)(tb + g * 16 + 8), s1 = *(const f32x4*)(tb + g * 16 + 12);
                const float sg = hh ? 1.f : -1.f; v4u nw;
                nw.x = pk2(bflo(own.x) * c0[0] + sg * bflo(oth.x) * s0[0], bfhi(own.x) * c0[1] + sg * bfhi(oth.x) * s0[1]); nw.y = pk2(bflo(own.y) * c0[2] + sg * bflo(oth.y) * s0[2], bfhi(own.y) * c0[3] + sg * bfhi(oth.y) * s0[3]);
                nw.z = pk2(bflo(own.z) * c1[0] + sg * bflo(oth.z) * s1[0], bfhi(own.z) * c1[1] + sg * bfhi(oth.z) * s1[1]); nw.w = pk2(bflo(own.w) * c1[2] + sg * bflo(oth.w) * s1[2], bfhi(own.w) * c1[3] + sg * bfhi(oth.w) * s1[3]);
                *(LAS v4u*)(qrl + (qt * 2 + g) * 1024) = nw; }
        } }
    if (MODE == 2) {
        LAS float* rt = (LAS float*)(lds + AT_RPB); const float* rpb = INP(I_RPB) + ((size_t)l * 8 + hd) * 15 * 31;
        for (int i = tid; i < 15 * 128; i += NTHREADS) { const int dr = i >> 7, dc = (i & 127) - 64; rt[i] = (dc >= -15 && dc <= 15) ? rpb[dr * 31 + dc + 15] * 1.4426950408889634f : 0.f; }
        asm volatile("s_waitcnt vmcnt(0) lgkmcnt(0)" ::: "memory");
    }
    constexpr float C2 = (MLA ? 0.10206207261596577f : 0.125f) * 1.4426950408889634f;
    f32x16 o[QT][2]; float m_[QT], l_[QT];
#pragma unroll
    for (int qt = 0; qt < QT; ++qt) { m_[qt] = -1e30f; l_[qt] = 0.f;
#pragma unroll
        for (int i = 0; i < 16; ++i) { o[qt][0][i] = 0.f; o[qt][1][i] = 0.f; } }
    const int rs_w = min(max(gi - 4, 0), 24);
    const int kroff = r * RS + hh * 16;
    const int vroff = ((lane >> 4) & 1) * 32 + ((lane & 15) >> 2) * 64 + (lane & 3) * 8 + hh * 4 * 64;
    AT_ISSUE(0, 0); AT_ISSUE(1, 1);
    int buf = 0, nbuf = 2;
    for (int t = 0; t < T; ++t) {
        if (t + 1 < T) asm volatile("s_waitcnt vmcnt(3)" ::: "memory"); else asm volatile("s_waitcnt vmcnt(0)" ::: "memory");
        __builtin_amdgcn_s_barrier(); asm volatile("" ::: "memory");
        if (t + 2 < T) AT_ISSUE(t + 2, nbuf);
        bool active = true; int kr = 0;
        if (MODE == 2 && t < NB) { kr = rs_min + t; active = (kr >= rs_w) && (kr < rs_w + 8); }
        if (active) {
            const LAS unsigned char* kb = lds + AT_K0 + buf * AT_KBUF + kroff; const LAS unsigned char* vb = lds + AT_V0 + buf * AT_VBUF + vroff;
            const bool band = (MODE == 2) && (t < NB);
#pragma unroll
            for (int kt = 0; kt < 2; ++kt) {
                if constexpr (QT == 2) { if (!band) {
                    const LAS unsigned char* kbt = kb + kt * 32 * RS;
                    auto qfrag = [&](int qt, int ks) -> bf16x8 { if (ks < KSR) return qf[qt][ks < KSR ? ks : 0]; return *(const LAS bf16x8*)(qrl + (qt * 2 + (ks - 4)) * 1024); };
                    auto softmax_nb = [&](f32x16& sv, int qt, bf16x8 (&pfo)[2], float& alpha) {
                        float mx = -1e30f, ps = 0.f;
#pragma unroll
                        for (int i = 0; i < 16; ++i) mx = fmaxf(mx, sv[i]);
                        mx = pair32_max(mx) * C2;
                        const float mn = fmaxf(m_[qt], mx); alpha = __builtin_amdgcn_exp2f(m_[qt] - mn); m_[qt] = mn;
#pragma unroll
                        for (int sx = 0; sx < 2; ++sx) { unsigned a[4];
#pragma unroll
                            for (int jj = 0; jj < 4; ++jj) { const int i = 8 * sx + 2 * jj;
                                const float p0 = __builtin_amdgcn_exp2f(fmaf(sv[i], C2, -mn)), p1 = __builtin_amdgcn_exp2f(fmaf(sv[i + 1], C2, -mn));
                                ps += p0 + p1; a[jj] = pk2(p0, p1); }
                            pfo[sx] = __builtin_bit_cast(bf16x8, (v4u){a[0], a[1], a[2], a[3]}); }
                        l_[qt] = l_[qt] * alpha + ps; };
                    f32x16 sA, sB;
#pragma unroll
                    for (int i = 0; i < 16; ++i) { sA[i] = 0.f; sB[i] = 0.f; }
                    bf16x8 kfr[KS];
#pragma unroll
                    for (int ks = 0; ks < KS; ++ks) { kfr[ks & 3] = *(const LAS bf16x8*)(kbt + ks * 32); sA = MFMA32(kfr[ks & 3], qfrag(0, ks), sA); }
                    __builtin_amdgcn_sched_barrier(0);
                    bf16x8 pfA[2], pfB[2]; float alA, alB;
                    bf16x8 kq[KS]; bf16x8 qq[KS];
#pragma unroll
                    for (int ks = 0; ks < KS; ++ks) { kq[ks] = *(const LAS bf16x8*)(kbt + ks * 32); qq[ks] = qfrag(1, ks); }
                    __builtin_amdgcn_sched_barrier(0);
#pragma unroll
                    for (int ks = 0; ks < KS; ++ks) sB = MFMA32(kq[ks], qq[ks], sB);
                    softmax_nb(sA, 0, pfA, alA);
#pragma unroll
                    for (int g = 0; g < KS; ++g) { __builtin_amdgcn_sched_group_barrier(0x008, 1, 0); __builtin_amdgcn_sched_group_barrier(0x002, 14, 0); }
                    __builtin_amdgcn_sched_barrier(0);
                    if (!__all(alA == 1.f)) {
#pragma unroll
                        for (int i = 0; i < 16; ++i) { o[0][0][i] *= alA; o[0][1][i] *= alA; } }
                    bf16x8 va[2], vc[2];
#pragma unroll
                    for (int sx = 0; sx < 2; ++sx) { const int rowb = (32 * kt + 16 * sx) * 64;
                        const v4i16 a00 = __builtin_amdgcn_ds_read_tr16_b64_v4i16((LAS v4i16*)(vb + rowb)), a01 = __builtin_amdgcn_ds_read_tr16_b64_v4i16((LAS v4i16*)(vb + rowb + 8 * 64));
                        const v4i16 a10 = __builtin_amdgcn_ds_read_tr16_b64_v4i16((LAS v4i16*)(vb + 4096 + rowb)), a11 = __builtin_amdgcn_ds_read_tr16_b64_v4i16((LAS v4i16*)(vb + 4096 + rowb + 8 * 64));
                        va[sx] = __builtin_shufflevector(a00, a01, 0, 1, 2, 3, 4, 5, 6, 7); vc[sx] = __builtin_shufflevector(a10, a11, 0, 1, 2, 3, 4, 5, 6, 7); }
                    __builtin_amdgcn_sched_barrier(0);
#pragma unroll
                    for (int sx = 0; sx < 2; ++sx) { o[0][0] = MFMA32(va[sx], pfA[sx], o[0][0]); o[0][1] = MFMA32(vc[sx], pfA[sx], o[0][1]); }
                    softmax_nb(sB, 1, pfB, alB);
#pragma unroll
                    for (int g = 0; g < 4; ++g) { __builtin_amdgcn_sched_group_barrier(0x008, 1, 0); __builtin_amdgcn_sched_group_barrier(0x002, 20, 0); }
                    __builtin_amdgcn_sched_barrier(0);
                    if (!__all(alB == 1.f)) {
#pragma unroll
                        for (int i = 0; i < 16; ++i) { o[1][0][i] *= alB; o[1][1][i] *= alB; } }
#pragma unroll
                    for (int sx = 0; sx < 2; ++sx) { o[1][0] = MFMA32(va[sx], pfB[sx], o[1][0]); o[1][1] = MFMA32(vc[sx], pfB[sx], o[1][1]); }
                    continue;
                } }
                f32x16 sc[QT];
#pragma unroll
                for (int qt = 0; qt < QT; ++qt)
#pragma unroll
                    for (int i = 0; i < 16; ++i) sc[qt][i] = 0.f;
#pragma unroll
                for (int ks = 0; ks < KS; ++ks) { const bf16x8 ka = *(const LAS bf16x8*)(kb + kt * 32 * RS + ks * 32);
#pragma unroll
                    for (int qt = 0; qt < QT; ++qt) { bf16x8 qb_; if (ks < KSR) qb_ = qf[qt][ks < KSR ? ks : 0]; else qb_ = *(const LAS bf16x8*)(qrl + (qt * 2 + (ks - 4)) * 1024);
                        sc[qt] = MFMA32(ka, qb_, sc[qt]); } }
                bf16x8 pf[QT][2];
#pragma unroll
                for (int qt = 0; qt < QT; ++qt) {
                    f32x16& s0 = sc[qt]; float mx = -1e30f, ps = 0.f, alpha;
                    if ((MODE == 2) && band) {
                        const bool part = qt != kt;
                        const int ilo = part ? (qt == 0 ? 0 : 12) : 0, ihi = part ? ilo + 4 : 16, sxv = qt == 0 ? 0 : 1;
                        const int ccol = 32 * qt + r; int cs = min(max(ccol - 8, 0), 48); asm volatile("" : "+v"(cs));
                        const LAS float* rt = (const LAS float*)(lds + AT_RPB) + (kr - gi + 7) * 128 + 64 - ccol + 32 * kt;
#pragma unroll
                        for (int i = 0; i < 16; ++i) if (i >= ilo && i < ihi) { const int k0 = 32 * kt + (i & 3) + 8 * (i >> 2) + 4 * hh; const bool v0 = (k0 >= cs) && (k0 < cs + 16);
                            s0[i] = v0 ? s0[i] * C2 + rt[(i & 3) + 8 * (i >> 2) + 4 * hh] : -1e30f; mx = fmaxf(mx, s0[i]); }
                        mx = pair32_max(mx);
                        const float mn = fmaxf(m_[qt], mx); alpha = __builtin_amdgcn_exp2f(m_[qt] - mn); m_[qt] = mn;
#pragma unroll
                        for (int sx = 0; sx < 2; ++sx) { if (part && sx != sxv) continue;
                            unsigned a[4];
#pragma unroll
                            for (int jj = 0; jj < 4; ++jj) { const int i = 8 * sx + 2 * jj;
                                if (!(i >= ilo && i < ihi)) { a[jj] = 0u; continue; }
                                float p0 = __builtin_amdgcn_exp2f(s0[i] - mn), p1 = __builtin_amdgcn_exp2f(s0[i + 1] - mn);
                                p0 = s0[i] > -1e29f ? p0 : 0.f; p1 = s0[i + 1] > -1e29f ? p1 : 0.f;
                                ps += p0 + p1; a[jj] = pk2(p0, p1); }
                            pf[qt][sx] = __builtin_bit_cast(bf16x8, (v4u){a[0], a[1], a[2], a[3]}); }
                    } else {
#pragma unroll
                        for (int i = 0; i < 16; ++i) mx = fmaxf(mx, s0[i]);
                        mx = pair32_max(mx) * C2;
                        const float mn = fmaxf(m_[qt], mx); alpha = __builtin_amdgcn_exp2f(m_[qt] - mn); m_[qt] = mn;
#pragma unroll
                        for (int sx = 0; sx < 2; ++sx) { unsigned a[4];
#pragma unroll
                            for (int jj = 0; jj < 4; ++jj) { const int i = 8 * sx + 2 * jj;
                                const float p0 = __builtin_amdgcn_exp2f(fmaf(s0[i], C2, -mn)), p1 = __builtin_amdgcn_exp2f(fmaf(s0[i + 1], C2, -mn));
                                ps += p0 + p1; a[jj] = pk2(p0, p1); }
                            pf[qt][sx] = __builtin_bit_cast(bf16x8, (v4u){a[0], a[1], a[2], a[3]}); }
                    }
                    l_[qt] = l_[qt] * alpha + ps;
                    if (!__all(alpha == 1.f)) {
#pragma unroll
                        for (int i = 0; i < 16; ++i) { o[qt][0][i] *= alpha; o[qt][1][i] *= alpha; } }
                }
#pragma unroll
                for (int sx = 0; sx < 2; ++sx) {
                    const int rowb = (32 * kt + 16 * sx) * 64;
                    const v4i16 a00 = __builtin_amdgcn_ds_read_tr16_b64_v4i16((LAS v4i16*)(vb + rowb)), a01 = __builtin_amdgcn_ds_read_tr16_b64_v4i16((LAS v4i16*)(vb + rowb + 8 * 64));
                    const v4i16 a10 = __builtin_amdgcn_ds_read_tr16_b64_v4i16((LAS v4i16*)(vb + 4096 + rowb)), a11 = __builtin_amdgcn_ds_read_tr16_b64_v4i16((LAS v4i16*)(vb + 4096 + rowb + 8 * 64));
                    const bf16x8 va = __builtin_shufflevector(a00, a01, 0, 1, 2, 3, 4, 5, 6, 7), vc = __builtin_shufflevector(a10, a11, 0, 1, 2, 3, 4, 5, 6, 7);
#pragma unroll
                    for (int qt = 0; qt < QT; ++qt) { if ((MODE == 2) && band && (qt != kt) && sx != (qt == 0 ? 0 : 1)) continue;
                        o[qt][0] = MFMA32(va, pf[qt][sx], o[qt][0]); o[qt][1] = MFMA32(vc, pf[qt][sx], o[qt][1]); } }
            }
        }
        buf = buf == 2 ? 0 : buf + 1; nbuf = nbuf == 2 ? 0 : nbuf + 1;
    }
#pragma unroll
    for (int qt = 0; qt < QT; ++qt) {
        const float lt = pair32_sum(l_[qt]), inv = 1.f / lt;
        bf16* op = Yo + (size_t)(qrow0 + 32 * qt) * 512 + hd * 64 + 4 * hh;
#pragma unroll
        for (int g4 = 0; g4 < 4; ++g4) { v2u w0, w1; w0.x = pk2(o[qt][0][4 * g4] * inv, o[qt][0][4 * g4 + 1] * inv); w0.y = pk2(o[qt][0][4 * g4 + 2] * inv, o[qt][0][4 * g4 + 3] * inv);
            w1.x = pk2(o[qt][1][4 * g4] * inv, o[qt][1][4 * g4 + 1] * inv); w1.y = pk2(o[qt][1][4 * g4 + 2] * inv, o[qt][1][4 * g4 + 3] * inv);
            *(v2u*)(op + 8 * g4) = w0; *(v2u*)(op + 32 + 8 * g4) = w1; } }
    __syncthreads();
#undef AT_ISSUE
}
__device__ __forceinline__ void phase_attn(const Ctx& C, int l) {
    for (int u = C.bid; u < 512; u += C.G) attn_unit<0>(C, l, u);
    for (int u = C.bid; u < 512; u += C.G) attn_unit<2>(C, l, u);
    if (l < NL - 1) for (int u = C.bid; u < 256; u += C.G) { if (u < 128) attn_unit<1>(C, l, u); else attn_unit<3>(C, l, u - 128); }
}

__device__ __forceinline__ float reduce16(float (&v)[16], int lane) {
#pragma unroll
    for (int i = 0; i < 8; ++i) { const bool hi = lane & 32; const float keep = hi ? v[i + 8] : v[i], send = hi ? v[i] : v[i + 8]; v[i] = keep + xshfl<32>(send); }
#pragma unroll
    for (int i = 0; i < 4; ++i) { const bool hi = lane & 16; const float keep = hi ? v[i + 4] : v[i], send = hi ? v[i] : v[i + 4]; v[i] = keep + xshfl<16>(send); }
#pragma unroll
    for (int i = 0; i < 2; ++i) { const bool hi = lane & 8; const float keep = hi ? v[i + 2] : v[i], send = hi ? v[i] : v[i + 2]; v[i] = keep + xshfl<8>(send); }
    { const bool hi = lane & 4; const float keep = hi ? v[1] : v[0], send = hi ? v[0] : v[1]; v[0] = keep + xshfl<4>(send); }
    v[0] += xshfl<2>(v[0]); v[0] += xshfl<1>(v[0]);
    return v[0];
}
__device__ __forceinline__ void phase_ln1(const Ctx& C, int l) {
    int lane = C.lane; OPAQUE(lane); const int gw = C.bid * NWAVES + C.wave, NGW = C.G * NWAVES;
    LAS float* Wr = (LAS float*)C.lds;
    const float* wr = INP(I_WROUTER) + (size_t)l * 1024 * 16;
    for (int idx = C.tid; idx < 16384; idx += NTHREADS) { const int c = idx >> 4, e = idx & 15; Wr[e * 1024 + c] = wr[idx]; }
    __syncthreads();
    const bf16* Yb = WSP(bf16, WS_Y); float* X = WSP(float, WS_X); bf16* H2 = WSP(bf16, WS_HB); float* AFF = WSP(float, WS_AFF);
    const float* MODS = WSP(float, WS_MODS) + (size_t)l * 17 * 6144;
    const float* lg = INP(I_LN1G) + l * 1024; const float* lb = INP(I_LN1B) + l * 1024;
    const int myexp = ((lane >> 5) & 1) * 8 + ((lane >> 4) & 1) * 4 + ((lane >> 3) & 1) * 2 + ((lane >> 2) & 1);
    const int nrp = (l == NL - 1 ? ML : MT) / 2;
    f32x4 nx[2][4]; v4u ny[2][2];
#define LN1_LOAD(rp_) do { const int r_ = 2 * (rp_); _Pragma("unroll") for (int j = 0; j < 2; ++j) { const int c = 8 * (lane + 64 * j); \
        nx[0][2 * j] = *(const f32x4*)(X + (size_t)r_ * DM + c); nx[0][2 * j + 1] = *(const f32x4*)(X + (size_t)r_ * DM + c + 4); nx[1][2 * j] = *(const f32x4*)(X + (size_t)(r_ + 1) * DM + c); nx[1][2 * j + 1] = *(const f32x4*)(X + (size_t)(r_ + 1) * DM + c + 4); \
        ny[0][j] = *(const v4u*)(Yb + (size_t)r_ * DM + c); ny[1][j] = *(const v4u*)(Yb + (size_t)(r_ + 1) * DM + c); } } while (0)
    if (gw < nrp) LN1_LOAD(gw);
    for (int rp = gw; rp < nrp; rp += NGW) {
        const int row = 2 * rp; const int mr = row < ML ? (row >> 11) : 16; const float* md = MODS + (size_t)mr * 6144;
        f32x4 v[2][4]; float sa = 0.f, sb = 0.f;
#pragma unroll
        for (int j = 0; j < 2; ++j) { const int c = 8 * (lane + 64 * j); const f32x4 g1a = *(const f32x4*)(md + 2048 + c), g1b = *(const f32x4*)(md + 2048 + c + 4);
            v[0][2 * j] = nx[0][2 * j] * DN_ALPHA + g1a * pg8::unpack4((v2u){ny[0][j].x, ny[0][j].y}); v[0][2 * j + 1] = nx[0][2 * j + 1] * DN_ALPHA + g1b * pg8::unpack4((v2u){ny[0][j].z, ny[0][j].w});
            v[1][2 * j] = nx[1][2 * j] * DN_ALPHA + g1a * pg8::unpack4((v2u){ny[1][j].x, ny[1][j].y}); v[1][2 * j + 1] = nx[1][2 * j + 1] * DN_ALPHA + g1b * pg8::unpack4((v2u){ny[1][j].z, ny[1][j].w}); }
        if (rp + NGW < nrp) LN1_LOAD(rp + NGW);
#pragma unroll
        for (int j = 0; j < 4; ++j) { sa += (v[0][j][0] + v[0][j][1]) + (v[0][j][2] + v[0][j][3]); sb += (v[1][j][0] + v[1][j][1]) + (v[1][j][2] + v[1][j][3]); }
        const float mean0 = wave_sum(sa) * (1.f / 1024.f), mean1 = wave_sum(sb) * (1.f / 1024.f); float qa = 0.f, qb = 0.f;
#pragma unroll
        for (int j = 0; j < 4; ++j) { v[0][j] = v[0][j] - mean0; v[1][j] = v[1][j] - mean1;
            qa += (v[0][j][0] * v[0][j][0] + v[0][j][1] * v[0][j][1]) + (v[0][j][2] * v[0][j][2] + v[0][j][3] * v[0][j][3]);
            qb += (v[1][j][0] * v[1][j][0] + v[1][j][1] * v[1][j][1]) + (v[1][j][2] * v[1][j][2] + v[1][j][3] * v[1][j][3]); }
        const float rstd0 = 1.f / sqrtf(wave_sum(qa) * (1.f / 1024.f) + LN_EPS), rstd1 = 1.f / sqrtf(wave_sum(qb) * (1.f / 1024.f) + LN_EPS);
        float lg0[16], lg1[16];
#pragma unroll
        for (int e = 0; e < 16; ++e) { lg0[e] = 0.f; lg1[e] = 0.f; }
#pragma unroll
        for (int j = 0; j < 2; ++j) { const int c0 = 8 * (lane + 64 * j); f32x4 ha[2], hb[2];
#pragma unroll
            for (int h = 0; h < 2; ++h) { const int c = c0 + 4 * h;
                const f32x4 gg = *(const f32x4*)(lg + c), bb = *(const f32x4*)(lb + c), scl = *(const f32x4*)(md + 4096 + c) + 1.f, shf = *(const f32x4*)(md + 3072 + c);
                const f32x4 xa = v[0][2 * j + h] * rstd0 * gg + bb, xb = v[1][2 * j + h] * rstd1 * gg + bb;
                *(f32x4*)(X + (size_t)row * DM + c) = xa; *(f32x4*)(X + (size_t)(row + 1) * DM + c) = xb;
                ha[h] = xa * scl + shf; hb[h] = xb * scl + shf; }
            *(v4u*)(H2 + (size_t)row * DM + c0) = pg8::pack8(ha[0], ha[1]); *(v4u*)(H2 + (size_t)(row + 1) * DM + c0) = pg8::pack8(hb[0], hb[1]);
#pragma unroll
            for (int h = 0; h < 2; ++h) {
#pragma unroll
                for (int e = 0; e < 16; ++e) { const f32x4 wv = *(const LAS f32x4*)(Wr + e * 1024 + c0 + 4 * h);
                    lg0[e] += (ha[h][0] * wv[0] + ha[h][1] * wv[1]) + (ha[h][2] * wv[2] + ha[h][3] * wv[3]); lg1[e] += (hb[h][0] * wv[0] + hb[h][1] * wv[1]) + (hb[h][2] * wv[2] + hb[h][3] * wv[3]); }
                asm volatile("" ::: "memory"); } }
        const float t0 = reduce16(lg0, lane), t1 = reduce16(lg1, lane);
        float m0 = t0, m1 = t1;
        m0 = fmaxf(m0, xshfl<4>(m0)); m1 = fmaxf(m1, xshfl<4>(m1)); m0 = fmaxf(m0, xshfl<8>(m0)); m1 = fmaxf(m1, xshfl<8>(m1)); m0 = fmaxf(m0, xshfl<16>(m0)); m1 = fmaxf(m1, xshfl<16>(m1)); m0 = pair32_max(m0); m1 = pair32_max(m1);
        const float p0 = expf(t0 - m0), p1 = expf(t1 - m1); float d0 = p0, d1 = p1;
        d0 += xshfl<4>(d0); d1 += xshfl<4>(d1); d0 += xshfl<8>(d0); d1 += xshfl<8>(d1); d0 += xshfl<16>(d0); d1 += xshfl<16>(d1); d0 = pair32_sum(d0); d1 = pair32_sum(d1);
        if ((lane & 3) == 0) { AFF[(size_t)row * 16 + myexp] = p0 / d0; AFF[(size_t)(row + 1) * 16 + myexp] = p1 / d1; }
    }
#undef LN1_LOAD
}

__device__ __forceinline__ void phase_topk(const Ctx& Cc, int l) {
    Ctx C = Cc; OPAQUE(C.tid);
    LAS unsigned long long* a = (LAS unsigned long long*)C.lds;
    const float* AFF = WSP(float, WS_AFF); int* SEL = WSP(int, WS_SEL); int* IDX = WSP(int, WS_IDX);
    const int nitem = l == NL - 1 ? 256 : 512;
    for (int item = C.bid; item < nitem; item += C.G) {
        const bool lat = item < 256; const int it = lat ? item : item - 256, b = it >> 4, e = it & 15;
        const int N = lat ? 2048 : 256, cap = lat ? CAPL : CAPC, base = lat ? b * 2048 : ML + b * 256, slotbase = lat ? b * CAPL : NBATCH * CAPL + b * CAPC;
        for (int t = C.tid; t < N; t += NTHREADS) a[t] = ((unsigned long long)__float_as_uint(AFF[(size_t)(base + t) * 16 + e]) << 32) | (unsigned long long)(0xFFFFFFFFu - (unsigned)t);
        __syncthreads();
        for (int k = 2; k <= N; k <<= 1)
            for (int j = k >> 1; j > 0; j >>= 1) {
                for (int p = C.tid; p < N / 2; p += NTHREADS) {
                    const int i = ((p & ~(j - 1)) << 1) | (p & (j - 1)), ij = i | j;
                    const unsigned long long x = a[i], y = a[ij];
                    const bool desc = (i & k) == 0;
                    if (desc ? (x < y) : (x > y)) { a[i] = y; a[ij] = x; }
                }
                __syncthreads();
            }
        for (int p = C.tid; p < N; p += NTHREADS) { const int tok = (int)(0xFFFFFFFFu - (unsigned)a[p]);
            SEL[(size_t)(base + tok) * 16 + e] = p < cap ? p : -1;
            if (p < cap) IDX[e * ROWS_E + slotbase + p] = base + tok; }
        __syncthreads();
    }
}

__device__ __forceinline__ void phase_gather(const Ctx& C) {
    int lane = C.lane; OPAQUE(lane); const int gw = C.bid * NWAVES + C.wave, NGW = C.G * NWAVES;
    const int* IDX = WSP(int, WS_IDX); const bf16* H2 = WSP(bf16, WS_HB); bf16* XG = WSP(bf16, WS_XG);
    for (int r = gw; r < MG; r += NGW) { const int src = IDX[r]; const v4u* s = (const v4u*)(H2 + (size_t)src * DM); v4u* d = (v4u*)(XG + (size_t)r * DM);
        const v4u a = s[lane], b = s[lane + 64]; d[lane] = a; d[lane + 64] = b; }
}

__device__ __forceinline__ void phase_combine(const Ctx& C, int l) {
    int lane = C.lane; OPAQUE(lane); const int gw = C.bid * NWAVES + C.wave, NGW = C.G * NWAVES;
    const bf16* Y = WSP(bf16, WS_Y); float* X = WSP(float, WS_X); bf16* H = WSP(bf16, WS_HB); const float* AFF = WSP(float, WS_AFF); const int* SEL = WSP(int, WS_SEL);
    const float* MODS = WSP(float, WS_MODS) + (size_t)l * 17 * 6144; const float* MODN = MODS + 17 * 6144;
    const float* lg = INP(I_LN2G) + l * 1024; const float* lb = INP(I_LN2B) + l * 1024;
    const int nrp = (l == NL - 1 ? ML : MT) / 2;
    f32x4 nxa[4], nxb[4]; int nsel = 0; float naff = 0.f;
#define CMB_LOAD(rp_) do { const int r_ = 2 * (rp_); nsel = SEL[(size_t)r_ * 16 + (lane & 31)]; naff = AFF[(size_t)r_ * 16 + (lane & 31)]; \
        _Pragma("unroll") for (int j = 0; j < 2; ++j) _Pragma("unroll") for (int h = 0; h < 2; ++h) { const int c = 8 * (lane + 64 * j) + 4 * h; nxa[2 * j + h] = *(const f32x4*)(X + (size_t)r_ * DM + c); nxb[2 * j + h] = *(const f32x4*)(X + (size_t)(r_ + 1) * DM + c); } } while (0)
    if (gw < nrp) CMB_LOAD(gw);
    for (int rp = gw; rp < nrp; rp += NGW) {
        const int row = 2 * rp; const bool lat = row < ML; const int mr = lat ? (row >> 11) : 16; const float* md = MODS + (size_t)mr * 6144;
        const int rb = lat ? (row >> 11) * CAPL : NBATCH * CAPL + ((row - ML) >> 8) * CAPC;
        const int selv = nsel; const float affv = naff;
        f32x4 xa[4], xb[4];
#pragma unroll
        for (int j = 0; j < 4; ++j) { xa[j] = nxa[j]; xb[j] = nxb[j]; }
        if (rp + NGW < nrp) CMB_LOAD(rp + NGW);
        unsigned long long bal = __ballot(selv >= 0);
        unsigned ma = (unsigned)(bal & 0xffffu), mb = (unsigned)((bal >> 16) & 0xffffu);
        f32x4 acca[4], accb[4];
#pragma unroll
        for (int j = 0; j < 4; ++j) { acca[j] = (f32x4){0.f, 0.f, 0.f, 0.f}; accb[j] = (f32x4){0.f, 0.f, 0.f, 0.f}; }
        while (ma | mb) {
            const int ea = ma ? __builtin_ctz(ma) : 0, eb = mb ? __builtin_ctz(mb) : 0;
            const int sa = __builtin_amdgcn_readlane(selv, ea), sb = __builtin_amdgcn_readlane(selv, 16 + eb); float fa = __uint_as_float(__builtin_amdgcn_readlane(__float_as_uint(affv), ea)), fb = __uint_as_float(__builtin_amdgcn_readlane(__float_as_uint(affv), 16 + eb));
            if (!ma) fa = 0.f; if (!mb) fb = 0.f;
            const bf16* ya = Y + ((size_t)ea * ROWS_E + rb + (ma ? sa : 0)) * DM; const bf16* yb = Y + ((size_t)eb * ROWS_E + rb + (mb ? sb : 0)) * DM;
            v4u wa[2], wb[2];
#pragma unroll
            for (int j = 0; j < 2; ++j) { wa[j] = *(const v4u*)(ya + 8 * (lane + 64 * j)); wb[j] = *(const v4u*)(yb + 8 * (lane + 64 * j)); }
#pragma unroll
            for (int j = 0; j < 2; ++j) { acca[2 * j] = acca[2 * j] + pg8::unpack4((v2u){wa[j].x, wa[j].y}) * fa; acca[2 * j + 1] = acca[2 * j + 1] + pg8::unpack4((v2u){wa[j].z, wa[j].w}) * fa;
                accb[2 * j] = accb[2 * j] + pg8::unpack4((v2u){wb[j].x, wb[j].y}) * fb; accb[2 * j + 1] = accb[2 * j + 1] + pg8::unpack4((v2u){wb[j].z, wb[j].w}) * fb; }
            ma &= ma - 1; mb &= mb - 1;
        }
        float sma = 0.f, smb = 0.f;
#pragma unroll
        for (int j = 0; j < 2; ++j)
#pragma unroll
            for (int h = 0; h < 2; ++h) { const int q = 2 * j + h; const f32x4 g2 = *(const f32x4*)(md + 5120 + 8 * (lane + 64 * j) + 4 * h); xa[q] = xa[q] * DN_ALPHA + g2 * acca[q]; xb[q] = xb[q] * DN_ALPHA + g2 * accb[q];
                sma += (xa[q][0] + xa[q][1]) + (xa[q][2] + xa[q][3]); smb += (xb[q][0] + xb[q][1]) + (xb[q][2] + xb[q][3]); }
        const float mean0 = wave_sum(sma) * (1.f / 1024.f), mean1 = wave_sum(smb) * (1.f / 1024.f); float qa = 0.f, qb = 0.f;
#pragma unroll
        for (int j = 0; j < 4; ++j) { xa[j] = xa[j] - mean0; xb[j] = xb[j] - mean1;
            qa += (xa[j][0] * xa[j][0] + xa[j][1] * xa[j][1]) + (xa[j][2] * xa[j][2] + xa[j][3] * xa[j][3]); qb += (xb[j][0] * xb[j][0] + xb[j][1] * xb[j][1]) + (xb[j][2] * xb[j][2] + xb[j][3] * xb[j][3]); }
        const float rstd0 = 1.f / sqrtf(wave_sum(qa) * (1.f / 1024.f) + LN_EPS), rstd1 = 1.f / sqrtf(wave_sum(qb) * (1.f / 1024.f) + LN_EPS);
#pragma unroll
        for (int j = 0; j < 2; ++j) { const int c0 = 8 * (lane + 64 * j); f32x4 ya[2], yb[2];
#pragma unroll
            for (int h = 0; h < 2; ++h) { const int c = c0 + 4 * h; const f32x4 gg = *(const f32x4*)(lg + c), bb = *(const f32x4*)(lb + c);
                ya[h] = xa[2 * j + h] * rstd0 * gg + bb; yb[h] = xb[2 * j + h] * rstd1 * gg + bb; }
            if (l < NL - 1) { const float* mn = MODN + (size_t)mr * 6144; f32x4 ha[2], hb[2];
#pragma unroll
                for (int h = 0; h < 2; ++h) { const int c = c0 + 4 * h; *(f32x4*)(X + (size_t)row * DM + c) = ya[h]; *(f32x4*)(X + (size_t)(row + 1) * DM + c) = yb[h];
                    const f32x4 scl = *(const f32x4*)(mn + 1024 + c) + 1.f, shf = *(const f32x4*)(mn + c); ha[h] = ya[h] * scl + shf; hb[h] = yb[h] * scl + shf; }
                *(v4u*)(H + (size_t)row * DM + c0) = pg8::pack8(ha[0], ha[1]); *(v4u*)(H + (size_t)(row + 1) * DM + c0) = pg8::pack8(hb[0], hb[1]); }
            else if (lat) {
#pragma unroll
                for (int h = 0; h < 2; ++h) { const int c = c0 + 4 * h; *(f32x4*)(C.out + (size_t)row * DM + c) = ya[h]; *(f32x4*)(C.out + (size_t)(row + 1) * DM + c) = yb[h]; } } }
    }
#undef CMB_LOAD
}

enum { PH_MODS = 0, PH_MOD0, PH_WIN, PH_PREP, PH_CONV, PH_UQ, PH_UKV, PH_ATTN, PH_MERGE, PH_WOUT, PH_LN1, PH_TOPK, PH_GATHER, PH_GU, PH_DOWN, PH_COMB, PH_COUNT };
template <int PH> __device__ __forceinline__ void run_phase(const Ctx& C, int l) {
    if constexpr (PH == PH_MODS) { phase_mods(C); __syncthreads(); conv_weights(C, 0, 0, 100, 0, C.G); }
    if constexpr (PH == PH_MOD0) { phase_mod0(C); }
    if constexpr (PH == PH_WIN) { pg8::ProbPlain P{WSP(bf16, WS_HB), WSW(bf16, WS_WIN, l), 1024, 1024, 1024}; pg8::EpiWin E{WSP(bf16, WS_R)};
        if (l == NL - 1) { pg8::OrderWinLast S; S.init(C.G, C.bid); pg8::gemm_phase(C.lds, P, S, E, C.wave); }
        else { pg8::Order<1> S; S.init(MT / 256, NP / 256, C.G, C.bid); pg8::gemm_phase(C.lds, P, S, E, C.wave); }
        if (l < NL - 1) { const int rem = (MT / 256 * (NP / 256)) % C.G; __syncthreads(); conv_weights(C, l + 1, 0, 20, rem, C.G - rem); } }
    if constexpr (PH == PH_PREP) { phase_prep(C, l); }
    if constexpr (PH == PH_CONV) { phase_conv(C, l); }
    if constexpr (PH == PH_UQ) { pg8::ProbUp2 P{WSP(bf16, WS_CQN), WSP(bf16, WS_CKVN), WSW(bf16, WS_WUQ, l), WSW(bf16, WS_WUKV, l), 256, 256, 256};
        pg8::OrderUp2 S; S.init((l == NL - 1 ? ML : MT) / 256, C.G, C.bid); pg8::EpiUp2 E{WSP(bf16, WS_QB), WSP(bf16, WS_KVB)}; pg8::gemm_phase(C.lds, P, S, E, C.wave); }
    if constexpr (PH == PH_ATTN) { phase_attn(C, l); }
    if constexpr (PH == PH_MERGE) { pg8::ProbSeg3 P{WSP(bf16, WS_YA), WSW(bf16, WS_WOA, l), 512, 512, 512, (size_t)(36 * MiB / 2), (size_t)(1 * MiB / 2)};
        pg8::Order<3> S; S.init((l == NL - 1 ? ML : MT) / 256, 4, C.G, C.bid); pg8::EpiMerge E{WSP(bf16, WS_R), WSP(bf16, WS_HB)}; pg8::gemm_phase(C.lds, P, S, E, C.wave);
        if (l < NL - 1) { const int rem = (MT / 256 * 4) % C.G; __syncthreads(); conv_weights(C, l + 1, 20, 56, rem, C.G - rem); } }
    if constexpr (PH == PH_WOUT) { pg8::ProbPlain P{WSP(bf16, WS_HB), WSW(bf16, WS_WOUT, l), 1024, 1024, 1024}; pg8::Order<1> S; S.init((l == NL - 1 ? ML : MT) / 256, 4, C.G, C.bid);
        pg8::EpiBf16 E{WSP(bf16, WS_Y), 1024}; pg8::gemm_phase(C.lds, P, S, E, C.wave);
        if (l < NL - 1) { const int rem = (MT / 256 * 4) % C.G; __syncthreads(); conv_weights(C, l + 1, 56, 80, rem, C.G - rem); } }
    if constexpr (PH == PH_LN1) { phase_ln1(C, l); }
    if constexpr (PH == PH_TOPK) { phase_topk(C, l); }
    if constexpr (PH == PH_GATHER) { phase_gather(C); }
    if constexpr (PH == PH_GU) { pg8::OrderOrd S; S.o.init(l == NL - 1 ? 256 : 288, 8, C.G, C.bid, l == NL - 1 ? 16 : 0);
        LAS int* lidx = (LAS int*)(C.lds + LIDX_OFF); const int* IDXg = WSP(int, WS_IDX);
        { pg8::Unit uu; for (int i = 0; i < 10 && S.next(i, uu); ++i) if (C.tid < 256) lidx[i * 256 + C.tid] = IDXg[uu.pm * 256 + C.tid]; }
        __syncthreads();
        pg8::ProbMoEGather P{WSP(bf16, WS_HB), WSW(bf16, WS_WGU, l), lidx, 1024, 1024, 1024, 2048};
        pg8::EpiSwiGLU E{WSP(bf16, WS_HID)}; pg8::gemm_phase(C.lds, P, S, E, C.wave); }
    if constexpr (PH == PH_DOWN) { pg8::ProbMoE P{WSP(bf16, WS_HID), WSW(bf16, WS_WD, l), 1024, 1024, 1024, 1024}; pg8::Order<1> S; S.init(l == NL - 1 ? 256 : 288, 4, C.G, C.bid, l == NL - 1 ? 16 : 0);
        pg8::EpiBf16 E{WSP(bf16, WS_Y), 1024}; pg8::gemm_phase(C.lds, P, S, E, C.wave);
        if (l < NL - 1) { const int rem = (288 * 4) % C.G; __syncthreads(); conv_weights(C, l + 1, 80, 100, rem, C.G - rem); } }
    if constexpr (PH == PH_COMB) { phase_combine(C, l); }
}
template <int PH> __device__ __forceinline__ void call_phase(const Ctx& Cin, int l) { Ctx C = Cin; C.lane = lane_id(); OPAQUE(C.lane); asm volatile("" : "+s"(C.wave)); C.tid = C.wave * 64 + C.lane; asm volatile("" : "+s"(l)); asm volatile("" : "+s"(C.G)); asm volatile("" : "+s"(C.bid)); { unsigned long long w_ = (unsigned long long)C.ws; unsigned lo_ = (unsigned)w_, hi_ = (unsigned)(w_ >> 32); asm volatile("" : "+s"(lo_)); asm volatile("" : "+s"(hi_)); C.ws = (unsigned char*)(GAS unsigned char*)(((unsigned long long)hi_ << 32) | lo_); } run_phase<PH>(C, l); }
__global__ void __launch_bounds__(NTHREADS, 2) mega_fwd(Args args) {
    extern __shared__ __attribute__((aligned(16))) unsigned char lds_raw[];
    Ctx C;
    C.lds = (LAS unsigned char*)lds_raw;
    C.tid = threadIdx.x; C.lane = C.tid & 63; C.wave = __builtin_amdgcn_readfirstlane(C.tid >> 6);
    C.G = gridDim.x; C.bid = blockIdx.x;
    C.in = args.in; C.ws = (unsigned char*)(GAS unsigned char*)args.ws; C.out = (float*)(GAS float*)args.out;
    volatile LAS unsigned* MISC = (volatile LAS unsigned*)(C.lds + MISC_OFF);
    for (int u = C.tid; u < (LDS_BYTES - LDSCTL_OFF) / 4; u += NTHREADS) ((LAS unsigned*)(C.lds + LDSCTL_OFF))[u] = 0u;
    __syncthreads();
    XcdBarrier bar = xcd_barrier_post((unsigned*)(C.ws + WS_CTL) + 4096, MISC + 8, C.wave);
    call_phase<PH_MODS>(C, 0); xcd_barrier(bar);
    call_phase<PH_MOD0>(C, 0); xcd_barrier(bar);
    for (int l = 0; l < NL; ++l) {
        call_phase<PH_WIN>(C, l); xcd_barrier(bar);
        call_phase<PH_PREP>(C, l); xcd_barrier(bar);
        call_phase<PH_CONV>(C, l); __syncthreads(); call_phase<PH_UQ>(C, l); xcd_barrier(bar);
        call_phase<PH_ATTN>(C, l); xcd_barrier(bar);
        call_phase<PH_MERGE>(C, l); xcd_barrier(bar);
        call_phase<PH_WOUT>(C, l); xcd_barrier(bar);
        call_phase<PH_LN1>(C, l); xcd_barrier(bar);
        call_phase<PH_TOPK>(C, l); xcd_barrier(bar);
        call_phase<PH_GU>(C, l); xcd_barrier(bar);
        call_phase<PH_DOWN>(C, l); xcd_barrier(bar);
        call_phase<PH_COMB>(C, l); if (l < NL - 1) xcd_barrier(bar);
    }
}

extern "C" void kernel_launch(void* const* d_in, const int* in_sizes, int n_in, void* d_out, int out_size, void* d_ws, size_t ws_size, hipStream_t stream) {
    static int grid = 0;
    if (grid == 0) {
        if (n_in != 28 || out_size != ML * DM || ws_size < WS_END) { fprintf(stderr, "kernel_launch: unexpected shapes: n_in %d out %d ws %zu (need %zu)\n", n_in, out_size, ws_size, (size_t)WS_END); grid = -1; return; }
        int dev = 0, cus = 0, per_cu = 0;
        if (hipGetDevice(&dev) != hipSuccess || hipDeviceGetAttribute(&cus, hipDeviceAttributeMultiprocessorCount, dev) != hipSuccess) { grid = -1; return; }
        if (hipFuncSetAttribute((const void*)mega_fwd, hipFuncAttributeMaxDynamicSharedMemorySize, LDS_BYTES) != hipSuccess) { fprintf(stderr, "kernel_launch: hipFuncSetAttribute failed\n"); grid = -1; return; }
        if (hipOccupancyMaxActiveBlocksPerMultiprocessor(&per_cu, (const void*)mega_fwd, NTHREADS, LDS_BYTES) != hipSuccess || per_cu < 1) { fprintf(stderr, "kernel_launch: occupancy query says %d\n", per_cu); grid = -1; return; }
        (void)hipGetLastError();
        grid = cus;
    }
    if (grid < 0) return;
    (void)hipMemsetAsync((char*)d_ws + WS_CTL, 0, CTL_ZERO_BYTES, stream);
    Args a{};
    for (int i = 0; i < 28; ++i) a.in[i] = (const float*)d_in[i];
    a.out = (float*)d_out; a.ws = (unsigned char*)d_ws;
    hipLaunchKernelGGL(mega_fwd, dim3(grid), dim3(NTHREADS), LDS_BYTES, stream, a);
}
```

```cpp
#include <hip/hip_runtime.h>
#include <cstdio>
#include <cstdint>
#include <utility>

#ifndef MK_ONE_LAUNCH
#define MK_ONE_LAUNCH 0
#endif

#define GAS __attribute__((address_space(1)))
#define LAS __attribute__((address_space(3)))
typedef unsigned short bf16;
typedef unsigned v4u __attribute__((ext_vector_type(4)));
typedef unsigned v2u __attribute__((ext_vector_type(2)));
typedef float f32x4 __attribute__((ext_vector_type(4)));
typedef float f32x2 __attribute__((ext_vector_type(2)));
typedef short bf16x8 __attribute__((ext_vector_type(8)));

constexpr int NL = 4, DM = 1024, NBATCH = 16, SQ = 2048, CL = 256;
constexpr int ML = NBATCH * SQ, MC = NBATCH * CL, MT = ML + MC;
constexpr int NP = 6144;
constexpr int C_QA = 0, C_KA = 512, C_VA = 1024, C_CQ = 1536, C_CKV = 1792, C_KR = 1920, C_CIN = 2048, C_GT = 3072;
constexpr int NE = 16, CAPL = 256, CAPC = 32, ROWS_E = NBATCH * CAPL + NBATCH * CAPC, MG = NE * ROWS_E;
constexpr float LN_EPS = 1e-5f, RMS_EPS = 1e-6f, DN_ALPHA = 1.681792830507429f;
constexpr int NWAVES = 8, NTHREADS = 512;

constexpr size_t MiB = 1u << 20;
constexpr size_t WS_CTL = 0, CTL_ZERO_BYTES = 1 * MiB;
constexpr size_t WS_MODS = 1 * MiB;
constexpr size_t WS_TAB = 3 * MiB;
constexpr size_t WS_AFF = 4 * MiB;
constexpr size_t WS_SEL = 7 * MiB;
constexpr size_t WS_IDX = 10 * MiB;
constexpr size_t WS_KR = 11 * MiB;
constexpr size_t WS_WIN = 14 * MiB;
constexpr size_t WS_WUQ = 26 * MiB;
constexpr size_t WS_WUKV = 26 * MiB + 512 * 1024;
constexpr size_t WS_WOA = 27 * MiB, WS_WOB = 28 * MiB, WS_WPW2 = 29 * MiB;
constexpr size_t WS_WOUT = 30 * MiB;
constexpr size_t WS_WGU = 32 * MiB;
constexpr size_t WS_WD = 96 * MiB;
constexpr size_t WS_X = 128 * MiB;
constexpr size_t WS_HB = 272 * MiB;
constexpr size_t WS_QB = 344 * MiB;
constexpr size_t WS_KVB = 398 * MiB;
constexpr size_t WS_U = 542 * MiB;
constexpr size_t WS_YA = 470 * MiB;
constexpr size_t WS_YB = 506 * MiB;
constexpr size_t WS_CQN = WS_YB, WS_CKVN = WS_YB + 18 * MiB;
constexpr size_t WS_R = 578 * MiB;
constexpr size_t WS_XG = WS_R, WS_HID = WS_R + 144 * MiB, WS_Y = WS_R + 288 * MiB;
constexpr size_t WS_YP = WS_R;
constexpr size_t WS_STAT = 13 * MiB + 512 * 1024;
constexpr size_t WS_WSET = 996 * MiB;
constexpr size_t WS_END = WS_R + 432 * MiB + 114 * MiB;

constexpr int RING_BYTES = 131072, LDSCTL_OFF = RING_BYTES, MISC_OFF = LDSCTL_OFF + 320, LIDX_OFF = RING_BYTES + 1024, LDS_BYTES = 147456;

#define LDS_WAIT() asm volatile("s_waitcnt lgkmcnt(0)" ::: "memory")
#define VM_WAIT() asm volatile("s_waitcnt vmcnt(0)" ::: "memory")
__device__ __forceinline__ int lane_id() { int r; asm volatile("v_mbcnt_lo_u32_b32 %0, -1, 0\n\tv_mbcnt_hi_u32_b32 %0, -1, %0" : "=v"(r)); return r; }
__device__ __forceinline__ unsigned f2bf(float f) { unsigned u = __builtin_bit_cast(unsigned, f); return (u + 0x7fffu + ((u >> 16) & 1u)) >> 16; }
__device__ __forceinline__ unsigned pk2(float lo, float hi) { unsigned r; asm("v_cvt_pk_bf16_f32 %0, %1, %2" : "=v"(r) : "v"(lo), "v"(hi)); return r; }
__device__ __forceinline__ float bflo(unsigned w) { return __uint_as_float(w << 16); }
__device__ __forceinline__ float bfhi(unsigned w) { return __uint_as_float(w & 0xffff0000u); }
__device__ __forceinline__ float bf2f(bf16 v) { return __uint_as_float(((unsigned)v) << 16); }
template <int O> __device__ __forceinline__ unsigned xshfl_u(unsigned v) {
    if constexpr (O == 32) { const auto t = __builtin_amdgcn_permlane32_swap(v, v, false, false); return (lane_id() & 32) ? t[0] : t[1]; }
    else return (unsigned)__builtin_amdgcn_ds_swizzle((int)v, (O << 10) | 0x1f);
}
template <int O> __device__ __forceinline__ float xshfl(float v) { return __uint_as_float(xshfl_u<O>(__float_as_uint(v))); }
template <int CTRL> __device__ __forceinline__ float dppf(float x) { return __builtin_bit_cast(float, __builtin_amdgcn_mov_dpp(__builtin_bit_cast(int, x), CTRL, 0xf, 0xf, true)); }
__device__ __forceinline__ float wave_sum(float x) {
    x += dppf<0xB1>(x); x += dppf<0x4E>(x); x += dppf<0x141>(x); x += dppf<0x128>(x);
    const auto s = __builtin_amdgcn_permlane16_swap(__float_as_uint(x), __float_as_uint(x), false, false); x = __uint_as_float(s[0]) + __uint_as_float(s[1]);
    const auto t = __builtin_amdgcn_permlane32_swap(__float_as_uint(x), __float_as_uint(x), false, false); return __uint_as_float(t[0]) + __uint_as_float(t[1]);
}
__device__ __forceinline__ float pair32_max(float x) { const auto t = __builtin_amdgcn_permlane32_swap(__float_as_uint(x), __float_as_uint(x), false, false); return fmaxf(__uint_as_float(t[0]), __uint_as_float(t[1])); }
__device__ __forceinline__ float pair32_sum(float x) { const auto t = __builtin_amdgcn_permlane32_swap(__float_as_uint(x), __float_as_uint(x), false, false); return __uint_as_float(t[0]) + __uint_as_float(t[1]); }
__device__ __forceinline__ float sigmoidf_(float x) { return 1.f / (1.f + __expf(-x)); }

namespace pg8 {
constexpr int BM = 256, BK = 64, HALF = 128, HTB = HALF * BK * 2, STAGE_BYTES = 8 * HTB, NXCD = 8, WGM = 8;
__host__ __device__ __forceinline__ int lds_byte(int r, int c) { const int st = (r >> 4) * 2 + (c >> 5), rr = r & 15, cc = c & 31, ob = rr * 64 + cc * 2; return st * 1024 + (ob ^ (((ob >> 9) & 1) << 5)); }
__host__ __device__ __forceinline__ void stage_rc(int b, int& R, int& C) { const int st = b / 1024, sb = b % 1024, swz = sb ^ (((sb >> 9) & 1) << 5); R = (st >> 1) * 16 + swz / 64; C = (st & 1) * 32 + (swz % 64) / 2; }

__host__ __device__ __forceinline__ int perm32(int rho) { const int n = rho >> 4, i = rho & 15; return 8 * (i >> 2) + 4 * n + (i & 3); }
struct Unit { int pm, pn, sg; };

template <int SEG> struct Order {
    int nM, nN, nwg, G, c, md;
    __device__ __forceinline__ void init(int nM_, int nN_, int G_, int c_, int md_ = 0) { nM = nM_; nN = nN_; nwg = nM * nN; G = G_; c = c_; md = md_; }
    __device__ __forceinline__ bool next(int i, Unit& u) const {
        const int it = i / SEG; u.sg = i - it * SEG;
        const long L = (long)it * G + c; if (L >= nwg) return false;
        int wgid = (int)L; { const int q = nwg / NXCD, r = nwg % NXCD, xcd = wgid % NXCD, off = wgid / NXCD; wgid = (xcd < r ? xcd * (q + 1) : r * (q + 1) + (xcd - r) * q) + off; }
        const int nig = WGM * nN, gid = wgid / nig, fm = gid * WGM, gsz = (nM - fm) < WGM ? (nM - fm) : WGM;
        u.pm = fm + ((wgid % nig) % gsz); u.pn = (wgid % nig) / gsz;
        if (md > 0) u.pm = (u.pm / md) * 18 + (u.pm % md);
        return true;
    }
};

template <class Prob, class Epi, class Sched>
__device__ __forceinline__ void gemm_phase(LAS unsigned char* lds, const Prob& P, const Sched& S, const Epi& E, int wid) {
    int lane_ = lane_id(); asm volatile("" : "+v"(lane_));
    const int lane = lane_, tid = wid * 64 + lane, wr = wid >> 2, wc = wid & 3, fr = lane & 15, fq = lane >> 4;
    const int K = P.K, nt = K / BK;
    unsigned voffA[2][2], voffN[2][2], voffB[2]; int stR[2], stC[2];
#pragma unroll
    for (int i = 0; i < 2; ++i) { stage_rc(tid * 16 + i * 8192, stR[i], stC[i]); const int Rb = (stR[i] & ~31) + perm32(stR[i] & 31); voffB[i] = (unsigned)(Rb * P.ldb + stC[i]) * 2u; }
    const size_t kstep = (size_t)(BK * 2);
    const size_t hstepB = (size_t)HALF * P.ldb * 2;
#define PG8_AOFF(dst, u) do { _Pragma("unroll") for (int h_ = 0; h_ < 2; ++h_) _Pragma("unroll") for (int i_ = 0; i_ < 2; ++i_) \
        dst[h_][i_] = (unsigned)(P.arow(u, h_ * HALF + stR[i_]) * P.lda + stC[i_]) * 2u; } while (0)
    const unsigned ldsw = (unsigned)wid * 1024u;
    const int aoff = lds_byte(wr * 64 + fr, fq * 8), boff = lds_byte(wc * 32 + fr, fq * 8);
#define PG8_SA(b, h) (((b) * 2 + (h)) * HTB)
#define PG8_SB(b, h) ((4 + (b) * 2 + (h)) * HTB)
#define PG8_STAGE(bufoff, gbase, voff) do { _Pragma("unroll") for (int _i = 0; _i < 2; ++_i) \
        __builtin_amdgcn_global_load_lds((const unsigned*)((const char*)(gbase) + (voff)[_i]), (LAS unsigned*)(lds + (bufoff) + ldsw + _i * 8192), 16, 0, 0); } while (0)
#define PG8_LDA(dst, b, h) do { _Pragma("unroll") for (int m = 0; m < 4; ++m) _Pragma("unroll") for (int k = 0; k < 2; ++k) dst[m][k] = *(const LAS bf16x8*)(lds + PG8_SA(b, h) + aoff + m * 2048 + k * 1024); } while (0)
#define PG8_LDB(dst, b, h) do { _Pragma("unroll") for (int n = 0; n < 2; ++n) _Pragma("unroll") for (int k = 0; k < 2; ++k) dst[n][k] = *(const LAS bf16x8*)(lds + PG8_SB(b, h) + boff + n * 2048 + k * 1024); } while (0)
#define PG8_MMA(ai, bj, At, Bt) do { __builtin_amdgcn_s_setprio(1); _Pragma("unroll") for (int m = 0; m < 4; ++m) _Pragma("unroll") for (int n = 0; n < 2; ++n) _Pragma("unroll") for (int k = 0; k < 2; ++k) \
        acc[ai][bj][m][n] = __builtin_amdgcn_mfma_f32_16x16x32_bf16(Bt[n][k], At[m][k], acc[ai][bj][m][n], 0, 0, 0); __builtin_amdgcn_s_setprio(0); } while (0)
#define PG8_WAIT_V(n) asm volatile("s_waitcnt vmcnt(" #n ")" ::: "memory")
#define PG8_WAIT_L(n) asm volatile("s_waitcnt lgkmcnt(" #n ")" ::: "memory")
#define PG8_BAR __builtin_amdgcn_s_barrier()
#define PG8_SCHED __builtin_amdgcn_sched_barrier(0)
    Unit cur, nxt; int ui = 0;
    if (!S.next(0, cur)) return;
    f32x4 acc[2][2][4][2];
#pragma unroll
    for (int a = 0; a < 2; ++a)
#pragma unroll
        for (int b = 0; b < 2; ++b)
#pragma unroll
            for (int m = 0; m < 4; ++m)
#pragma unroll
                for (int n = 0; n < 2; ++n) acc[a][b][m][n] = (f32x4){0.f, 0.f, 0.f, 0.f};
    bf16x8 At[4][2], B0[2][2], B1[2][2];
    const char* cA = P.ap(cur); const char* cB = P.bp(cur);
    PG8_AOFF(voffA, cur);
    PG8_STAGE(PG8_SB(0, 0), cB, voffB); PG8_STAGE(PG8_SB(0, 1), cB + hstepB, voffB); PG8_STAGE(PG8_SA(0, 0), cA, voffA[0]); PG8_STAGE(PG8_SA(0, 1), cA, voffA[1]);
    if (wr == 1) PG8_BAR;
    PG8_WAIT_V(2); PG8_BAR;
    PG8_STAGE(PG8_SB(1, 0), cB + kstep, voffB); PG8_STAGE(PG8_SA(1, 0), cA + kstep, voffA[0]); PG8_STAGE(PG8_SB(1, 1), cB + hstepB + kstep, voffB);
    PG8_WAIT_V(6); PG8_BAR;
    for (;;) {
        const bool has_next = S.next(ui + 1, nxt);
        const char* nA = has_next ? P.ap(nxt) : cA; const char* nB = has_next ? P.bp(nxt) : cB;
        if constexpr (Prob::GATHER) { if (has_next) PG8_AOFF(voffN, nxt); else { _Pragma("unroll") for (int h_ = 0; h_ < 2; ++h_) _Pragma("unroll") for (int i_ = 0; i_ < 2; ++i_) voffN[h_][i_] = voffA[h_][i_]; } }
        for (int t = 0; t < nt; t += 2) {
            const bool last = (t == nt - 2);
            const char* a1 = cA + (size_t)(t + 1) * kstep;
            const char* a2 = last ? nA : cA + (size_t)(t + 2) * kstep; const char* b2 = last ? nB : cB + (size_t)(t + 2) * kstep;
            const char* a3 = a2 + kstep; const char* b3 = b2 + kstep;
            unsigned vo2[2][2];
#pragma unroll
            for (int h_ = 0; h_ < 2; ++h_)
#pragma unroll
                for (int i_ = 0; i_ < 2; ++i_) vo2[h_][i_] = (Prob::GATHER && last) ? voffN[h_][i_] : voffA[h_][i_];
            PG8_LDB(B0, 0, 0); PG8_LDB(B1, 0, 1); PG8_SCHED; PG8_LDA(At, 0, 0); PG8_STAGE(PG8_SA(1, 1), a1, voffA[1]);
            PG8_WAIT_V(8); PG8_WAIT_L(0); PG8_BAR; PG8_MMA(0, 0, At, B0); PG8_MMA(0, 1, At, B1); PG8_BAR; PG8_SCHED;
            PG8_LDA(At, 0, 1); PG8_STAGE(PG8_SB(0, 0), b2, voffB); PG8_STAGE(PG8_SB(0, 1), b2 + hstepB, voffB); PG8_STAGE(PG8_SA(0, 0), a2, vo2[0]);
            PG8_WAIT_V(8); PG8_WAIT_L(0); PG8_BAR; PG8_MMA(1, 0, At, B0); PG8_MMA(1, 1, At, B1); PG8_BAR; PG8_SCHED;
            PG8_LDB(B0, 1, 0); PG8_LDB(B1, 1, 1); PG8_SCHED; PG8_LDA(At, 1, 0); PG8_STAGE(PG8_SA(0, 1), a2, vo2[1]);
            PG8_WAIT_V(8); PG8_WAIT_L(0); PG8_BAR; PG8_MMA(0, 0, At, B0); PG8_MMA(0, 1, At, B1); PG8_BAR; PG8_SCHED;
            PG8_LDA(At, 1, 1); PG8_STAGE(PG8_SB(1, 0), b3, voffB); PG8_STAGE(PG8_SB(1, 1), b3 + hstepB, voffB); PG8_STAGE(PG8_SA(1, 0), a3, vo2[0]);
            PG8_WAIT_V(8); PG8_WAIT_L(0); PG8_BAR; PG8_MMA(1, 0, At, B0); PG8_MMA(1, 1, At, B1); PG8_BAR; PG8_SCHED;
        }
        if (wr == 0) PG8_BAR;
        const bool z = E(acc, cur, wr, wc, fr, fq);
        if (!has_next) break;
        if (z) {
#pragma unroll
            for (int a = 0; a < 2; ++a)
#pragma unroll
                for (int b = 0; b < 2; ++b)
#pragma unroll
                    for (int m = 0; m < 4; ++m)
#pragma unroll
                        for (int n = 0; n < 2; ++n) acc[a][b][m][n] = (f32x4){0.f, 0.f, 0.f, 0.f};
        }
        cur = nxt; cA = nA; cB = nB; ++ui;
        if constexpr (Prob::GATHER) { _Pragma("unroll") for (int h_ = 0; h_ < 2; ++h_) _Pragma("unroll") for (int i_ = 0; i_ < 2; ++i_) voffA[h_][i_] = voffN[h_][i_]; }
        if (wr == 1) PG8_BAR;
    }
    PG8_WAIT_V(0);
    PG8_BAR;
#undef PG8_AOFF
#undef PG8_SA
#undef PG8_SB
#undef PG8_STAGE
#undef PG8_LDA
#undef PG8_LDB
#undef PG8_MMA
#undef PG8_WAIT_V
#undef PG8_WAIT_L
#undef PG8_BAR
#undef PG8_SCHED
}

struct ProbPlain { static constexpr bool GATHER = false; const bf16* A; const bf16* B; int K, lda, ldb;
    __device__ __forceinline__ const char* ap(const Unit& u) const { return (const char*)(A + (size_t)u.pm * 256 * lda); }
    __device__ __forceinline__ int arow(const Unit&, int rr) const { return rr; }
    __device__ __forceinline__ const char* bp(const Unit& u) const { return (const char*)(B + (size_t)u.pn * 256 * ldb); } };
struct ProbSeg3 { static constexpr bool GATHER = false; const bf16* A; const bf16* B; int K, lda, ldb; size_t sA, sB;
    __device__ __forceinline__ const char* ap(const Unit& u) const { return (const char*)(A + (size_t)u.sg * sA + (size_t)u.pm * 256 * lda); }
    __device__ __forceinline__ int arow(const Unit&, int rr) const { return rr; }
    __device__ __forceinline__ const char* bp(const Unit& u) const { return (const char*)(B + (size_t)u.sg * sB + (size_t)u.pn * 256 * ldb); } };
struct ProbUp2 { static constexpr bool GATHER = false; const bf16* A0; const bf16* A1; const bf16* B0; const bf16* B1; int K, lda, ldb;
    __device__ __forceinline__ const char* ap(const Unit& u) const { return (const char*)((u.sg ? A1 : A0) + (size_t)u.pm * 256 * lda); }
    __device__ __forceinline__ int arow(const Unit&, int rr) const { return rr; }
    __device__ __forceinline__ const char* bp(const Unit& u) const { return (const char*)((u.sg ? B1 : B0) + (size_t)u.pn * 256 * ldb); } };
struct OrderUp2 { int n0, nwg, G, c, nM0;
    __device__ __forceinline__ void init(int nM0_, int G_, int c_) { nM0 = nM0_; n0 = nM0_ * 3; nwg = n0 + (MT / 256) * 4; G = G_; c = c_; }
    __device__ __forceinline__ bool next(int i, Unit& u) const { const int L = i * G + c; if (L >= nwg) return false;
        if (L < n0) { u.sg = 0; u.pm = L / 3; u.pn = L - u.pm * 3; } else { const int r = L - n0; u.sg = 1; u.pm = r >> 2; u.pn = r & 3; } return true; } };
struct OrderWinLast { int G, c;
    __device__ __forceinline__ void init(int G_, int c_) { G = G_; c = c_; }
    __device__ __forceinline__ bool next(int i, Unit& u) const { const int L = i * G + c; u.sg = 0; if (L >= 128 * 24 + 16 * 5) return false;
        if (L < 128 * 24) { const int g = L / (8 * 24), q = L - g * 8 * 24; u.pm = g * 8 + (q & 7); u.pn = q >> 3; }
        else { const int r = L - 128 * 24, t = r % 5; u.pm = 128 + r / 5; u.pn = t < 4 ? 2 + t : 7; } return true; } };
struct ProbMoE { static constexpr bool GATHER = false; const bf16* A; const bf16* B; int K, lda, ldb; int nrowsB;
    __device__ __forceinline__ const char* ap(const Unit& u) const { return (const char*)(A + (size_t)u.pm * 256 * lda); }
    __device__ __forceinline__ int arow(const Unit&, int rr) const { return rr; }
    __device__ __forceinline__ const char* bp(const Unit& u) const { return (const char*)(B + ((size_t)(u.pm / 18) * nrowsB + (size_t)u.pn * 256) * ldb); } };
struct ProbMoEGather { static constexpr bool GATHER = true; const bf16* A; const bf16* B; const LAS int* lidx; int K, lda, ldb; int nrowsB;
    __device__ __forceinline__ const char* ap(const Unit&) const { return (const char*)A; }
    __device__ __forceinline__ int arow(const Unit& u, int rr) const { return lidx[u.sg * 256 + rr]; }
    __device__ __forceinline__ const char* bp(const Unit& u) const { return (const char*)(B + ((size_t)(u.pm / 18) * nrowsB + (size_t)u.pn * 256) * ldb); } };
struct OrderOrd { Order<1> o;
    __device__ __forceinline__ bool next(int i, Unit& u) const { const bool r = o.next(i, u); u.sg = i; return r; } };

#define EPI_ROWS(...) _Pragma("unroll") for (int ai = 0; ai < 2; ++ai) _Pragma("unroll") for (int m = 0; m < 4; ++m) { const int row = u.pm * 256 + ai * 128 + wr * 64 + m * 16 + fr; __VA_ARGS__ }
#define EPI_COLS8(...) _Pragma("unroll") for (int bj = 0; bj < 2; ++bj) { const int col = u.pn * 256 + bj * 128 + wc * 32 + 8 * fq; __VA_ARGS__ }
#define EPI_LANE() int t_ = lane_id(); asm volatile("" : "+v"(t_)); const int fr = t_ & 15, fq = t_ >> 4
__device__ __forceinline__ v4u pack8(const f32x4& a, const f32x4& b) { v4u w; w.x = pk2(a[0], a[1]); w.y = pk2(a[2], a[3]); w.z = pk2(b[0], b[1]); w.w = pk2(b[2], b[3]); return w; }
__device__ __forceinline__ f32x4 unpack4(v2u w) { return (f32x4){bflo(w.x), bfhi(w.x), bflo(w.y), bfhi(w.y)}; }
struct EpiBf16 { bf16* O; int ldc;
    __device__ __forceinline__ bool operator()(f32x4 (&acc)[2][2][4][2], const Unit& u, int wr, int wc, int fr_, int fq_) const {
        EPI_LANE();
        EPI_ROWS( bf16* rp = O + (size_t)row * ldc; EPI_COLS8( *(v4u*)(rp + col) = pack8(acc[ai][bj][m][0], acc[ai][bj][m][1]); ) )
        return true; } };
__device__ __forceinline__ f32x4 sigmoid4(const f32x4& v) { return (f32x4){__builtin_amdgcn_rcpf(1.f + __expf(-v[0])), __builtin_amdgcn_rcpf(1.f + __expf(-v[1])), __builtin_amdgcn_rcpf(1.f + __expf(-v[2])), __builtin_amdgcn_rcpf(1.f + __expf(-v[3]))}; }
struct EpiUp2 { bf16* O0; bf16* O1;
    __device__ __forceinline__ bool operator()(f32x4 (&acc)[2][2][4][2], const Unit& u, int wr, int wc, int fr_, int fq_) const {
        EPI_LANE();
        bf16* O = u.sg ? O1 : O0; const int ldc = u.sg ? 1024 : 768;
        EPI_ROWS( bf16* rp = O + (size_t)row * ldc; EPI_COLS8( *(v4u*)(rp + col) = pack8(acc[ai][bj][m][0], acc[ai][bj][m][1]); ) )
        return true; } };
struct EpiWin { bf16* O;
    __device__ __forceinline__ bool operator()(f32x4 (&acc)[2][2][4][2], const Unit& u, int wr, int wc, int fr_, int fq_) const {
        EPI_LANE();
        const bool sg = u.pn >= 10;
        EPI_ROWS( bf16* rp = O + (size_t)row * NP; EPI_COLS8( f32x4 v0 = acc[ai][bj][m][0], v1 = acc[ai][bj][m][1];
            if (sg) { v0 = sigmoid4(v0); v1 = sigmoid4(v1); }
            *(v4u*)(rp + col) = pack8(v0, v1); ) )
        return true; } };
__device__ __forceinline__ f32x4 gate_ratio(v2u a, v2u b, bool fin) { const f32x4 x = unpack4(a), y = unpack4(b);
    return (f32x4){x[0] * (fin ? 1.f : __builtin_amdgcn_rcpf(fmaxf(y[0], 1e-20f))), x[1] * (fin ? 1.f : __builtin_amdgcn_rcpf(fmaxf(y[1], 1e-20f))), x[2] * (fin ? 1.f : __builtin_amdgcn_rcpf(fmaxf(y[2], 1e-20f))), x[3] * (fin ? 1.f : __builtin_amdgcn_rcpf(fmaxf(y[3], 1e-20f)))}; }
struct EpiMerge { const bf16* PROJ; bf16* O;
    __device__ __forceinline__ bool operator()(f32x4 (&acc)[2][2][4][2], const Unit& u, int wr, int wc, int fr_, int fq_) const {
        EPI_LANE();
        const int sg = u.sg; const bool fin = sg == 2; const int sgb = fin ? 2 : sg + 1;
        _Pragma("unroll") for (int ai = 0; ai < 2; ++ai) {
            _Pragma("unroll") for (int m = 0; m < 4; ++m) { const int row = u.pm * 256 + ai * 128 + wr * 64 + m * 16 + fr;
                const bf16* gp = PROJ + (size_t)row * NP + C_GT; bf16* rp = O + (size_t)row * DM;
                EPI_COLS8( const v4u ga = *(const v4u*)(gp + sg * 1024 + col), gb = *(const v4u*)(gp + sgb * 1024 + col);
                    const f32x4 v0 = acc[ai][bj][m][0] * gate_ratio((v2u){ga.x, ga.y}, (v2u){gb.x, gb.y}, fin), v1 = acc[ai][bj][m][1] * gate_ratio((v2u){ga.z, ga.w}, (v2u){gb.z, gb.w}, fin);
                    acc[ai][bj][m][0] = v0; acc[ai][bj][m][1] = v1;
                    if (fin) *(v4u*)(rp + col) = pack8(v0, v1); ) }
            asm volatile("" ::: "memory"); }
        return fin; } };
struct EpiSwiGLU { bf16* HID;
    __device__ __forceinline__ bool operator()(f32x4 (&acc)[2][2][4][2], const Unit& u, int wr, int wc, int fr_, int fq_) const {
        EPI_LANE();
        EPI_ROWS( bf16* rp = HID + (size_t)row * 1024 + u.pn * 128 + wc * 32 + 8 * fq; f32x4 h[2];
            _Pragma("unroll") for (int n = 0; n < 2; ++n) { const f32x4 g = acc[ai][0][m][n], up = acc[ai][1][m][n];
                h[n] = (f32x4){g[0] * __builtin_amdgcn_rcpf(1.f + __expf(-g[0])) * up[0], g[1] * __builtin_amdgcn_rcpf(1.f + __expf(-g[1])) * up[1], g[2] * __builtin_amdgcn_rcpf(1.f + __expf(-g[2])) * up[2], g[3] * __builtin_amdgcn_rcpf(1.f + __expf(-g[3])) * up[3]}; }
            *(v4u*)rp = pack8(h[0], h[1]); )
        return true; } };
}

#define XB_TMO      128
#define XB_XCNT(j)  (256  + 64 * (j))
#define XB_XSUB(j)  (1280 + 64 * (j))
#define XB_XGEN(j)  (2304 + 64 * (j))
#define XB_TOP      3328
#define XB_TOPGEN   3392
#define XCD_BAR_WORDS 3456
#define XB_SPIN_CAP (1u << 22)
__device__ __forceinline__ unsigned xb_ld(unsigned* p)              { return __hip_atomic_load(p, __ATOMIC_RELAXED, __HIP_MEMORY_SCOPE_AGENT); }
__device__ __forceinline__ unsigned xb_add(unsigned* p, unsigned v) { return __hip_atomic_fetch_add(p, v, __ATOMIC_RELAXED, __HIP_MEMORY_SCOPE_AGENT); }
__device__ __forceinline__ unsigned xb_xcc_id() { return (unsigned)__builtin_amdgcn_s_getreg((3 << 11) | 20) & 0xFu; }
#define XB_SPIN(cond, bar) do { unsigned _sp = 0; while (cond) { __builtin_amdgcn_s_sleep(1); \
    if ((++_sp & 255u) == 0u) { if (xb_ld(&(bar)[XB_TMO])) break; if (_sp > XB_SPIN_CAP) { atomicAdd(&(bar)[XB_TMO], 1u); break; } } } } while (0)
struct XcdBarrier { unsigned* bar; unsigned x; volatile LAS unsigned* st; int wv; };
__device__ __forceinline__ XcdBarrier xcd_barrier_post(unsigned* bar, volatile LAS unsigned* st, int wv) {
    XcdBarrier b; b.bar = bar; b.x = xb_xcc_id(); b.st = st; b.wv = wv;
    if (wv == 0 && lane_id() == 0) (void)xb_add(&bar[XB_XCNT(b.x)], 1u);
    return b;
}
__device__ __forceinline__ void xcd_barrier_complete(unsigned* bar, unsigned x, unsigned& nloc, unsigned& nx) {
    const unsigned G = gridDim.x * gridDim.y * gridDim.z;
    unsigned sum, cnt, mine, sp = 0u;
    for (;;) {
        sum = 0u; cnt = 0u; mine = 0u;
#pragma unroll
        for (unsigned j = 0; j < 16; ++j) { const unsigned c = xb_ld(&bar[XB_XCNT(j)]); sum += c; cnt += (c > 0u) ? 1u : 0u; mine = (j == x) ? c : mine; }
        if (sum == G) break;
        __builtin_amdgcn_s_sleep(1);
        if ((++sp & 255u) == 0u) { if (xb_ld(&bar[XB_TMO])) break; if (sp > XB_SPIN_CAP) { atomicAdd(&bar[XB_TMO], 1u); break; } }
    }
    nloc = mine > 0u ? mine : 1u; nx = cnt > 0u ? cnt : 1u;
}
__device__ __forceinline__ void xcd_barrier(const XcdBarrier& b) {
    asm volatile("s_waitcnt vmcnt(0)" ::: "memory");
    __syncthreads();
    if (b.wv == 0 && lane_id() == 0) {
        unsigned* bar = b.bar; unsigned bx_ = b.x; asm volatile("" : "+s"(bx_)); asm volatile("" : "+s"(bar));
        __builtin_amdgcn_s_waitcnt(0);
        unsigned nloc = b.st[0], nx = b.st[1];
        if (nloc == 0u) { xcd_barrier_complete(bar, bx_, nloc, nx); b.st[0] = nloc; b.st[1] = nx; }
        const unsigned old = xb_add(&bar[XB_XSUB(bx_)], 1u);
        const unsigned gen = old / nloc;
        if (old + 1u == (gen + 1u) * nloc) {
            __builtin_amdgcn_fence(__ATOMIC_RELEASE, "agent");
            asm volatile("s_waitcnt vmcnt(0)" ::: "memory");
            const unsigned og = xb_add(&bar[XB_TOP], 1u);
            const unsigned tg = og / nx;
            if (og + 1u == (tg + 1u) * nx) xb_add(&bar[XB_TOPGEN], 1u);
            else XB_SPIN(xb_ld(&bar[XB_TOPGEN]) == tg, bar);
            __builtin_amdgcn_fence(__ATOMIC_ACQUIRE, "agent");
            xb_add(&bar[XB_XGEN(bx_)], 1u);
            asm volatile("s_waitcnt vmcnt(0)" ::: "memory");
        } else {
            XB_SPIN(xb_ld(&bar[XB_XGEN(bx_)]) == gen, bar);
            __builtin_amdgcn_fence(__ATOMIC_ACQUIRE, "agent");
            asm volatile("s_waitcnt vmcnt(0)" ::: "memory");
        }
    }
    __syncthreads();
}

struct Args { const float* in[28]; float* out; unsigned char* ws; };
enum { I_X = 0, I_C, I_CTX, I_CCTX, I_WADA, I_BADA, I_WIN, I_GQ, I_WUQ, I_GKV, I_WUKV, I_RPB, I_WDW, I_BDW, I_GCN, I_BCN, I_WPW2, I_WOA, I_WOB, I_WOUT, I_LN1G, I_LN1B, I_WROUTER, I_WGATE, I_WUP, I_WDOWN, I_LN2G, I_LN2B };

#define OPAQUE(v) asm volatile("" : "+v"(v))
struct Ctx {
    LAS unsigned char* lds;
    int tid, lane, wave, G, bid;
    const float* const* in;
    unsigned char* ws;
    float* out;
};
#define INP(i) ((const float*)(const GAS float*)C.in[i])
#define WSP(T, off) ((T*)(C.ws + (off)))
#define WSW(T, off, l) ((T*)(C.ws + (off) + (size_t)((l) & 1) * WS_WSET))

template <class RowPtr>
__device__ __forceinline__ void tr_item(const float* W, int N, int k0, int n0, const RowPtr& rp, LAS float* scr, int lane) {
#pragma unroll
    for (int i = 0; i < 8; ++i) { const int kk = 8 * i + (lane >> 3), nn = (lane & 7) * 4; const f32x4 v = *(const f32x4*)(W + (size_t)(k0 + kk) * N + n0 + nn);
        scr[kk * 33 + nn] = v[0]; scr[kk * 33 + nn + 1] = v[1]; scr[kk * 33 + nn + 2] = v[2]; scr[kk * 33 + nn + 3] = v[3]; }
    LDS_WAIT(); asm volatile("" ::: "memory");
    const int c = lane & 7;
#pragma unroll
    for (int j = 0; j < 4; ++j) { const int n = (lane >> 3) + 8 * j; const LAS float* s = scr + (8 * c) * 33 + n;
        v4u o; o.x = pk2(s[0 * 33], s[1 * 33]); o.y = pk2(s[2 * 33], s[3 * 33]); o.z = pk2(s[4 * 33], s[5 * 33]); o.w = pk2(s[6 * 33], s[7 * 33]);
        *(v4u*)(rp(n0 + n) + k0 + 8 * c) = o; }
    LDS_WAIT(); asm volatile("" ::: "memory");
}
struct RpPlain { bf16* base; int ld; __device__ __forceinline__ bf16* operator()(int n) const { return base + (size_t)n * ld; } };
struct RpWin { bf16* base; __device__ __forceinline__ bf16* operator()(int n) const { return base + (size_t)(n < 1952 ? n : n + 96) * 1024; } };
struct RpGU { bf16* base; int add; __device__ __forceinline__ bf16* operator()(int n) const { return base + (size_t)((n >> 7) * 256 + (n & 127) + add) * 1024; } };

__device__ __forceinline__ void conv_weights(const Ctx& Cc, int l, int f0, int f1, int wg0, int nwg) {
    Ctx C = Cc; OPAQUE(C.lane); OPAQUE(C.tid);
    LAS float* scr = (LAS float*)(C.lds + C.wave * 16384);
    if (C.bid < wg0) return;
    const int gw = (C.bid - wg0) * NWAVES + C.wave, NGW = nwg * NWAVES;
    constexpr int I_IN = 16 * 189, I_UQ = 4 * 24, I_UKV = 2 * 32, I_PW = 8 * 32, I_OUT = 16 * 32, I_EX = 16 * 32;
    constexpr int NITEMS = I_IN + I_UQ + I_UKV + 3 * I_PW + I_OUT + 48 * I_EX;
    bf16* WinT = WSW(bf16, WS_WIN, l);
    const int it0 = (int)((long)NITEMS * f0 / 100), it1 = (int)((long)NITEMS * f1 / 100);
    for (int it = it0 + gw; it < it1; it += NGW) {
        int r = it;
        if (r < I_IN) { const int kb = r / 189, nb = r % 189; tr_item(INP(I_WIN) + (size_t)l * 1024 * 6048, 6048, kb * 64, nb * 32, RpWin{WinT}, scr, C.lane); continue; } r -= I_IN;
        if (r < I_UQ) { const int kb = r / 24, nb = r % 24; tr_item(INP(I_WUQ) + (size_t)l * 256 * 768, 768, kb * 64, nb * 32, RpPlain{WSW(bf16, WS_WUQ, l), 256}, scr, C.lane); continue; } r -= I_UQ;
        if (r < I_UKV) { const int kb = r / 32, nb = r % 32; tr_item(INP(I_WUKV) + (size_t)l * 128 * 1024, 1024, kb * 64, nb * 32, RpPlain{WSW(bf16, WS_WUKV, l), 256}, scr, C.lane); continue; } r -= I_UKV;
        if (r < 3 * I_PW) { const int w = r / I_PW, q = r % I_PW, kb = q / 32, nb = q % 32;
            const float* src = (w == 0 ? INP(I_WPW2) : (w == 1 ? INP(I_WOA) : INP(I_WOB))) + (size_t)l * 512 * 1024;
            bf16* dst = WSW(bf16, w == 0 ? WS_WPW2 : (w == 1 ? WS_WOA : WS_WOB), l);
            tr_item(src, 1024, kb * 64, nb * 32, RpPlain{dst, 512}, scr, C.lane); continue; } r -= 3 * I_PW;
        if (r < I_OUT) { const int kb = r / 32, nb = r % 32; tr_item(INP(I_WOUT) + (size_t)l * 1024 * 1024, 1024, kb * 64, nb * 32, RpPlain{WSW(bf16, WS_WOUT, l), 1024}, scr, C.lane); continue; } r -= I_OUT;
        { const int mat = r / I_EX, q = r % I_EX, kb = q / 32, nb = q % 32, w = mat / 16, e = mat % 16;
          const float* src = (w == 0 ? INP(I_WGATE) : (w == 1 ? INP(I_WUP) : INP(I_WDOWN))) + ((size_t)l * 16 + e) * 1024 * 1024;
          if (w < 2) tr_item(src, 1024, kb * 64, nb * 32, RpGU{WSW(bf16, WS_WGU, l) + (size_t)e * 2048 * 1024, w * 128}, scr, C.lane);
          else tr_item(src, 1024, kb * 64, nb * 32, RpPlain{WSW(bf16, WS_WD, l) + (size_t)e * 1024 * 1024, 1024}, scr, C.lane); }
    }
    if (f0 != 0) return;
    const int gt = (C.bid - wg0) * NTHREADS + C.tid, NGT = nwg * NTHREADS;
    unsigned zz_ = 0u; asm volatile("" : "+v"(zz_)); const v4u z = (v4u){zz_, zz_, zz_, zz_};
    for (int i = gt; i < 96 * 128; i += NGT) *((v4u*)(WinT + (size_t)1952 * 1024) + i) = z;
    for (int i = gt; i < 1024 * 16; i += NGT) { const int n = i >> 4, c = i & 15; *((v4u*)(WSW(bf16, WS_WUKV, l) + (size_t)n * 256 + 128) + c) = z; }
}

__device__ __forceinline__ void phase_mods(const Ctx& Cc) {
    Ctx C = Cc; OPAQUE(C.lane); OPAQUE(C.tid);
    LAS float* sc = (LAS float*)C.lds;
    LAS float* red = (LAS float*)(C.lds + 69632);
    for (int idx = C.tid; idx < 17 * 1024; idx += NTHREADS) { const int r = idx >> 10, k = idx & 1023; const float v = r < 16 ? INP(I_C)[r * 1024 + k] : INP(I_CCTX)[k]; sc[idx] = v / (1.f + __expf(-v)); }
    __syncthreads();
    float* MODS = WSP(float, WS_MODS);
    for (int item = C.bid; item < NL * 96; item += C.G) {
        const int l = item / 96, cb = item % 96, col = cb * 64 + C.lane;
        const float* W = INP(I_WADA) + (size_t)l * 1024 * 6144;
        float acc[17];
#pragma unroll
        for (int r = 0; r < 17; ++r) acc[r] = 0.f;
        for (int k = C.wave * 128; k < C.wave * 128 + 128; k += 4) { const float w0 = W[(size_t)k * 6144 + col], w1 = W[(size_t)(k + 1) * 6144 + col], w2 = W[(size_t)(k + 2) * 6144 + col], w3 = W[(size_t)(k + 3) * 6144 + col];
#pragma unroll
            for (int r = 0; r < 17; ++r) { const f32x4 sv = *(const LAS f32x4*)(sc + r * 1024 + k); acc[r] += (sv[0] * w0 + sv[1] * w1) + (sv[2] * w2 + sv[3] * w3); } }
#pragma unroll
        for (int r = 0; r < 17; ++r) red[(C.wave * 17 + r) * 64 + C.lane] = acc[r];
        __syncthreads();
        for (int o = C.tid; o < 17 * 64; o += NTHREADS) { const int r = o >> 6, cl = o & 63; float s = INP(I_BADA)[l * 6144 + cb * 64 + cl];
#pragma unroll
            for (int w = 0; w < 8; ++w) s += red[(w * 17 + r) * 64 + cl];
            MODS[((size_t)l * 17 + r) * 6144 + cb * 64 + cl] = s; }
        __syncthreads();
    }
    float* TAB = WSP(float, WS_TAB);
    const int gt = C.bid * NTHREADS + C.tid, NGT = C.G * NTHREADS;
    for (int idx = gt; idx < 2048 * 16; idx += NGT) { const int t = idx >> 4, j = idx & 15, which = j >> 3, i = j & 7;
        const float pos = (float)(which ? (t & 63) : (t >> 6)), invf = exp2f(-(float)i * (13.287712379549449f / 8.f)), ang = pos * invf;
        TAB[t * 32 + which * 16 + i] = __cosf(ang); TAB[t * 32 + which * 16 + 8 + i] = __sinf(ang); }
}

__device__ __forceinline__ void phase_mod0(const Ctx& Cc) {
    Ctx C = Cc; OPAQUE(C.lane);
    const int gw = C.bid * NWAVES + C.wave, NGW = C.G * NWAVES;
    const float* MODS = WSP(float, WS_MODS); float* X = WSP(float, WS_X); bf16* H = WSP(bf16, WS_HB);
    for (int row = gw; row < MT; row += NGW) {
        const float* src = row < ML ? INP(I_X) + (size_t)row * DM : INP(I_CTX) + (size_t)(row - ML) * DM;
        const int mr = row < ML ? (row >> 11) : 16; const float* md = MODS + (size_t)mr * 6144;
#pragma unroll
        for (int j = 0; j < 2; ++j) { const int c0 = 8 * (C.lane + 64 * j); f32x4 h[2];
#pragma unroll
            for (int q = 0; q < 2; ++q) { const int c = c0 + 4 * q; const f32x4 xv = *(const f32x4*)(src + c), sh = *(const f32x4*)(md + c), scl = *(const f32x4*)(md + 1024 + c);
                h[q] = xv * (scl + 1.f) + sh; }
            *(v4u*)(H + (size_t)row * DM + c0) = pg8::pack8(h[0], h[1]); }
    }
}

__device__ __forceinline__ void phase_prep(const Ctx& C, int l) {
    int lane = C.lane; OPAQUE(lane); const int gw = C.bid * NWAVES + C.wave, NGW = C.G * NWAVES;
    const bf16* PROJ = WSP(bf16, WS_R); bf16* CQN = WSP(bf16, WS_CQN); bf16* CKVN = WSP(bf16, WS_CKVN); bf16* KR = WSP(bf16, WS_KR);
    const float* TAB = WSP(float, WS_TAB);
    const f32x4 gq = *(const f32x4*)(INP(I_GQ) + l * 256 + 4 * lane); const f32x2 gkv = *(const f32x2*)(INP(I_GKV) + l * 128 + 2 * lane);
    for (int row = gw; row < MT; row += NGW) {
        const bf16* p = PROJ + (size_t)row * NP;
        { const v2u w = *(const v2u*)(p + C_CQ + 4 * lane); const float x0 = bflo(w.x), x1 = bfhi(w.x), x2 = bflo(w.y), x3 = bfhi(w.y);
          const float ss = wave_sum(x0 * x0 + x1 * x1 + x2 * x2 + x3 * x3), r = 1.f / sqrtf(ss * (1.f / 256.f) + RMS_EPS);
          v2u o; o.x = pk2(x0 * r * gq[0], x1 * r * gq[1]); o.y = pk2(x2 * r * gq[2], x3 * r * gq[3]); *(v2u*)(CQN + (size_t)row * 256 + 4 * lane) = o; }
        { const unsigned w = *(const unsigned*)(p + C_CKV + 2 * lane); const float x0 = bflo(w), x1 = bfhi(w);
          const float ss = wave_sum(x0 * x0 + x1 * x1), r = 1.f / sqrtf(ss * (1.f / 128.f) + RMS_EPS);
          *(unsigned*)(CKVN + (size_t)row * 256 + 2 * lane) = pk2(x0 * r * gkv[0], x1 * r * gkv[1]); *(unsigned*)(CKVN + (size_t)row * 256 + 128 + 2 * lane) = 0u; }
        if (lane < 16) { const int gi = lane >> 3, i = lane & 7; const float x1 = bf2f(p[C_KR + gi * 16 + i]), x2 = bf2f(p[C_KR + gi * 16 + 8 + i]); float o1 = x1, o2 = x2;
          if (row < ML) { const int t = row & 2047; const float cs = TAB[t * 32 + gi * 16 + i], sn = TAB[t * 32 + gi * 16 + 8 + i]; o1 = x1 * cs - x2 * sn; o2 = x2 * cs + x1 * sn; }
          KR[(size_t)row * 32 + gi * 16 + i] = (bf16)f2bf(o1); KR[(size_t)row * 32 + gi * 16 + 8 + i] = (bf16)f2bf(o2); }
    }
}

__device__ __forceinline__ void phase_conv(const Ctx& C, int l) {
    int tid = C.tid; OPAQUE(tid); const int lane = tid & 63, w = C.wave;
    LAS float* Wt = (LAS float*)C.lds;
    LAS unsigned char* Xt = C.lds + 63488;
    const bf16* PROJ = WSP(bf16, WS_R); bf16* U = WSP(bf16, WS_U);
    { const float* wdw = INP(I_WDW) + (size_t)l * 31 * 512;
      for (int i = tid; i < 31 * 128; i += NTHREADS) { const int j = i >> 7, c4 = i & 127, ln = c4 >> 1, hf = c4 & 1; *(LAS f32x4*)(Wt + ((j * 2 + hf) * 64 + ln) * 4) = *(const f32x4*)(wdw + j * 512 + 4 * c4); } }
    const f32x4 bd0 = *(const f32x4*)(INP(I_BDW) + l * 512 + 8 * lane), bd1 = *(const f32x4*)(INP(I_BDW) + l * 512 + 8 * lane + 4);
    const f32x4 gc0 = *(const f32x4*)(INP(I_GCN) + l * 512 + 8 * lane), gc1 = *(const f32x4*)(INP(I_GCN) + l * 512 + 8 * lane + 4);
    const f32x4 bc0 = *(const f32x4*)(INP(I_BCN) + l * 512 + 8 * lane), bc1 = *(const f32x4*)(INP(I_BCN) + l * 512 + 8 * lane + 4);
    const int ntile = (l == NL - 1 ? ML : MT) / 32;
    for (int tile = C.bid; tile < ntile; tile += C.G) {
        const int r0 = tile * 32, t0 = r0 < ML ? (r0 & 2047) : ((r0 - ML) & 255), L = r0 < ML ? 2048 : 256;
#pragma unroll
        for (int it = 0; it < 8; ++it) { const int idx = tid + 512 * it, rr = idx >> 6, ch = idx & 63, tt = t0 - 15 + rr;
            if (rr < 62) { v4u o = (v4u){0u, 0u, 0u, 0u};
                if (tt >= 0 && tt < L) { const bf16* p = PROJ + (size_t)(r0 - 15 + rr) * NP + C_CIN + 8 * ch; const v4u a = *(const v4u*)p, g = *(const v4u*)(p + 512);
                    o.x = pk2(bflo(a.x) * bflo(g.x), bfhi(a.x) * bfhi(g.x)); o.y = pk2(bflo(a.y) * bflo(g.y), bfhi(a.y) * bfhi(g.y));
                    o.z = pk2(bflo(a.z) * bflo(g.z), bfhi(a.z) * bfhi(g.z)); o.w = pk2(bflo(a.w) * bflo(g.w), bfhi(a.w) * bfhi(g.w)); }
                *(LAS v4u*)(Xt + rr * 1024 + ch * 16) = o; } }
        __syncthreads();
        f32x4 a0[4], a1[4];
#pragma unroll
        for (int tk = 0; tk < 4; ++tk) { a0[tk] = bd0; a1[tk] = bd1; }
        f32x4 wq0[4], wq1[4];
#pragma unroll
        for (int d = 0; d < 4; ++d) { wq0[d] = (f32x4){0.f, 0.f, 0.f, 0.f}; wq1[d] = (f32x4){0.f, 0.f, 0.f, 0.f}; }
#pragma unroll
        for (int rr = 0; rr < 34; ++rr) {
            if (rr <= 30) { wq0[0] = *(const LAS f32x4*)(Wt + ((rr * 2 + 0) * 64 + lane) * 4); wq1[0] = *(const LAS f32x4*)(Wt + ((rr * 2 + 1) * 64 + lane) * 4); }
            else { wq0[0] = (f32x4){0.f, 0.f, 0.f, 0.f}; wq1[0] = (f32x4){0.f, 0.f, 0.f, 0.f}; }
            const v4u g = *(const LAS v4u*)(Xt + (4 * w + rr) * 1024 + lane * 16);
            const f32x4 x0 = (f32x4){bflo(g.x), bfhi(g.x), bflo(g.y), bfhi(g.y)}, x1 = (f32x4){bflo(g.z), bfhi(g.z), bflo(g.w), bfhi(g.w)};
#pragma unroll
            for (int tk = 0; tk < 4; ++tk) { const int j = rr - tk; if (j >= 0 && j <= 30) { a0[tk] = a0[tk] + x0 * wq0[tk]; a1[tk] = a1[tk] + x1 * wq1[tk]; } }
            wq0[3] = wq0[2]; wq0[2] = wq0[1]; wq0[1] = wq0[0]; wq1[3] = wq1[2]; wq1[2] = wq1[1]; wq1[1] = wq1[0];
        }
#pragma unroll
        for (int tk = 0; tk < 4; ++tk) { f32x4 x0 = a0[tk], x1 = a1[tk];
            const float mean = wave_sum((x0[0] + x0[1]) + (x0[2] + x0[3]) + (x1[0] + x1[1]) + (x1[2] + x1[3])) * (1.f / 512.f);
            x0 = x0 - mean; x1 = x1 - mean;
            const float var = wave_sum((x0[0] * x0[0] + x0[1] * x0[1]) + (x0[2] * x0[2] + x0[3] * x0[3]) + (x1[0] * x1[0] + x1[1] * x1[1]) + (x1[2] * x1[2] + x1[3] * x1[3])) * (1.f / 512.f);
            const float rstd = 1.f / sqrtf(var + LN_EPS);
            f32x4 y0 = x0 * rstd * gc0 + bc0, y1 = x1 * rstd * gc1 + bc1;
#pragma unroll
            for (int q = 0; q < 4; ++q) { y0[q] = y0[q] / (1.f + __expf(-y0[q])); y1[q] = y1[q] / (1.f + __expf(-y1[q])); }
            v4u o; o.x = pk2(y0[0], y0[1]); o.y = pk2(y0[2], y0[3]); o.z = pk2(y1[0], y1[1]); o.w = pk2(y1[2], y1[3]);
            *(v4u*)(U + (size_t)(r0 + 4 * w + tk) * 512 + 8 * lane) = o; }
        __syncthreads();
    }
}

typedef float f32x16 __attribute__((ext_vector_type(16)));
typedef short v4i16 __attribute__((ext_vector_type(4)));
#define MFMA32(a, b, c) __builtin_amdgcn_mfma_f32_32x32x16_bf16(a, b, c, 0, 0, 0)
constexpr int AT_KBUF = 13312, AT_VBUF = 8192;
constexpr int AT_K0 = 0, AT_V0 = 3 * AT_KBUF, AT_RPB = AT_V0 + 3 * AT_VBUF, AT_QR = AT_RPB + 15 * 128 * 4, AT_END = AT_QR + 8 * 4096;
static_assert(AT_END <= RING_BYTES, "attention LDS map");
template <int MODE> __device__ __forceinline__ void attn_unit(const Ctx& C, int l, int unit) {
    constexpr bool MLA = MODE < 2; constexpr int DQK = MLA ? 96 : 64, KC = DQK / 8, KS = DQK / 16, RS = DQK * 2 + 16, NCH = 64 * KC + 512;
    constexpr int QT = (MODE == 0 || MODE == 2) ? 2 : 1;
    const int w = C.wave, lane = lane_id(), tid = w * 64 + lane, r = lane & 31, hh = lane >> 5;
    const bf16* PROJ = WSP(bf16, WS_R); const bf16* QB = WSP(bf16, WS_QB); const bf16* KVB = WSP(bf16, WS_KVB); const bf16* KR = WSP(bf16, WS_KR); const float* TAB = WSP(float, WS_TAB);
    bf16* Yo = WSP(bf16, MLA ? WS_YB : WS_YA);
    LAS unsigned char* lds = C.lds;
    int b, hd, q0, T, NB = 0, rs_min = 0, gi = 0;
    if (MODE == 0) { hd = unit & 7; const int qb = (unit >> 3) & 3; b = unit >> 5; q0 = b * 2048 + qb * 512; T = 36; }
    else if (MODE == 2) { hd = unit & 7; const int ib = (unit >> 3) & 3; b = unit >> 5; q0 = b * 2048 + ib * 512; gi = ib * 8 + w;
        rs_min = min(max(ib * 8 - 4, 0), 24); const int rs_max = min(max(ib * 8 + 3, 0), 24); NB = rs_max - rs_min + 8; T = NB + 4; }
    else { hd = unit & 7; b = unit >> 3; q0 = ML + b * 256; T = 4; }
    const int qrow0 = q0 + 32 * QT * w + r;
    constexpr int NKQ = (64 * (KC + 1)) / 64, NQ = NKQ + 8;
    auto tile_row0 = [&](int t) -> int {
        if (MODE == 0) return t < 4 ? ML + b * 256 + 64 * t : b * 2048 + 64 * (t - 4);
        if (MODE == 2) return t < NB ? b * 2048 + (rs_min + t) * 64 : ML + b * 256 + 64 * (t - NB);
        return ML + b * 256 + 64 * t; };
    int goff[3]; bool gkr[3]; int dblk[3]; bool dk[3];
#pragma unroll
    for (int j = 0; j < 3; ++j) { int q_ = w + 8 * j; if (q_ >= NQ) q_ -= 8; gkr[j] = false; dk[j] = q_ < NKQ; dblk[j] = (q_ < NKQ ? q_ : q_ - NKQ) * 1024;
        if (q_ < NKQ) { const int p_ = 64 * q_ + lane, key_ = p_ / (KC + 1), kc0_ = p_ - key_ * (KC + 1), kc_ = kc0_ == KC ? 0 : kc0_;
            if (MLA) { if (kc_ < 8) goff[j] = key_ * 1024 + hd * 128 + 8 * kc_; else { goff[j] = key_ * 32 + 8 * (kc_ - 8); gkr[j] = true; } } else goff[j] = key_ * NP + C_KA + hd * 64 + 8 * kc_; }
        else { const int p_ = 64 * (q_ - NKQ) + lane, dh_ = p_ >> 8, key_ = (p_ >> 2) & 63, vc_ = dh_ * 4 + (p_ & 3);
            goff[j] = MLA ? key_ * 1024 + hd * 128 + 64 + 8 * vc_ : key_ * NP + C_VA + hd * 64 + 8 * vc_; } }
#define AT_ISSUE(t, slot) do { const int row0_ = tile_row0(t); const bf16* bm_ = MLA ? KVB + (size_t)row0_ * 1024 : PROJ + (size_t)row0_ * NP; const bf16* br_ = KR + (size_t)row0_ * 32; \
        _Pragma("unroll") for (int j = 0; j < 3; ++j) { const bf16* g_ = ((MLA && gkr[j]) ? br_ : bm_) + goff[j]; \
            LAS unsigned char* d_ = lds + (dk[j] ? AT_K0 + (slot) * AT_KBUF : AT_V0 + (slot) * AT_VBUF) + dblk[j]; \
            __builtin_amdgcn_global_load_lds((const unsigned*)g_, (LAS unsigned*)d_, 16, 0, 0); } } while (0)
    constexpr int KSR = (MODE == 0) ? 4 : KS;
    bf16x8 qf[QT][KSR];
    LAS unsigned char* qrl = lds + AT_QR + w * 4096 + lane * 16;
#pragma unroll
    for (int qt = 0; qt < QT; ++qt) { const int qrow = qrow0 + 32 * qt;
        const bf16* qp = MLA ? QB + (size_t)qrow * 768 + hd * 96 : PROJ + (size_t)qrow * NP + C_QA + hd * 64;
#pragma unroll
        for (int ks = 0; ks < KSR; ++ks) qf[qt][ks] = *(const bf16x8*)(qp + 16 * ks + 8 * hh);
        if (MODE == 0) {
            const float* tb = TAB + (size_t)(qrow & 2047) * 32;
#pragma unroll
            for (int g = 0; g < 2; ++g) { const v4u own = *(const v4u*)(qp + 16 * (4 + g) + 8 * hh); v4u oth; oth.x = xshfl_u<32>(own.x); oth.y = xshfl_u<32>(own.y); oth.z = xshfl_u<32>(own.z); oth.w = xshfl_u<32>(own.w);
                const f32x4 c0 = *(const f32x4*)(tb + g * 16), c1 = *(const f32x4*)(tb + g * 16 + 4), s0 = *(const f32x4*)(tb + g * 16 + 8), s1 = *(const f32x4*)(tb + g * 16 + 12);
                const float sg = hh ? 1.f : -1.f; v4u nw;
                nw.x = pk2(bflo(own.x) * c0[0] + sg * bflo(oth.x) * s0[0], bfhi(own.x) * c0[1] + sg * bfhi(oth.x) * s0[1]); nw.y = pk2(bflo(own.y) * c0[2] + sg * bflo(oth.y) * s0[2], bfhi(own.y) * c0[3] + sg * bfhi(oth.y) * s0[3]);
                nw.z = pk2(bflo(own.z) * c1[0] + sg * bflo(oth.z) * s1[0], bfhi(own.z) * c1[1] + sg * bfhi(oth.z) * s1[1]); nw.w = pk2(bflo(own.w) * c1[2] + sg * bflo(oth.w) * s1[2], bfhi(own.w) * c1[3] + sg * bfhi(oth.w) * s1[3]);
                *(LAS v4u*)(qrl + (qt * 2 + g) * 1024) = nw; }
        } }
    if (MODE == 2) {
        LAS float* rt = (LAS float*)(lds + AT_RPB); const float* rpb = INP(I_RPB) + ((size_t)l * 8 + hd) * 15 * 31;
        for (int i = tid; i < 15 * 128; i += NTHREADS) { const int dr = i >> 7, dc = (i & 127) - 64; rt[i] = (dc >= -15 && dc <= 15) ? rpb[dr * 31 + dc + 15] * 1.4426950408889634f : 0.f; }
        asm volatile("s_waitcnt vmcnt(0) lgkmcnt(0)" ::: "memory");
    }
    constexpr float C2 = (MLA ? 0.10206207261596577f : 0.125f) * 1.4426950408889634f;
    f32x16 o[QT][2]; float m_[QT], l_[QT];
#pragma unroll
    for (int qt = 0; qt < QT; ++qt) { m_[qt] = -1e30f; l_[qt] = 0.f;
#pragma unroll
        for (int i = 0; i < 16; ++i) { o[qt][0][i] = 0.f; o[qt][1][i] = 0.f; } }
    const int rs_w = min(max(gi - 4, 0), 24);
    const int kroff = r * RS + hh * 16;
    const int vroff = ((lane >> 4) & 1) * 32 + ((lane & 15) >> 2) * 64 + (lane & 3) * 8 + hh * 4 * 64;
    AT_ISSUE(0, 0); AT_ISSUE(1, 1);
    int buf = 0, nbuf = 2;
    for (int t = 0; t < T; ++t) {
        if (t + 1 < T) asm volatile("s_waitcnt vmcnt(3)" ::: "memory"); else asm volatile("s_waitcnt vmcnt(0)" ::: "memory");
        __builtin_amdgcn_s_barrier(); asm volatile("" ::: "memory");
        if (t + 2 < T) AT_ISSUE(t + 2, nbuf);
        bool active = true; int kr = 0;
        if (MODE == 2 && t < NB) { kr = rs_min + t; active = (kr >= rs_w) && (kr < rs_w + 8); }
        if (active) {
            const LAS unsigned char* kb = lds + AT_K0 + buf * AT_KBUF + kroff; const LAS unsigned char* vb = lds + AT_V0 + buf * AT_VBUF + vroff;
            const bool band = (MODE == 2) && (t < NB);
#pragma unroll
            for (int kt = 0; kt < 2; ++kt) {
                if constexpr (QT == 2) { if (!band) {
                    const LAS unsigned char* kbt = kb + kt * 32 * RS;
                    auto qfrag = [&](int qt, int ks) -> bf16x8 { if (ks < KSR) return qf[qt][ks < KSR ? ks : 0]; return *(const LAS bf16x8*)(qrl + (qt * 2 + (ks - 4)) * 1024); };
                    auto softmax_nb = [&](f32x16& sv, int qt, bf16x8 (&pfo)[2], float& alpha) {
                        float mx = -1e30f, ps = 0.f;
#pragma unroll
                        for (int i = 0; i < 16; ++i) mx = fmaxf(mx, sv[i]);
                        mx = pair32_max(mx) * C2;
                        const float mn = fmaxf(m_[qt], mx); alpha = __builtin_amdgcn_exp2f(m_[qt] - mn); m_[qt] = mn;
#pragma unroll
                        for (int sx = 0; sx < 2; ++sx) { unsigned a[4];
#pragma unroll
                            for (int jj = 0; jj < 4; ++jj) { const int i = 8 * sx + 2 * jj;
                                const float p0 = __builtin_amdgcn_exp2f(fmaf(sv[i], C2, -mn)), p1 = __builtin_amdgcn_exp2f(fmaf(sv[i + 1], C2, -mn));
                                ps += p0 + p1; a[jj] = pk2(p0, p1); }
                            pfo[sx] = __builtin_bit_cast(bf16x8, (v4u){a[0], a[1], a[2], a[3]}); }
                        l_[qt] = l_[qt] * alpha + ps; };
                    f32x16 sA, sB;
#pragma unroll
                    for (int i = 0; i < 16; ++i) { sA[i] = 0.f; sB[i] = 0.f; }
                    bf16x8 kfr[KS];
#pragma unroll
                    for (int ks = 0; ks < KS; ++ks) { kfr[ks & 3] = *(const LAS bf16x8*)(kbt + ks * 32); sA = MFMA32(kfr[ks & 3], qfrag(0, ks), sA); }
                    __builtin_amdgcn_sched_barrier(0);
                    bf16x8 pfA[2], pfB[2]; float alA, alB;
                    bf16x8 kq[KS]; bf16x8 qq[KS];
#pragma unroll
                    for (int ks = 0; ks < KS; ++ks) { kq[ks] = *(const LAS bf16x8*)(kbt + ks * 32); qq[ks] = qfrag(1, ks); }
                    __builtin_amdgcn_sched_barrier(0);
#pragma unroll
                    for (int ks = 0; ks < KS; ++ks) sB = MFMA32(kq[ks], qq[ks], sB);
                    softmax_nb(sA, 0, pfA, alA);
#pragma unroll
                    for (int g = 0; g < KS; ++g) { __builtin_amdgcn_sched_group_barrier(0x008, 1, 0); __builtin_amdgcn_sched_group_barrier(0x002, 14, 0); }
                    __builtin_amdgcn_sched_barrier(0);
                    if (!__all(alA == 1.f)) {
#pragma unroll
                        for (int i = 0; i < 16; ++i) { o[0][0][i] *= alA; o[0][1][i] *= alA; } }
                    bf16x8 va[2], vc[2];
#pragma unroll
                    for (int sx = 0; sx < 2; ++sx) { const int rowb = (32 * kt + 16 * sx) * 64;
                        const v4i16 a00 = __builtin_amdgcn_ds_read_tr16_b64_v4i16((LAS v4i16*)(vb + rowb)), a01 = __builtin_amdgcn_ds_read_tr16_b64_v4i16((LAS v4i16*)(vb + rowb + 8 * 64));
                        const v4i16 a10 = __builtin_amdgcn_ds_read_tr16_b64_v4i16((LAS v4i16*)(vb + 4096 + rowb)), a11 = __builtin_amdgcn_ds_read_tr16_b64_v4i16((LAS v4i16*)(vb + 4096 + rowb + 8 * 64));
                        va[sx] = __builtin_shufflevector(a00, a01, 0, 1, 2, 3, 4, 5, 6, 7); vc[sx] = __builtin_shufflevector(a10, a11, 0, 1, 2, 3, 4, 5, 6, 7); }
                    __builtin_amdgcn_sched_barrier(0);
#pragma unroll
                    for (int sx = 0; sx < 2; ++sx) { o[0][0] = MFMA32(va[sx], pfA[sx], o[0][0]); o[0][1] = MFMA32(vc[sx], pfA[sx], o[0][1]); }
                    softmax_nb(sB, 1, pfB, alB);
#pragma unroll
                    for (int g = 0; g < 4; ++g) { __builtin_amdgcn_sched_group_barrier(0x008, 1, 0); __builtin_amdgcn_sched_group_barrier(0x002, 20, 0); }
                    __builtin_amdgcn_sched_barrier(0);
                    if (!__all(alB == 1.f)) {
#pragma unroll
                        for (int i = 0; i < 16; ++i) { o[1][0][i] *= alB; o[1][1][i] *= alB; } }
#pragma unroll
                    for (int sx = 0; sx < 2; ++sx) { o[1][0] = MFMA32(va[sx], pfB[sx], o[1][0]); o[1][1] = MFMA32(vc[sx], pfB[sx], o[1][1]); }
                    continue;
                } }
                f32x16 sc[QT];
#pragma unroll
                for (int qt = 0; qt < QT; ++qt)
#pragma unroll
                    for (int i = 0; i < 16; ++i) sc[qt][i] = 0.f;
#pragma unroll
                for (int ks = 0; ks < KS; ++ks) { const bf16x8 ka = *(const LAS bf16x8*)(kb + kt * 32 * RS + ks * 32);
#pragma unroll
                    for (int qt = 0; qt < QT; ++qt) { bf16x8 qb_; if (ks < KSR) qb_ = qf[qt][ks < KSR ? ks : 0]; else qb_ = *(const LAS bf16x8*)(qrl + (qt * 2 + (ks - 4)) * 1024);
                        sc[qt] = MFMA32(ka, qb_, sc[qt]); } }
                bf16x8 pf[QT][2];
#pragma unroll
                for (int qt = 0; qt < QT; ++qt) {
                    f32x16& s0 = sc[qt]; float mx = -1e30f, ps = 0.f, alpha;
                    if ((MODE == 2) && band) {
                        const bool part = qt != kt;
                        const int ilo = part ? (qt == 0 ? 0 : 12) : 0, ihi = part ? ilo + 4 : 16, sxv = qt == 0 ? 0 : 1;
                        const int ccol = 32 * qt + r; int cs = min(max(ccol - 8, 0), 48); asm volatile("" : "+v"(cs));
                        const LAS float* rt = (const LAS float*)(lds + AT_RPB) + (kr - gi + 7) * 128 + 64 - ccol + 32 * kt;
#pragma unroll
                        for (int i = 0; i < 16; ++i) if (i >= ilo && i < ihi) { const int k0 = 32 * kt + (i & 3) + 8 * (i >> 2) + 4 * hh; const bool v0 = (k0 >= cs) && (k0 < cs + 16);
                            s0[i] = v0 ? s0[i] * C2 + rt[(i & 3) + 8 * (i >> 2) + 4 * hh] : -1e30f; mx = fmaxf(mx, s0[i]); }
                        mx = pair32_max(mx);
                        const float mn = fmaxf(m_[qt], mx); alpha = __builtin_amdgcn_exp2f(m_[qt] - mn); m_[qt] = mn;
#pragma unroll
                        for (int sx = 0; sx < 2; ++sx) { if (part && sx != sxv) continue;
                            unsigned a[4];
#pragma unroll
                            for (int jj = 0; jj < 4; ++jj) { const int i = 8 * sx + 2 * jj;
                                if (!(i >= ilo && i < ihi)) { a[jj] = 0u; continue; }
                                float p0 = __builtin_amdgcn_exp2f(s0[i] - mn), p1 = __builtin_amdgcn_exp2f(s0[i + 1] - mn);
                                p0 = s0[i] > -1e29f ? p0 : 0.f; p1 = s0[i + 1] > -1e29f ? p1 : 0.f;
                                ps += p0 + p1; a[jj] = pk2(p0, p1); }
                            pf[qt][sx] = __builtin_bit_cast(bf16x8, (v4u){a[0], a[1], a[2], a[3]}); }
                    } else {
#pragma unroll
                        for (int i = 0; i < 16; ++i) mx = fmaxf(mx, s0[i]);
                        mx = pair32_max(mx) * C2;
                        const float mn = fmaxf(m_[qt], mx); alpha = __builtin_amdgcn_exp2f(m_[qt] - mn); m_[qt] = mn;
#pragma unroll
                        for (int sx = 0; sx < 2; ++sx) { unsigned a[4];
#pragma unroll
                            for (int jj = 0; jj < 4; ++jj) { const int i = 8 * sx + 2 * jj;
                                const float p0 = __builtin_amdgcn_exp2f(fmaf(s0[i], C2, -mn)), p1 = __builtin_amdgcn_exp2f(fmaf(s0[i + 1], C2, -mn));
                                ps += p0 + p1; a[jj] = pk2(p0, p1); }
                            pf[qt][sx] = __builtin_bit_cast(bf16x8, (v4u){a[0], a[1], a[2], a[3]}); }
                    }
                    l_[qt] = l_[qt] * alpha + ps;
                    if (!__all(alpha == 1.f)) {
#pragma unroll
                        for (int i = 0; i < 16; ++i) { o[qt][0][i] *= alpha; o[qt][1][i] *= alpha; } }
                }
#pragma unroll
                for (int sx = 0; sx < 2; ++sx) {
                    const int rowb = (32 * kt + 16 * sx) * 64;
                    const v4i16 a00 = __builtin_amdgcn_ds_read_tr16_b64_v4i16((LAS v4i16*)(vb + rowb)), a01 = __builtin_amdgcn_ds_read_tr16_b64_v4i16((LAS v4i16*)(vb + rowb + 8 * 64));
                    const v4i16 a10 = __builtin_amdgcn_ds_read_tr16_b64_v4i16((LAS v4i16*)(vb + 4096 + rowb)), a11 = __builtin_amdgcn_ds_read_tr16_b64_v4i16((LAS v4i16*)(vb + 4096 + rowb + 8 * 64));
                    const bf16x8 va = __builtin_shufflevector(a00, a01, 0, 1, 2, 3, 4, 5, 6, 7), vc = __builtin_shufflevector(a10, a11, 0, 1, 2, 3, 4, 5, 6, 7);
#pragma unroll
                    for (int qt = 0; qt < QT; ++qt) { if ((MODE == 2) && band && (qt != kt) && sx != (qt == 0 ? 0 : 1)) continue;
                        o[qt][0] = MFMA32(va, pf[qt][sx], o[qt][0]); o[qt][1] = MFMA32(vc, pf[qt][sx], o[qt][1]); } }
            }
        }
        buf = buf == 2 ? 0 : buf + 1; nbuf = nbuf == 2 ? 0 : nbuf + 1;
    }
#pragma unroll
    for (int qt = 0; qt < QT; ++qt) {
        const float lt = pair32_sum(l_[qt]), inv = 1.f / lt;
        bf16* op = Yo + (size_t)(qrow0 + 32 * qt) * 512 + hd * 64 + 4 * hh;
#pragma unroll
        for (int g4 = 0; g4 < 4; ++g4) { v2u w0, w1; w0.x = pk2(o[qt][0][4 * g4] * inv, o[qt][0][4 * g4 + 1] * inv); w0.y = pk2(o[qt][0][4 * g4 + 2] * inv, o[qt][0][4 * g4 + 3] * inv);
            w1.x = pk2(o[qt][1][4 * g4] * inv, o[qt][1][4 * g4 + 1] * inv); w1.y = pk2(o[qt][1][4 * g4 + 2] * inv, o[qt][1][4 * g4 + 3] * inv);
            *(v2u*)(op + 8 * g4) = w0; *(v2u*)(op + 32 + 8 * g4) = w1; } }
    __syncthreads();
#undef AT_ISSUE
}
__device__ __forceinline__ void phase_attn(const Ctx& C, int l) {
    for (int u = C.bid; u < 512; u += C.G) attn_unit<0>(C, l, u);
    for (int u = C.bid; u < 512; u += C.G) attn_unit<2>(C, l, u);
    if (l < NL - 1) for (int u = C.bid; u < 256; u += C.G) { if (u < 128) attn_unit<1>(C, l, u); else attn_unit<3>(C, l, u - 128); }
}

__device__ __forceinline__ float reduce16(float (&v)[16], int lane) {
#pragma unroll
    for (int i = 0; i < 8; ++i) { const bool hi = lane & 32; const float keep = hi ? v[i + 8] : v[i], send = hi ? v[i] : v[i + 8]; v[i] = keep + xshfl<32>(send); }
#pragma unroll
    for (int i = 0; i < 4; ++i) { const bool hi = lane & 16; const float keep = hi ? v[i + 4] : v[i], send = hi ? v[i] : v[i + 4]; v[i] = keep + xshfl<16>(send); }
#pragma unroll
    for (int i = 0; i < 2; ++i) { const bool hi = lane & 8; const float keep = hi ? v[i + 2] : v[i], send = hi ? v[i] : v[i + 2]; v[i] = keep + xshfl<8>(send); }
    { const bool hi = lane & 4; const float keep = hi ? v[1] : v[0], send = hi ? v[0] : v[1]; v[0] = keep + xshfl<4>(send); }
    v[0] += xshfl<2>(v[0]); v[0] += xshfl<1>(v[0]);
    return v[0];
}
__device__ __forceinline__ void phase_ln1(const Ctx& C, int l) {
    int lane = C.lane; OPAQUE(lane); const int gw = C.bid * NWAVES + C.wave, NGW = C.G * NWAVES;
    LAS float* Wr = (LAS float*)C.lds;
    const float* wr = INP(I_WROUTER) + (size_t)l * 1024 * 16;
    for (int idx = C.tid; idx < 16384; idx += NTHREADS) { const int c = idx >> 4, e = idx & 15; Wr[e * 1024 + c] = wr[idx]; }
    __syncthreads();
    const bf16* Yb = WSP(bf16, WS_YP); const float* X = WSP(float, WS_X); bf16* H2 = WSP(bf16, WS_HB); float* AFF = WSP(float, WS_AFF); float* STAT = WSP(float, WS_STAT);
    const float* XI = INP(I_X); const float* XC = INP(I_CTX) - (size_t)ML * DM;
    const float* MODS = WSP(float, WS_MODS) + (size_t)l * 17 * 6144;
    const float* lg = INP(I_LN1G) + l * 1024; const float* lb = INP(I_LN1B) + l * 1024;
    const int myexp = ((lane >> 5) & 1) * 8 + ((lane >> 4) & 1) * 4 + ((lane >> 3) & 1) * 2 + ((lane >> 2) & 1);
    const int nrp = (l == NL - 1 ? ML : MT) / 2;
    f32x4 nx[2][4]; v4u ny[2][2];
#define LN1_LOAD(rp_) do { const int r_ = 2 * (rp_); const float* xs_ = (l == 0 ? (r_ < ML ? XI : XC) : X) + (size_t)r_ * DM; _Pragma("unroll") for (int j = 0; j < 2; ++j) { const int c = 8 * (lane + 64 * j); \
        nx[0][2 * j] = *(const f32x4*)(xs_ + c); nx[0][2 * j + 1] = *(const f32x4*)(xs_ + c + 4); nx[1][2 * j] = *(const f32x4*)(xs_ + DM + c); nx[1][2 * j + 1] = *(const f32x4*)(xs_ + DM + c + 4); \
        ny[0][j] = *(const v4u*)(Yb + (size_t)r_ * DM + c); ny[1][j] = *(const v4u*)(Yb + (size_t)(r_ + 1) * DM + c); } } while (0)
    if (gw < nrp) LN1_LOAD(gw);
    for (int rp = gw; rp < nrp; rp += NGW) {
        const int row = 2 * rp; const int mr = row < ML ? (row >> 11) : 16; const float* md = MODS + (size_t)mr * 6144;
        f32x4 v[2][4]; float sa = 0.f, sb = 0.f;
#pragma unroll
        for (int j = 0; j < 2; ++j) { const int c = 8 * (lane + 64 * j); const f32x4 g1a = *(const f32x4*)(md + 2048 + c), g1b = *(const f32x4*)(md + 2048 + c + 4);
            v[0][2 * j] = nx[0][2 * j] * DN_ALPHA + g1a * pg8::unpack4((v2u){ny[0][j].x, ny[0][j].y}); v[0][2 * j + 1] = nx[0][2 * j + 1] * DN_ALPHA + g1b * pg8::unpack4((v2u){ny[0][j].z, ny[0][j].w});
            v[1][2 * j] = nx[1][2 * j] * DN_ALPHA + g1a * pg8::unpack4((v2u){ny[1][j].x, ny[1][j].y}); v[1][2 * j + 1] = nx[1][2 * j + 1] * DN_ALPHA + g1b * pg8::unpack4((v2u){ny[1][j].z, ny[1][j].w}); }
        if (rp + NGW < nrp) LN1_LOAD(rp + NGW);
#pragma unroll
        for (int j = 0; j < 4; ++j) { sa += (v[0][j][0] + v[0][j][1]) + (v[0][j][2] + v[0][j][3]); sb += (v[1][j][0] + v[1][j][1]) + (v[1][j][2] + v[1][j][3]); }
        const float mean0 = wave_sum(sa) * (1.f / 1024.f), mean1 = wave_sum(sb) * (1.f / 1024.f); float qa = 0.f, qb = 0.f;
#pragma unroll
        for (int j = 0; j < 4; ++j) { v[0][j] = v[0][j] - mean0; v[1][j] = v[1][j] - mean1;
            qa += (v[0][j][0] * v[0][j][0] + v[0][j][1] * v[0][j][1]) + (v[0][j][2] * v[0][j][2] + v[0][j][3] * v[0][j][3]);
            qb += (v[1][j][0] * v[1][j][0] + v[1][j][1] * v[1][j][1]) + (v[1][j][2] * v[1][j][2] + v[1][j][3] * v[1][j][3]); }
        const float rstd0 = 1.f / sqrtf(wave_sum(qa) * (1.f / 1024.f) + LN_EPS), rstd1 = 1.f / sqrtf(wave_sum(qb) * (1.f / 1024.f) + LN_EPS);
        if (lane == 0) *(f32x4*)(STAT + (size_t)row * 2) = (f32x4){mean0, rstd0, mean1, rstd1};
        float lg0[16], lg1[16];
#pragma unroll
        for (int e = 0; e < 16; ++e) { lg0[e] = 0.f; lg1[e] = 0.f; }
#pragma unroll
        for (int j = 0; j < 2; ++j) { const int c0 = 8 * (lane + 64 * j); f32x4 ha[2], hb[2];
#pragma unroll
            for (int h = 0; h < 2; ++h) { const int c = c0 + 4 * h;
                const f32x4 gg = *(const f32x4*)(lg + c), bb = *(const f32x4*)(lb + c), scl = *(const f32x4*)(md + 4096 + c) + 1.f, shf = *(const f32x4*)(md + 3072 + c);
                const f32x4 xa = v[0][2 * j + h] * rstd0 * gg + bb, xb = v[1][2 * j + h] * rstd1 * gg + bb;
                ha[h] = xa * scl + shf; hb[h] = xb * scl + shf; }
            *(v4u*)(H2 + (size_t)row * DM + c0) = pg8::pack8(ha[0], ha[1]); *(v4u*)(H2 + (size_t)(row + 1) * DM + c0) = pg8::pack8(hb[0], hb[1]);
#pragma unroll
            for (int h = 0; h < 2; ++h) {
#pragma unroll
                for (int e = 0; e < 16; ++e) { const f32x4 wv = *(const LAS f32x4*)(Wr + e * 1024 + c0 + 4 * h);
                    lg0[e] += (ha[h][0] * wv[0] + ha[h][1] * wv[1]) + (ha[h][2] * wv[2] + ha[h][3] * wv[3]); lg1[e] += (hb[h][0] * wv[0] + hb[h][1] * wv[1]) + (hb[h][2] * wv[2] + hb[h][3] * wv[3]); }
                asm volatile("" ::: "memory"); } }
        const float t0 = reduce16(lg0, lane), t1 = reduce16(lg1, lane);
        float m0 = t0, m1 = t1;
        m0 = fmaxf(m0, xshfl<4>(m0)); m1 = fmaxf(m1, xshfl<4>(m1)); m0 = fmaxf(m0, xshfl<8>(m0)); m1 = fmaxf(m1, xshfl<8>(m1)); m0 = fmaxf(m0, xshfl<16>(m0)); m1 = fmaxf(m1, xshfl<16>(m1)); m0 = pair32_max(m0); m1 = pair32_max(m1);
        const float p0 = expf(t0 - m0), p1 = expf(t1 - m1); float d0 = p0, d1 = p1;
        d0 += xshfl<4>(d0); d1 += xshfl<4>(d1); d0 += xshfl<8>(d0); d1 += xshfl<8>(d1); d0 += xshfl<16>(d0); d1 += xshfl<16>(d1); d0 = pair32_sum(d0); d1 = pair32_sum(d1);
        if ((lane & 3) == 0) { AFF[(size_t)row * 16 + myexp] = p0 / d0; AFF[(size_t)(row + 1) * 16 + myexp] = p1 / d1; }
    }
#undef LN1_LOAD
}

__device__ __forceinline__ void phase_topk(const Ctx& Cc, int l) {
    Ctx C = Cc; OPAQUE(C.tid);
    LAS unsigned long long* a = (LAS unsigned long long*)C.lds;
    const float* AFF = WSP(float, WS_AFF); int* SEL = WSP(int, WS_SEL); int* IDX = WSP(int, WS_IDX);
    const int nitem = l == NL - 1 ? 256 : 512;
    for (int item = C.bid; item < nitem; item += C.G) {
        const bool lat = item < 256; const int it = lat ? item : item - 256, b = it >> 4, e = it & 15;
        const int N = lat ? 2048 : 256, cap = lat ? CAPL : CAPC, base = lat ? b * 2048 : ML + b * 256, slotbase = lat ? b * CAPL : NBATCH * CAPL + b * CAPC;
        for (int t = C.tid; t < N; t += NTHREADS) a[t] = ((unsigned long long)__float_as_uint(AFF[(size_t)(base + t) * 16 + e]) << 32) | (unsigned long long)(0xFFFFFFFFu - (unsigned)t);
        __syncthreads();
        for (int k = 2; k <= N; k <<= 1)
            for (int j = k >> 1; j > 0; j >>= 1) {
                for (int p = C.tid; p < N / 2; p += NTHREADS) {
                    const int i = ((p & ~(j - 1)) << 1) | (p & (j - 1)), ij = i | j;
                    const unsigned long long x = a[i], y = a[ij];
                    const bool desc = (i & k) == 0;
                    if (desc ? (x < y) : (x > y)) { a[i] = y; a[ij] = x; }
                }
                __syncthreads();
            }
        for (int p = C.tid; p < N; p += NTHREADS) { const int tok = (int)(0xFFFFFFFFu - (unsigned)a[p]);
            SEL[(size_t)(base + tok) * 16 + e] = p < cap ? p : -1;
            if (p < cap) IDX[e * ROWS_E + slotbase + p] = base + tok; }
        __syncthreads();
    }
}

__device__ __forceinline__ void phase_gather(const Ctx& C) {
    int lane = C.lane; OPAQUE(lane); const int gw = C.bid * NWAVES + C.wave, NGW = C.G * NWAVES;
    const int* IDX = WSP(int, WS_IDX); const bf16* H2 = WSP(bf16, WS_HB); bf16* XG = WSP(bf16, WS_XG);
    for (int r = gw; r < MG; r += NGW) { const int src = IDX[r]; const v4u* s = (const v4u*)(H2 + (size_t)src * DM); v4u* d = (v4u*)(XG + (size_t)r * DM);
        const v4u a = s[lane], b = s[lane + 64]; d[lane] = a; d[lane + 64] = b; }
}

__device__ __forceinline__ void phase_combine(const Ctx& C, int l) {
    int lane = C.lane; OPAQUE(lane); const int gw = C.bid * NWAVES + C.wave, NGW = C.G * NWAVES;
    const bf16* Y = WSP(bf16, WS_Y); float* X = WSP(float, WS_X); bf16* H = WSP(bf16, WS_HB); const float* AFF = WSP(float, WS_AFF); const int* SEL = WSP(int, WS_SEL);
    const bf16* Yp = WSP(bf16, WS_YP); const float* STAT = WSP(float, WS_STAT); const float* l1g = INP(I_LN1G) + l * 1024; const float* l1b = INP(I_LN1B) + l * 1024;
    const float* XI = INP(I_X); const float* XC = INP(I_CTX) - (size_t)ML * DM;
    const float* MODS = WSP(float, WS_MODS) + (size_t)l * 17 * 6144; const float* MODN = MODS + 17 * 6144;
    const float* lg = INP(I_LN2G) + l * 1024; const float* lb = INP(I_LN2B) + l * 1024;
    const int nrp = (l == NL - 1 ? ML : MT) / 2;
    f32x4 nxa[4], nxb[4]; v4u nya[2], nyb[2]; f32x4 nst = (f32x4){0.f, 0.f, 0.f, 0.f}; int nsel = 0; float naff = 0.f;
#define CMB_LOAD(rp_) do { const int r_ = 2 * (rp_); nsel = SEL[(size_t)r_ * 16 + (lane & 31)]; naff = AFF[(size_t)r_ * 16 + (lane & 31)]; nst = *(const f32x4*)(STAT + (size_t)r_ * 2); \
        const float* xs_ = (l == 0 ? (r_ < ML ? XI : XC) : (const float*)X) + (size_t)r_ * DM; \
        _Pragma("unroll") for (int j = 0; j < 2; ++j) { nya[j] = *(const v4u*)(Yp + (size_t)r_ * DM + 8 * (lane + 64 * j)); nyb[j] = *(const v4u*)(Yp + (size_t)(r_ + 1) * DM + 8 * (lane + 64 * j)); \
            _Pragma("unroll") for (int h = 0; h < 2; ++h) { const int c = 8 * (lane + 64 * j) + 4 * h; nxa[2 * j + h] = *(const f32x4*)(xs_ + c); nxb[2 * j + h] = *(const f32x4*)(xs_ + DM + c); } } } while (0)
    if (gw < nrp) CMB_LOAD(gw);
    for (int rp = gw; rp < nrp; rp += NGW) {
        const int row = 2 * rp; const bool lat = row < ML; const int mr = lat ? (row >> 11) : 16; const float* md = MODS + (size_t)mr * 6144;
        const int rb = lat ? (row >> 11) * CAPL : NBATCH * CAPL + ((row - ML) >> 8) * CAPC;
        const int selv = nsel; const float affv = naff;
        f32x4 xa[4], xb[4];
        {
            const f32x4 st = nst;
#pragma unroll
            for (int j = 0; j < 2; ++j) { const int c = 8 * (lane + 64 * j); const f32x4 g1a = *(const f32x4*)(md + 2048 + c), g1b = *(const f32x4*)(md + 2048 + c + 4);
                const f32x4 gga = *(const f32x4*)(l1g + c), ggb = *(const f32x4*)(l1g + c + 4), bba = *(const f32x4*)(l1b + c), bbb = *(const f32x4*)(l1b + c + 4);
                xa[2 * j] = ((nxa[2 * j] * DN_ALPHA + g1a * pg8::unpack4((v2u){nya[j].x, nya[j].y})) - st[0]) * st[1] * gga + bba; xa[2 * j + 1] = ((nxa[2 * j + 1] * DN_ALPHA + g1b * pg8::unpack4((v2u){nya[j].z, nya[j].w})) - st[0]) * st[1] * ggb + bbb;
                xb[2 * j] = ((nxb[2 * j] * DN_ALPHA + g1a * pg8::unpack4((v2u){nyb[j].x, nyb[j].y})) - st[2]) * st[3] * gga + bba; xb[2 * j + 1] = ((nxb[2 * j + 1] * DN_ALPHA + g1b * pg8::unpack4((v2u){nyb[j].z, nyb[j].w})) - st[2]) * st[3] * ggb + bbb; }
        }
        if (rp + NGW < nrp) CMB_LOAD(rp + NGW);
        unsigned long long bal = __ballot(selv >= 0);
        unsigned ma = (unsigned)(bal & 0xffffu), mb = (unsigned)((bal >> 16) & 0xffffu);
        f32x4 acca[4], accb[4];
#pragma unroll
        for (int j = 0; j < 4; ++j) { acca[j] = (f32x4){0.f, 0.f, 0.f, 0.f}; accb[j] = (f32x4){0.f, 0.f, 0.f, 0.f}; }
        while (ma | mb) {
            const int ea = ma ? __builtin_ctz(ma) : 0, eb = mb ? __builtin_ctz(mb) : 0;
            const int sa = __builtin_amdgcn_readlane(selv, ea), sb = __builtin_amdgcn_readlane(selv, 16 + eb); float fa = __uint_as_float(__builtin_amdgcn_readlane(__float_as_uint(affv), ea)), fb = __uint_as_float(__builtin_amdgcn_readlane(__float_as_uint(affv), 16 + eb));
            if (!ma) fa = 0.f; if (!mb) fb = 0.f;
            const bf16* ya = Y + ((size_t)ea * ROWS_E + rb + (ma ? sa : 0)) * DM; const bf16* yb = Y + ((size_t)eb * ROWS_E + rb + (mb ? sb : 0)) * DM;
            v4u wa[2], wb[2];
#pragma unroll
            for (int j = 0; j < 2; ++j) { wa[j] = *(const v4u*)(ya + 8 * (lane + 64 * j)); wb[j] = *(const v4u*)(yb + 8 * (lane + 64 * j)); }
#pragma unroll
            for (int j = 0; j < 2; ++j) { acca[2 * j] = acca[2 * j] + pg8::unpack4((v2u){wa[j].x, wa[j].y}) * fa; acca[2 * j + 1] = acca[2 * j + 1] + pg8::unpack4((v2u){wa[j].z, wa[j].w}) * fa;
                accb[2 * j] = accb[2 * j] + pg8::unpack4((v2u){wb[j].x, wb[j].y}) * fb; accb[2 * j + 1] = accb[2 * j + 1] + pg8::unpack4((v2u){wb[j].z, wb[j].w}) * fb; }
            ma &= ma - 1; mb &= mb - 1;
        }
        float sma = 0.f, smb = 0.f;
#pragma unroll
        for (int j = 0; j < 2; ++j)
#pragma unroll
            for (int h = 0; h < 2; ++h) { const int q = 2 * j + h; const f32x4 g2 = *(const f32x4*)(md + 5120 + 8 * (lane + 64 * j) + 4 * h); xa[q] = xa[q] * DN_ALPHA + g2 * acca[q]; xb[q] = xb[q] * DN_ALPHA + g2 * accb[q];
                sma += (xa[q][0] + xa[q][1]) + (xa[q][2] + xa[q][3]); smb += (xb[q][0] + xb[q][1]) + (xb[q][2] + xb[q][3]); }
        const float mean0 = wave_sum(sma) * (1.f / 1024.f), mean1 = wave_sum(smb) * (1.f / 1024.f); float qa = 0.f, qb = 0.f;
#pragma unroll
        for (int j = 0; j < 4; ++j) { xa[j] = xa[j] - mean0; xb[j] = xb[j] - mean1;
            qa += (xa[j][0] * xa[j][0] + xa[j][1] * xa[j][1]) + (xa[j][2] * xa[j][2] + xa[j][3] * xa[j][3]); qb += (xb[j][0] * xb[j][0] + xb[j][1] * xb[j][1]) + (xb[j][2] * xb[j][2] + xb[j][3] * xb[j][3]); }
        const float rstd0 = 1.f / sqrtf(wave_sum(qa) * (1.f / 1024.f) + LN_EPS), rstd1 = 1.f / sqrtf(wave_sum(qb) * (1.f / 1024.f) + LN_EPS);
#pragma unroll
        for (int j = 0; j < 2; ++j) { const int c0 = 8 * (lane + 64 * j); f32x4 ya[2], yb[2];
#pragma unroll
            for (int h = 0; h < 2; ++h) { const int c = c0 + 4 * h; const f32x4 gg = *(const f32x4*)(lg + c), bb = *(const f32x4*)(lb + c);
                ya[h] = xa[2 * j + h] * rstd0 * gg + bb; yb[h] = xb[2 * j + h] * rstd1 * gg + bb; }
            if (l < NL - 1) { const float* mn = MODN + (size_t)mr * 6144; f32x4 ha[2], hb[2];
#pragma unroll
                for (int h = 0; h < 2; ++h) { const int c = c0 + 4 * h; *(f32x4*)(X + (size_t)row * DM + c) = ya[h]; *(f32x4*)(X + (size_t)(row + 1) * DM + c) = yb[h];
                    const f32x4 scl = *(const f32x4*)(mn + 1024 + c) + 1.f, shf = *(const f32x4*)(mn + c); ha[h] = ya[h] * scl + shf; hb[h] = yb[h] * scl + shf; }
                *(v4u*)(H + (size_t)row * DM + c0) = pg8::pack8(ha[0], ha[1]); *(v4u*)(H + (size_t)(row + 1) * DM + c0) = pg8::pack8(hb[0], hb[1]); }
            else if (lat) {
#pragma unroll
                for (int h = 0; h < 2; ++h) { const int c = c0 + 4 * h; *(f32x4*)(C.out + (size_t)row * DM + c) = ya[h]; *(f32x4*)(C.out + (size_t)(row + 1) * DM + c) = yb[h]; } } }
    }
#undef CMB_LOAD
}

enum { PH_MODS = 0, PH_MOD0, PH_WIN, PH_PREP, PH_CONV, PH_UQ, PH_UKV, PH_ATTN, PH_MERGE, PH_WOUT, PH_LN1, PH_TOPK, PH_GATHER, PH_GU, PH_DOWN, PH_COMB, PH_COUNT };
template <int PH> __device__ __forceinline__ void run_phase(const Ctx& C, int l) {
    if constexpr (PH == PH_MODS) { phase_mods(C); __syncthreads(); conv_weights(C, 0, 0, 100, 0, C.G); }
    if constexpr (PH == PH_MOD0) { phase_mod0(C); }
    if constexpr (PH == PH_WIN) { pg8::ProbPlain P{WSP(bf16, WS_HB), WSW(bf16, WS_WIN, l), 1024, 1024, 1024}; pg8::EpiWin E{WSP(bf16, WS_R)};
        if (l == NL - 1) { pg8::OrderWinLast S; S.init(C.G, C.bid); pg8::gemm_phase(C.lds, P, S, E, C.wave); }
        else { pg8::Order<1> S; S.init(MT / 256, NP / 256, C.G, C.bid); pg8::gemm_phase(C.lds, P, S, E, C.wave); }
        if (l < NL - 1) { const int rem = (MT / 256 * (NP / 256)) % C.G; __syncthreads(); conv_weights(C, l + 1, 0, 20, rem, C.G - rem); } }
    if constexpr (PH == PH_PREP) { phase_prep(C, l); }
    if constexpr (PH == PH_CONV) { phase_conv(C, l); }
    if constexpr (PH == PH_UQ) { pg8::ProbUp2 P{WSP(bf16, WS_CQN), WSP(bf16, WS_CKVN), WSW(bf16, WS_WUQ, l), WSW(bf16, WS_WUKV, l), 256, 256, 256};
        pg8::OrderUp2 S; S.init((l == NL - 1 ? ML : MT) / 256, C.G, C.bid); pg8::EpiUp2 E{WSP(bf16, WS_QB), WSP(bf16, WS_KVB)}; pg8::gemm_phase(C.lds, P, S, E, C.wave); }
    if constexpr (PH == PH_ATTN) { phase_attn(C, l); }
    if constexpr (PH == PH_MERGE) { pg8::ProbSeg3 P{WSP(bf16, WS_YA), WSW(bf16, WS_WOA, l), 512, 512, 512, (size_t)(36 * MiB / 2), (size_t)(1 * MiB / 2)};
        pg8::Order<3> S; S.init((l == NL - 1 ? ML : MT) / 256, 4, C.G, C.bid); pg8::EpiMerge E{WSP(bf16, WS_R), WSP(bf16, WS_HB)}; pg8::gemm_phase(C.lds, P, S, E, C.wave);
        if (l < NL - 1) { const int rem = (MT / 256 * 4) % C.G; __syncthreads(); conv_weights(C, l + 1, 20, 56, rem, C.G - rem); } }
    if constexpr (PH == PH_WOUT) { pg8::ProbPlain P{WSP(bf16, WS_HB), WSW(bf16, WS_WOUT, l), 1024, 1024, 1024}; pg8::Order<1> S; S.init((l == NL - 1 ? ML : MT) / 256, 4, C.G, C.bid);
        pg8::EpiBf16 E{WSP(bf16, WS_YP), 1024}; pg8::gemm_phase(C.lds, P, S, E, C.wave);
        if (l < NL - 1) { const int rem = (MT / 256 * 4) % C.G; __syncthreads(); conv_weights(C, l + 1, 56, 80, rem, C.G - rem); } }
    if constexpr (PH == PH_LN1) { phase_ln1(C, l); }
    if constexpr (PH == PH_TOPK) { phase_topk(C, l); }
    if constexpr (PH == PH_GATHER) { phase_gather(C); }
    if constexpr (PH == PH_GU) { pg8::OrderOrd S; S.o.init(l == NL - 1 ? 256 : 288, 8, C.G, C.bid, l == NL - 1 ? 16 : 0);
        LAS int* lidx = (LAS int*)(C.lds + LIDX_OFF); const int* IDXg = WSP(int, WS_IDX);
        { pg8::Unit uu; for (int i = 0; i < 10 && S.next(i, uu); ++i) if (C.tid < 256) lidx[i * 256 + C.tid] = IDXg[uu.pm * 256 + C.tid]; }
        __syncthreads();
        pg8::ProbMoEGather P{WSP(bf16, WS_HB), WSW(bf16, WS_WGU, l), lidx, 1024, 1024, 1024, 2048};
        pg8::EpiSwiGLU E{WSP(bf16, WS_HID)}; pg8::gemm_phase(C.lds, P, S, E, C.wave); }
    if constexpr (PH == PH_DOWN) { pg8::ProbMoE P{WSP(bf16, WS_HID), WSW(bf16, WS_WD, l), 1024, 1024, 1024, 1024}; pg8::Order<1> S; S.init(l == NL - 1 ? 256 : 288, 4, C.G, C.bid, l == NL - 1 ? 16 : 0);
        pg8::EpiBf16 E{WSP(bf16, WS_Y), 1024}; pg8::gemm_phase(C.lds, P, S, E, C.wave);
        if (l < NL - 1) { const int rem = (288 * 4) % C.G; __syncthreads(); conv_weights(C, l + 1, 80, 100, rem, C.G - rem); } }
    if constexpr (PH == PH_COMB) { phase_combine(C, l); }
}
template <int PH> __device__ __forceinline__ void call_phase(const Ctx& Cin, int l) { Ctx C = Cin; C.lane = lane_id(); OPAQUE(C.lane); asm volatile("" : "+s"(C.wave)); C.tid = C.wave * 64 + C.lane; asm volatile("" : "+s"(l)); asm volatile("" : "+s"(C.G)); asm volatile("" : "+s"(C.bid)); { unsigned long long w_ = (unsigned long long)C.ws; unsigned lo_ = (unsigned)w_, hi_ = (unsigned)(w_ >> 32); asm volatile("" : "+s"(lo_)); asm volatile("" : "+s"(hi_)); C.ws = (unsigned char*)(GAS unsigned char*)(((unsigned long long)hi_ << 32) | lo_); } run_phase<PH>(C, l); }
__global__ void __launch_bounds__(NTHREADS, 2) mega_fwd(Args args) {
    extern __shared__ __attribute__((aligned(16))) unsigned char lds_raw[];
    Ctx C;
    C.lds = (LAS unsigned char*)lds_raw;
    C.tid = threadIdx.x; C.lane = C.tid & 63; C.wave = __builtin_amdgcn_readfirstlane(C.tid >> 6);
    C.G = gridDim.x; C.bid = blockIdx.x;
    C.in = args.in; C.ws = (unsigned char*)(GAS unsigned char*)args.ws; C.out = (float*)(GAS float*)args.out;
    volatile LAS unsigned* MISC = (volatile LAS unsigned*)(C.lds + MISC_OFF);
    for (int u = C.tid; u < (LDS_BYTES - LDSCTL_OFF) / 4; u += NTHREADS) ((LAS unsigned*)(C.lds + LDSCTL_OFF))[u] = 0u;
    __syncthreads();
    XcdBarrier bar = xcd_barrier_post((unsigned*)(C.ws + WS_CTL) + 4096, MISC + 8, C.wave);
    call_phase<PH_MODS>(C, 0); xcd_barrier(bar);
    call_phase<PH_MOD0>(C, 0); xcd_barrier(bar);
    for (int l = 0; l < NL; ++l) {
        call_phase<PH_WIN>(C, l); xcd_barrier(bar);
        call_phase<PH_PREP>(C, l); xcd_barrier(bar);
        call_phase<PH_CONV>(C, l); __syncthreads(); call_phase<PH_UQ>(C, l); xcd_barrier(bar);
        call_phase<PH_ATTN>(C, l); xcd_barrier(bar);
        call_phase<PH_MERGE>(C, l); xcd_barrier(bar);
        call_phase<PH_WOUT>(C, l); xcd_barrier(bar);
        call_phase<PH_LN1>(C, l); xcd_barrier(bar);
        call_phase<PH_TOPK>(C, l); xcd_barrier(bar);
        call_phase<PH_GU>(C, l); xcd_barrier(bar);
        call_phase<PH_DOWN>(C, l); xcd_barrier(bar);
        call_phase<PH_COMB>(C, l); if (l < NL - 1) xcd_barrier(bar);
    }
}

extern "C" void kernel_launch(void* const* d_in, const int* in_sizes, int n_in, void* d_out, int out_size, void* d_ws, size_t ws_size, hipStream_t stream) {
    static int grid = 0;
    if (grid == 0) {
        if (n_in != 28 || out_size != ML * DM || ws_size < WS_END) { fprintf(stderr, "kernel_launch: unexpected shapes: n_in %d out %d ws %zu (need %zu)\n", n_in, out_size, ws_size, (size_t)WS_END); grid = -1; return; }
        int dev = 0, cus = 0, per_cu = 0;
        if (hipGetDevice(&dev) != hipSuccess || hipDeviceGetAttribute(&cus, hipDeviceAttributeMultiprocessorCount, dev) != hipSuccess) { grid = -1; return; }
        if (hipFuncSetAttribute((const void*)mega_fwd, hipFuncAttributeMaxDynamicSharedMemorySize, LDS_BYTES) != hipSuccess) { fprintf(stderr, "kernel_launch: hipFuncSetAttribute failed\n"); grid = -1; return; }
        if (hipOccupancyMaxActiveBlocksPerMultiprocessor(&per_cu, (const void*)mega_fwd, NTHREADS, LDS_BYTES) != hipSuccess || per_cu < 1) { fprintf(stderr, "kernel_launch: occupancy query says %d\n", per_cu); grid = -1; return; }
        (void)hipGetLastError();
        grid = cus;
    }
    if (grid < 0) return;
    (void)hipMemsetAsync((char*)d_ws + WS_CTL, 0, CTL_ZERO_BYTES, stream);
    Args a{};
    for (int i = 0; i < 28; ++i) a.in[i] = (const float*)d_in[i];
    a.out = (float*)d_out; a.ws = (unsigned char*)d_ws;
    hipLaunchKernelGGL(mega_fwd, dim3(grid), dim3(NTHREADS), LDS_BYTES, stream, a);
}
```

```cpp
#include <hip/hip_runtime.h>
#include <cstdio>
#include <cstdint>
#include <utility>

#ifndef MK_ONE_LAUNCH
#define MK_ONE_LAUNCH 0
#endif

#define GAS __attribute__((address_space(1)))
#define LAS __attribute__((address_space(3)))
typedef unsigned short bf16;
typedef unsigned v4u __attribute__((ext_vector_type(4)));
typedef unsigned v2u __attribute__((ext_vector_type(2)));
typedef float f32x4 __attribute__((ext_vector_type(4)));
typedef float f32x2 __attribute__((ext_vector_type(2)));
typedef short bf16x8 __attribute__((ext_vector_type(8)));

constexpr int NL = 4, DM = 1024, NBATCH = 16, SQ = 2048, CL = 256;
constexpr int ML = NBATCH * SQ, MC = NBATCH * CL, MT = ML + MC;
constexpr int NP = 6144;
constexpr int C_QA = 0, C_KA = 512, C_VA = 1024, C_CQ = 1536, C_CKV = 1792, C_KR = 1920, C_CIN = 2048, C_GT = 3072;
constexpr int NE = 16, CAPL = 256, CAPC = 32, ROWS_E = NBATCH * CAPL + NBATCH * CAPC, MG = NE * ROWS_E;
constexpr float LN_EPS = 1e-5f, RMS_EPS = 1e-6f, DN_ALPHA = 1.681792830507429f;
constexpr int NWAVES = 8, NTHREADS = 512;

constexpr size_t MiB = 1u << 20;
constexpr size_t WS_CTL = 0, CTL_ZERO_BYTES = 1 * MiB;
constexpr size_t WS_MODS = 1 * MiB;
constexpr size_t WS_TAB = 3 * MiB;
constexpr size_t WS_AFF = 4 * MiB;
constexpr size_t WS_SEL = 7 * MiB;
constexpr size_t WS_IDX = 10 * MiB;
constexpr size_t WS_KR = 11 * MiB;
constexpr size_t WS_WIN = 14 * MiB;
constexpr size_t WS_WUQ = 26 * MiB;
constexpr size_t WS_WUKV = 26 * MiB + 512 * 1024;
constexpr size_t WS_WOA = 27 * MiB, WS_WOB = 28 * MiB, WS_WPW2 = 29 * MiB;
constexpr size_t WS_WOUT = 30 * MiB;
constexpr size_t WS_WGU = 32 * MiB;
constexpr size_t WS_WD = 96 * MiB;
constexpr size_t WS_X = 128 * MiB;
constexpr size_t WS_HB = 272 * MiB;
constexpr size_t WS_QB = 344 * MiB;
constexpr size_t WS_KVB = 398 * MiB;
constexpr size_t WS_U = 542 * MiB;
constexpr size_t WS_YA = 470 * MiB;
constexpr size_t WS_YB = 506 * MiB;
constexpr size_t WS_CQN = WS_YB, WS_CKVN = WS_YB + 18 * MiB;
constexpr size_t WS_R = 578 * MiB;
constexpr size_t WS_XG = WS_R, WS_HID = WS_R + 144 * MiB, WS_Y = WS_R + 288 * MiB;
constexpr size_t WS_YP = WS_R;
constexpr size_t WS_STAT = 13 * MiB + 512 * 1024;
constexpr size_t WS_WSET = 996 * MiB;
constexpr size_t WS_END = WS_R + 432 * MiB + 114 * MiB;

constexpr int RING_BYTES = 131072, LDSCTL_OFF = RING_BYTES, MISC_OFF = LDSCTL_OFF + 320, LIDX_OFF = RING_BYTES + 1024, LDS_BYTES = 147456;

#define LDS_WAIT() asm volatile("s_waitcnt lgkmcnt(0)" ::: "memory")
#define VM_WAIT() asm volatile("s_waitcnt vmcnt(0)" ::: "memory")
__device__ __forceinline__ int lane_id() { int r; asm volatile("v_mbcnt_lo_u32_b32 %0, -1, 0\n\tv_mbcnt_hi_u32_b32 %0, -1, %0" : "=v"(r)); return r; }
__device__ __forceinline__ unsigned f2bf(float f) { unsigned u = __builtin_bit_cast(unsigned, f); return (u + 0x7fffu + ((u >> 16) & 1u)) >> 16; }
__device__ __forceinline__ unsigned pk2(float lo, float hi) { unsigned r; asm("v_cvt_pk_bf16_f32 %0, %1, %2" : "=v"(r) : "v"(lo), "v"(hi)); return r; }
__device__ __forceinline__ float bflo(unsigned w) { return __uint_as_float(w << 16); }
__device__ __forceinline__ float bfhi(unsigned w) { return __uint_as_float(w & 0xffff0000u); }
__device__ __forceinline__ float bf2f(bf16 v) { return __uint_as_float(((unsigned)v) << 16); }
template <int O> __device__ __forceinline__ unsigned xshfl_u(unsigned v) {
    if constexpr (O == 32) { const auto t = __builtin_amdgcn_permlane32_swap(v, v, false, false); return (lane_id() & 32) ? t[0] : t[1]; }
    else return (unsigned)__builtin_amdgcn_ds_swizzle((int)v, (O << 10) | 0x1f);
}
template <int O> __device__ __forceinline__ float xshfl(float v) { return __uint_as_float(xshfl_u<O>(__float_as_uint(v))); }
template <int CTRL> __device__ __forceinline__ float dppf(float x) { return __builtin_bit_cast(float, __builtin_amdgcn_mov_dpp(__builtin_bit_cast(int, x), CTRL, 0xf, 0xf, true)); }
__device__ __forceinline__ float wave_sum(float x) {
    x += dppf<0xB1>(x); x += dppf<0x4E>(x); x += dppf<0x141>(x); x += dppf<0x128>(x);
    const auto s = __builtin_amdgcn_permlane16_swap(__float_as_uint(x), __float_as_uint(x), false, false); x = __uint_as_float(s[0]) + __uint_as_float(s[1]);
    const auto t = __builtin_amdgcn_permlane32_swap(__float_as_uint(x), __float_as_uint(x), false, false); return __uint_as_float(t[0]) + __uint_as_float(t[1]);
}
__device__ __forceinline__ float pair32_max(float x) { const auto t = __builtin_amdgcn_permlane32_swap(__float_as_uint(x), __float_as_uint(x), false, false); return fmaxf(__uint_as_float(t[0]), __uint_as_float(t[1])); }
__device__ __forceinline__ float pair32_sum(float x) { const auto t = __builtin_amdgcn_permlane32_swap(__float_as_uint(x), __float_as_uint(x), false, false); return __uint_as_float(t[0]) + __uint_as_float(t[1]); }
__device__ __forceinline__ float sigmoidf_(float x) { return 1.f / (1.f + __expf(-x)); }

namespace pg8 {
constexpr int BM = 256, BK = 64, HALF = 128, HTB = HALF * BK * 2, STAGE_BYTES = 8 * HTB, NXCD = 8, WGM = 8;
__host__ __device__ __forceinline__ int lds_byte(int r, int c) { const int st = (r >> 4) * 2 + (c >> 5), rr = r & 15, cc = c & 31, ob = rr * 64 + cc * 2; return st * 1024 + (ob ^ (((ob >> 9) & 1) << 5)); }
__host__ __device__ __forceinline__ void stage_rc(int b, int& R, int& C) { const int st = b / 1024, sb = b % 1024, swz = sb ^ (((sb >> 9) & 1) << 5); R = (st >> 1) * 16 + swz / 64; C = (st & 1) * 32 + (swz % 64) / 2; }

__host__ __device__ __forceinline__ int perm32(int rho) { const int n = rho >> 4, i = rho & 15; return 8 * (i >> 2) + 4 * n + (i & 3); }
struct Unit { int pm, pn, sg; };

template <int SEG> struct Order {
    int nM, nN, nwg, G, c, md;
    __device__ __forceinline__ void init(int nM_, int nN_, int G_, int c_, int md_ = 0) { nM = nM_; nN = nN_; nwg = nM * nN; G = G_; c = c_; md = md_; }
    __device__ __forceinline__ bool next(int i, Unit& u) const {
        const int it = i / SEG; u.sg = i - it * SEG;
        const long L = (long)it * G + c; if (L >= nwg) return false;
        int wgid = (int)L; { const int q = nwg / NXCD, r = nwg % NXCD, xcd = wgid % NXCD, off = wgid / NXCD; wgid = (xcd < r ? xcd * (q + 1) : r * (q + 1) + (xcd - r) * q) + off; }
        const int nig = WGM * nN, gid = wgid / nig, fm = gid * WGM, gsz = (nM - fm) < WGM ? (nM - fm) : WGM;
        u.pm = fm + ((wgid % nig) % gsz); u.pn = (wgid % nig) / gsz;
        if (md > 0) u.pm = (u.pm / md) * 18 + (u.pm % md);
        return true;
    }
};

template <class Prob, class Epi, class Sched>
__device__ __forceinline__ void gemm_phase(LAS unsigned char* lds, const Prob& P, const Sched& S, const Epi& E, int wid) {
    int lane_ = lane_id(); asm volatile("" : "+v"(lane_));
    const int lane = lane_, tid = wid * 64 + lane, wr = wid >> 2, wc = wid & 3, fr = lane & 15, fq = lane >> 4;
    const int K = P.K, nt = K / BK;
    unsigned voffA[2][2], voffN[2][2], voffB[2]; int stR[2], stC[2];
#pragma unroll
    for (int i = 0; i < 2; ++i) { stage_rc(tid * 16 + i * 8192, stR[i], stC[i]); const int Rb = (stR[i] & ~31) + perm32(stR[i] & 31); voffB[i] = (unsigned)(Rb * P.ldb + stC[i]) * 2u; }
    const size_t kstep = (size_t)(BK * 2);
    const size_t hstepB = (size_t)HALF * P.ldb * 2;
#define PG8_AOFF(dst, u) do { _Pragma("unroll") for (int h_ = 0; h_ < 2; ++h_) _Pragma("unroll") for (int i_ = 0; i_ < 2; ++i_) \
        dst[h_][i_] = (unsigned)(P.arow(u, h_ * HALF + stR[i_]) * P.lda + stC[i_]) * 2u; } while (0)
    const unsigned ldsw = (unsigned)wid * 1024u;
    const int aoff = lds_byte(wr * 64 + fr, fq * 8), boff = lds_byte(wc * 32 + fr, fq * 8);
#define PG8_SA(b, h) (((b) * 2 + (h)) * HTB)
#define PG8_SB(b, h) ((4 + (b) * 2 + (h)) * HTB)
#define PG8_STAGE(bufoff, gbase, voff) do { _Pragma("unroll") for (int _i = 0; _i < 2; ++_i) \
        __builtin_amdgcn_global_load_lds((const unsigned*)((const char*)(gbase) + (voff)[_i]), (LAS unsigned*)(lds + (bufoff) + ldsw + _i * 8192), 16, 0, 0); } while (0)
#define PG8_LDA(dst, b, h) do { _Pragma("unroll") for (int m = 0; m < 4; ++m) _Pragma("unroll") for (int k = 0; k < 2; ++k) dst[m][k] = *(const LAS bf16x8*)(lds + PG8_SA(b, h) + aoff + m * 2048 + k * 1024); } while (0)
#define PG8_LDB(dst, b, h) do { _Pragma("unroll") for (int n = 0; n < 2; ++n) _Pragma("unroll") for (int k = 0; k < 2; ++k) dst[n][k] = *(const LAS bf16x8*)(lds + PG8_SB(b, h) + boff + n * 2048 + k * 1024); } while (0)
#define PG8_MMA(ai, bj, At, Bt) do { __builtin_amdgcn_s_setprio(1); _Pragma("unroll") for (int m = 0; m < 4; ++m) _Pragma("unroll") for (int n = 0; n < 2; ++n) _Pragma("unroll") for (int k = 0; k < 2; ++k) \
        acc[ai][bj][m][n] = __builtin_amdgcn_mfma_f32_16x16x32_bf16(Bt[n][k], At[m][k], acc[ai][bj][m][n], 0, 0, 0); __builtin_amdgcn_s_setprio(0); } while (0)
#define PG8_WAIT_V(n) asm volatile("s_waitcnt vmcnt(" #n ")" ::: "memory")
#define PG8_WAIT_L(n) asm volatile("s_waitcnt lgkmcnt(" #n ")" ::: "memory")
#define PG8_BAR __builtin_amdgcn_s_barrier()
#define PG8_SCHED __builtin_amdgcn_sched_barrier(0)
    Unit cur, nxt; int ui = 0;
    if (!S.next(0, cur)) return;
    f32x4 acc[2][2][4][2];
#pragma unroll
    for (int a = 0; a < 2; ++a)
#pragma unroll
        for (int b = 0; b < 2; ++b)
#pragma unroll
            for (int m = 0; m < 4; ++m)
#pragma unroll
                for (int n = 0; n < 2; ++n) acc[a][b][m][n] = (f32x4){0.f, 0.f, 0.f, 0.f};
    bf16x8 At[4][2], B0[2][2], B1[2][2];
    const char* cA = P.ap(cur); const char* cB = P.bp(cur);
    PG8_AOFF(voffA, cur);
    PG8_STAGE(PG8_SB(0, 0), cB, voffB); PG8_STAGE(PG8_SB(0, 1), cB + hstepB, voffB); PG8_STAGE(PG8_SA(0, 0), cA, voffA[0]); PG8_STAGE(PG8_SA(0, 1), cA, voffA[1]);
    if (wr == 1) PG8_BAR;
    PG8_WAIT_V(2); PG8_BAR;
    PG8_STAGE(PG8_SB(1, 0), cB + kstep, voffB); PG8_STAGE(PG8_SA(1, 0), cA + kstep, voffA[0]); PG8_STAGE(PG8_SB(1, 1), cB + hstepB + kstep, voffB);
    PG8_WAIT_V(6); PG8_BAR;
    for (;;) {
        const bool has_next = S.next(ui + 1, nxt);
        const char* nA = has_next ? P.ap(nxt) : cA; const char* nB = has_next ? P.bp(nxt) : cB;
        if constexpr (Prob::GATHER) { if (has_next) PG8_AOFF(voffN, nxt); else { _Pragma("unroll") for (int h_ = 0; h_ < 2; ++h_) _Pragma("unroll") for (int i_ = 0; i_ < 2; ++i_) voffN[h_][i_] = voffA[h_][i_]; } }
        for (int t = 0; t < nt; t += 2) {
            const bool last = (t == nt - 2);
            const char* a1 = cA + (size_t)(t + 1) * kstep;
            const char* a2 = last ? nA : cA + (size_t)(t + 2) * kstep; const char* b2 = last ? nB : cB + (size_t)(t + 2) * kstep;
            const char* a3 = a2 + kstep; const char* b3 = b2 + kstep;
            unsigned vo2[2][2];
#pragma unroll
            for (int h_ = 0; h_ < 2; ++h_)
#pragma unroll
                for (int i_ = 0; i_ < 2; ++i_) vo2[h_][i_] = (Prob::GATHER && last) ? voffN[h_][i_] : voffA[h_][i_];
            PG8_LDB(B0, 0, 0); PG8_LDB(B1, 0, 1); PG8_SCHED; PG8_LDA(At, 0, 0); PG8_STAGE(PG8_SA(1, 1), a1, voffA[1]);
            PG8_WAIT_V(8); PG8_WAIT_L(0); PG8_BAR; PG8_MMA(0, 0, At, B0); PG8_MMA(0, 1, At, B1); PG8_BAR; PG8_SCHED;
            PG8_LDA(At, 0, 1); PG8_STAGE(PG8_SB(0, 0), b2, voffB); PG8_STAGE(PG8_SB(0, 1), b2 + hstepB, voffB); PG8_STAGE(PG8_SA(0, 0), a2, vo2[0]);
            PG8_WAIT_V(8); PG8_WAIT_L(0); PG8_BAR; PG8_MMA(1, 0, At, B0); PG8_MMA(1, 1, At, B1); PG8_BAR; PG8_SCHED;
            PG8_LDB(B0, 1, 0); PG8_LDB(B1, 1, 1); PG8_SCHED; PG8_LDA(At, 1, 0); PG8_STAGE(PG8_SA(0, 1), a2, vo2[1]);
            PG8_WAIT_V(8); PG8_WAIT_L(0); PG8_BAR; PG8_MMA(0, 0, At, B0); PG8_MMA(0, 1, At, B1); PG8_BAR; PG8_SCHED;
            PG8_LDA(At, 1, 1); PG8_STAGE(PG8_SB(1, 0), b3, voffB); PG8_STAGE(PG8_SB(1, 1), b3 + hstepB, voffB); PG8_STAGE(PG8_SA(1, 0), a3, vo2[0]);
            PG8_WAIT_V(8); PG8_WAIT_L(0); PG8_BAR; PG8_MMA(1, 0, At, B0); PG8_MMA(1, 1, At, B1); PG8_BAR; PG8_SCHED;
        }
        if (wr == 0) PG8_BAR;
        const bool z = E(acc, cur, wr, wc, fr, fq);
        if (!has_next) break;
        if (z) {
#pragma unroll
            for (int a = 0; a < 2; ++a)
#pragma unroll
                for (int b = 0; b < 2; ++b)
#pragma unroll
                    for (int m = 0; m < 4; ++m)
#pragma unroll
                        for (int n = 0; n < 2; ++n) acc[a][b][m][n] = (f32x4){0.f, 0.f, 0.f, 0.f};
        }
        cur = nxt; cA = nA; cB = nB; ++ui;
        if constexpr (Prob::GATHER) { _Pragma("unroll") for (int h_ = 0; h_ < 2; ++h_) _Pragma("unroll") for (int i_ = 0; i_ < 2; ++i_) voffA[h_][i_] = voffN[h_][i_]; }
        if (wr == 1) PG8_BAR;
    }
    PG8_WAIT_V(0);
    PG8_BAR;
#undef PG8_AOFF
#undef PG8_SA
#undef PG8_SB
#undef PG8_STAGE
#undef PG8_LDA
#undef PG8_LDB
#undef PG8_MMA
#undef PG8_WAIT_V
#undef PG8_WAIT_L
#undef PG8_BAR
#undef PG8_SCHED
}

struct ProbPlain { static constexpr bool GATHER = false; const bf16* A; const bf16* B; int K, lda, ldb;
    __device__ __forceinline__ const char* ap(const Unit& u) const { return (const char*)(A + (size_t)u.pm * 256 * lda); }
    __device__ __forceinline__ int arow(const Unit&, int rr) const { return rr; }
    __device__ __forceinline__ const char* bp(const Unit& u) const { return (const char*)(B + (size_t)u.pn * 256 * ldb); } };
struct ProbSeg3 { static constexpr bool GATHER = false; const bf16* A; const bf16* B; int K, lda, ldb; size_t sA, sB;
    __device__ __forceinline__ const char* ap(const Unit& u) const { return (const char*)(A + (size_t)u.sg * sA + (size_t)u.pm * 256 * lda); }
    __device__ __forceinline__ int arow(const Unit&, int rr) const { return rr; }
    __device__ __forceinline__ const char* bp(const Unit& u) const { return (const char*)(B + (size_t)u.sg * sB + (size_t)u.pn * 256 * ldb); } };
struct ProbUp2 { static constexpr bool GATHER = false; const bf16* A0; const bf16* A1; const bf16* B0; const bf16* B1; int K, lda, ldb;
    __device__ __forceinline__ const char* ap(const Unit& u) const { return (const char*)((u.sg ? A1 : A0) + (size_t)u.pm * 256 * lda); }
    __device__ __forceinline__ int arow(const Unit&, int rr) const { return rr; }
    __device__ __forceinline__ const char* bp(const Unit& u) const { return (const char*)((u.sg ? B1 : B0) + (size_t)u.pn * 256 * ldb); } };
struct OrderUp2 { int n0, nwg, G, c, nM0;
    __device__ __forceinline__ void init(int nM0_, int G_, int c_) { nM0 = nM0_; n0 = nM0_ * 3; nwg = n0 + (MT / 256) * 4; G = G_; c = c_; }
    __device__ __forceinline__ bool next(int i, Unit& u) const { const int L = i * G + c; if (L >= nwg) return false;
        if (L < n0) { u.sg = 0; u.pm = L / 3; u.pn = L - u.pm * 3; } else { const int r = L - n0; u.sg = 1; u.pm = r >> 2; u.pn = r & 3; } return true; } };
struct OrderWinLast { int G, c;
    __device__ __forceinline__ void init(int G_, int c_) { G = G_; c = c_; }
    __device__ __forceinline__ bool next(int i, Unit& u) const { const int L = i * G + c; u.sg = 0; if (L >= 128 * 24 + 16 * 5) return false;
        if (L < 128 * 24) { const int g = L / (8 * 24), q = L - g * 8 * 24; u.pm = g * 8 + (q & 7); u.pn = q >> 3; }
        else { const int r = L - 128 * 24, t = r % 5; u.pm = 128 + r / 5; u.pn = t < 4 ? 2 + t : 7; } return true; } };
struct ProbMoE { static constexpr bool GATHER = false; const bf16* A; const bf16* B; int K, lda, ldb; int nrowsB;
    __device__ __forceinline__ const char* ap(const Unit& u) const { return (const char*)(A + (size_t)u.pm * 256 * lda); }
    __device__ __forceinline__ int arow(const Unit&, int rr) const { return rr; }
    __device__ __forceinline__ const char* bp(const Unit& u) const { return (const char*)(B + ((size_t)(u.pm / 18) * nrowsB + (size_t)u.pn * 256) * ldb); } };
struct ProbMoEGather { static constexpr bool GATHER = true; const bf16* A; const bf16* B; const LAS int* lidx; int K, lda, ldb; int nrowsB;
    __device__ __forceinline__ const char* ap(const Unit&) const { return (const char*)A; }
    __device__ __forceinline__ int arow(const Unit& u, int rr) const { return lidx[u.sg * 256 + rr]; }
    __device__ __forceinline__ const char* bp(const Unit& u) const { return (const char*)(B + ((size_t)(u.pm / 18) * nrowsB + (size_t)u.pn * 256) * ldb); } };
struct OrderOrd { Order<1> o;
    __device__ __forceinline__ bool next(int i, Unit& u) const { const bool r = o.next(i, u); u.sg = i; return r; } };

#define EPI_ROWS(...) _Pragma("unroll") for (int ai = 0; ai < 2; ++ai) _Pragma("unroll") for (int m = 0; m < 4; ++m) { const int row = u.pm * 256 + ai * 128 + wr * 64 + m * 16 + fr; __VA_ARGS__ }
#define EPI_COLS8(...) _Pragma("unroll") for (int bj = 0; bj < 2; ++bj) { const int col = u.pn * 256 + bj * 128 + wc * 32 + 8 * fq; __VA_ARGS__ }
#define EPI_LANE() int t_ = lane_id(); asm volatile("" : "+v"(t_)); const int fr = t_ & 15, fq = t_ >> 4
__device__ __forceinline__ v4u pack8(const f32x4& a, const f32x4& b) { v4u w; w.x = pk2(a[0], a[1]); w.y = pk2(a[2], a[3]); w.z = pk2(b[0], b[1]); w.w = pk2(b[2], b[3]); return w; }
__device__ __forceinline__ f32x4 unpack4(v2u w) { return (f32x4){bflo(w.x), bfhi(w.x), bflo(w.y), bfhi(w.y)}; }
struct EpiBf16 { bf16* O; int ldc;
    __device__ __forceinline__ bool operator()(f32x4 (&acc)[2][2][4][2], const Unit& u, int wr, int wc, int fr_, int fq_) const {
        EPI_LANE();
        EPI_ROWS( bf16* rp = O + (size_t)row * ldc; EPI_COLS8( *(v4u*)(rp + col) = pack8(acc[ai][bj][m][0], acc[ai][bj][m][1]); ) )
        return true; } };
__device__ __forceinline__ f32x4 sigmoid4(const f32x4& v) { return (f32x4){__builtin_amdgcn_rcpf(1.f + __expf(-v[0])), __builtin_amdgcn_rcpf(1.f + __expf(-v[1])), __builtin_amdgcn_rcpf(1.f + __expf(-v[2])), __builtin_amdgcn_rcpf(1.f + __expf(-v[3]))}; }
struct EpiUp2 { bf16* O0; bf16* O1;
    __device__ __forceinline__ bool operator()(f32x4 (&acc)[2][2][4][2], const Unit& u, int wr, int wc, int fr_, int fq_) const {
        EPI_LANE();
        bf16* O = u.sg ? O1 : O0; const int ldc = u.sg ? 1024 : 768;
        EPI_ROWS( bf16* rp = O + (size_t)row * ldc; EPI_COLS8( *(v4u*)(rp + col) = pack8(acc[ai][bj][m][0], acc[ai][bj][m][1]); ) )
        return true; } };
struct EpiWin { bf16* O;
    __device__ __forceinline__ bool operator()(f32x4 (&acc)[2][2][4][2], const Unit& u, int wr, int wc, int fr_, int fq_) const {
        EPI_LANE();
        const bool sg = u.pn >= 10;
        EPI_ROWS( bf16* rp = O + (size_t)row * NP; EPI_COLS8( f32x4 v0 = acc[ai][bj][m][0], v1 = acc[ai][bj][m][1];
            if (sg) { v0 = sigmoid4(v0); v1 = sigmoid4(v1); }
            *(v4u*)(rp + col) = pack8(v0, v1); ) )
        return true; } };
__device__ __forceinline__ f32x4 gate_ratio(v2u a, v2u b, bool fin) { const f32x4 x = unpack4(a), y = unpack4(b);
    return (f32x4){x[0] * (fin ? 1.f : __builtin_amdgcn_rcpf(fmaxf(y[0], 1e-20f))), x[1] * (fin ? 1.f : __builtin_amdgcn_rcpf(fmaxf(y[1], 1e-20f))), x[2] * (fin ? 1.f : __builtin_amdgcn_rcpf(fmaxf(y[2], 1e-20f))), x[3] * (fin ? 1.f : __builtin_amdgcn_rcpf(fmaxf(y[3], 1e-20f)))}; }
struct EpiMerge { const bf16* PROJ; bf16* O;
    __device__ __forceinline__ bool operator()(f32x4 (&acc)[2][2][4][2], const Unit& u, int wr, int wc, int fr_, int fq_) const {
        EPI_LANE();
        const int sg = u.sg; const bool fin = sg == 2; const int sgb = fin ? 2 : sg + 1;
        _Pragma("unroll") for (int ai = 0; ai < 2; ++ai) {
            _Pragma("unroll") for (int m = 0; m < 4; ++m) { const int row = u.pm * 256 + ai * 128 + wr * 64 + m * 16 + fr;
                const bf16* gp = PROJ + (size_t)row * NP + C_GT; bf16* rp = O + (size_t)row * DM;
                EPI_COLS8( const v4u ga = *(const v4u*)(gp + sg * 1024 + col), gb = *(const v4u*)(gp + sgb * 1024 + col);
                    const f32x4 v0 = acc[ai][bj][m][0] * gate_ratio((v2u){ga.x, ga.y}, (v2u){gb.x, gb.y}, fin), v1 = acc[ai][bj][m][1] * gate_ratio((v2u){ga.z, ga.w}, (v2u){gb.z, gb.w}, fin);
                    acc[ai][bj][m][0] = v0; acc[ai][bj][m][1] = v1;
                    if (fin) *(v4u*)(rp + col) = pack8(v0, v1); ) }
            asm volatile("" ::: "memory"); }
        return fin; } };
struct EpiSwiGLU { bf16* HID;
    __device__ __forceinline__ bool operator()(f32x4 (&acc)[2][2][4][2], const Unit& u, int wr, int wc, int fr_, int fq_) const {
        EPI_LANE();
        EPI_ROWS( bf16* rp = HID + (size_t)row * 1024 + u.pn * 128 + wc * 32 + 8 * fq; f32x4 h[2];
            _Pragma("unroll") for (int n = 0; n < 2; ++n) { const f32x4 g = acc[ai][0][m][n], up = acc[ai][1][m][n];
                h[n] = (f32x4){g[0] * __builtin_amdgcn_rcpf(1.f + __expf(-g[0])) * up[0], g[1] * __builtin_amdgcn_rcpf(1.f + __expf(-g[1])) * up[1], g[2] * __builtin_amdgcn_rcpf(1.f + __expf(-g[2])) * up[2], g[3] * __builtin_amdgcn_rcpf(1.f + __expf(-g[3])) * up[3]}; }
            *(v4u*)rp = pack8(h[0], h[1]); )
        return true; } };
}

#define XB_TMO      128
#define XB_XCNT(j)  (256  + 64 * (j))
#define XB_XSUB(j)  (1280 + 64 * (j))
#define XB_XGEN(j)  (2304 + 64 * (j))
#define XB_TOP      3328
#define XB_TOPGEN   3392
#define XCD_BAR_WORDS 3456
#define XB_SPIN_CAP (1u << 22)
__device__ __forceinline__ unsigned xb_ld(unsigned* p)              { return __hip_atomic_load(p, __ATOMIC_RELAXED, __HIP_MEMORY_SCOPE_AGENT); }
__device__ __forceinline__ unsigned xb_add(unsigned* p, unsigned v) { return __hip_atomic_fetch_add(p, v, __ATOMIC_RELAXED, __HIP_MEMORY_SCOPE_AGENT); }
__device__ __forceinline__ unsigned xb_xcc_id() { return (unsigned)__builtin_amdgcn_s_getreg((3 << 11) | 20) & 0xFu; }
#define XB_SPIN(cond, bar) do { unsigned _sp = 0; while (cond) { __builtin_amdgcn_s_sleep(1); \
    if ((++_sp & 255u) == 0u) { if (xb_ld(&(bar)[XB_TMO])) break; if (_sp > XB_SPIN_CAP) { atomicAdd(&(bar)[XB_TMO], 1u); break; } } } } while (0)
struct XcdBarrier { unsigned* bar; unsigned x; volatile LAS unsigned* st; int wv; };
__device__ __forceinline__ XcdBarrier xcd_barrier_post(unsigned* bar, volatile LAS unsigned* st, int wv) {
    XcdBarrier b; b.bar = bar; b.x = xb_xcc_id(); b.st = st; b.wv = wv;
    if (wv == 0 && lane_id() == 0) (void)xb_add(&bar[XB_XCNT(b.x)], 1u);
    return b;
}
__device__ __forceinline__ void xcd_barrier_complete(unsigned* bar, unsigned x, unsigned& nloc, unsigned& nx) {
    const unsigned G = gridDim.x * gridDim.y * gridDim.z;
    unsigned sum, cnt, mine, sp = 0u;
    for (;;) {
        sum = 0u; cnt = 0u; mine = 0u;
#pragma unroll
        for (unsigned j = 0; j < 16; ++j) { const unsigned c = xb_ld(&bar[XB_XCNT(j)]); sum += c; cnt += (c > 0u) ? 1u : 0u; mine = (j == x) ? c : mine; }
        if (sum == G) break;
        __builtin_amdgcn_s_sleep(1);
        if ((++sp & 255u) == 0u) { if (xb_ld(&bar[XB_TMO])) break; if (sp > XB_SPIN_CAP) { atomicAdd(&bar[XB_TMO], 1u); break; } }
    }
    nloc = mine > 0u ? mine : 1u; nx = cnt > 0u ? cnt : 1u;
}
__device__ __forceinline__ void xcd_barrier(const XcdBarrier& b) {
    asm volatile("s_waitcnt vmcnt(0)" ::: "memory");
    __syncthreads();
    if (b.wv == 0 && lane_id() == 0) {
        unsigned* bar = b.bar; unsigned bx_ = b.x; asm volatile("" : "+s"(bx_)); asm volatile("" : "+s"(bar));
        __builtin_amdgcn_s_waitcnt(0);
        unsigned nloc = b.st[0], nx = b.st[1];
        if (nloc == 0u) { xcd_barrier_complete(bar, bx_, nloc, nx); b.st[0] = nloc; b.st[1] = nx; }
        const unsigned old = xb_add(&bar[XB_XSUB(bx_)], 1u);
        const unsigned gen = old / nloc;
        if (old + 1u == (gen + 1u) * nloc) {
            __builtin_amdgcn_fence(__ATOMIC_RELEASE, "agent");
            asm volatile("s_waitcnt vmcnt(0)" ::: "memory");
            const unsigned og = xb_add(&bar[XB_TOP], 1u);
            const unsigned tg = og / nx;
            if (og + 1u == (tg + 1u) * nx) xb_add(&bar[XB_TOPGEN], 1u);
            else XB_SPIN(xb_ld(&bar[XB_TOPGEN]) == tg, bar);
            __builtin_amdgcn_fence(__ATOMIC_ACQUIRE, "agent");
            xb_add(&bar[XB_XGEN(bx_)], 1u);
            asm volatile("s_waitcnt vmcnt(0)" ::: "memory");
        } else {
            XB_SPIN(xb_ld(&bar[XB_XGEN(bx_)]) == gen, bar);
            __builtin_amdgcn_fence(__ATOMIC_ACQUIRE, "agent");
            asm volatile("s_waitcnt vmcnt(0)" ::: "memory");
        }
    }
    __syncthreads();
}

struct Args { const float* in[28]; float* out; unsigned char* ws; };
enum { I_X = 0, I_C, I_CTX, I_CCTX, I_WADA, I_BADA, I_WIN, I_GQ, I_WUQ, I_GKV, I_WUKV, I_RPB, I_WDW, I_BDW, I_GCN, I_BCN, I_WPW2, I_WOA, I_WOB, I_WOUT, I_LN1G, I_LN1B, I_WROUTER, I_WGATE, I_WUP, I_WDOWN, I_LN2G, I_LN2B };

#define OPAQUE(v) asm volatile("" : "+v"(v))
struct Ctx {
    LAS unsigned char* lds;
    int tid, lane, wave, G, bid;
    const float* const* in;
    unsigned char* ws;
    float* out;
};
#define INP(i) ((const float*)(const GAS float*)C.in[i])
#define WSP(T, off) ((T*)(C.ws + (off)))
#define WSW(T, off, l) ((T*)(C.ws + (off) + (size_t)((l) & 1) * WS_WSET))

struct CwD { const float* src; bf16* db; int N, ld, kind, add, n0; };
__device__ __forceinline__ void cw_decode(const Ctx& C, int l, int it, CwD& d) {
    constexpr int I_IN = 16 * 189, I_UQ = 4 * 24, I_UKV = 2 * 32, I_PW = 8 * 32, I_OUT = 16 * 32, I_EX = 16 * 32;
    int r = it; d.kind = 0; d.add = 0;
    if (r < I_IN) { const int kb = r / 189, nb = r % 189; d.src = INP(I_WIN) + (size_t)l * 1024 * 6048 + (size_t)(kb * 64) * 6048 + nb * 32; d.N = 6048; d.db = WSW(bf16, WS_WIN, l) + kb * 64; d.ld = 1024; d.kind = 1; d.n0 = nb * 32; return; } r -= I_IN;
    if (r < I_UQ) { const int kb = r / 24, nb = r % 24; d.src = INP(I_WUQ) + (size_t)l * 256 * 768 + (size_t)(kb * 64) * 768 + nb * 32; d.N = 768; d.db = WSW(bf16, WS_WUQ, l) + kb * 64; d.ld = 256; d.n0 = nb * 32; return; } r -= I_UQ;
    if (r < I_UKV) { const int kb = r / 32, nb = r % 32; d.src = INP(I_WUKV) + (size_t)l * 128 * 1024 + (size_t)(kb * 64) * 1024 + nb * 32; d.N = 1024; d.db = WSW(bf16, WS_WUKV, l) + kb * 64; d.ld = 256; d.n0 = nb * 32; return; } r -= I_UKV;
    if (r < 3 * I_PW) { const int w = r / I_PW, q = r % I_PW, kb = q / 32, nb = q % 32;
        d.src = (w == 0 ? INP(I_WPW2) : (w == 1 ? INP(I_WOA) : INP(I_WOB))) + (size_t)l * 512 * 1024 + (size_t)(kb * 64) * 1024 + nb * 32; d.N = 1024;
        d.db = WSW(bf16, w == 0 ? WS_WPW2 : (w == 1 ? WS_WOA : WS_WOB), l) + kb * 64; d.ld = 512; d.n0 = nb * 32; return; } r -= 3 * I_PW;
    if (r < I_OUT) { const int kb = r / 32, nb = r % 32; d.src = INP(I_WOUT) + (size_t)l * 1024 * 1024 + (size_t)(kb * 64) * 1024 + nb * 32; d.N = 1024; d.db = WSW(bf16, WS_WOUT, l) + kb * 64; d.ld = 1024; d.n0 = nb * 32; return; } r -= I_OUT;
    { const int mat = r / I_EX, q = r % I_EX, kb = q / 32, nb = q % 32, w = mat / 16, e = mat % 16;
      d.src = (w == 0 ? INP(I_WGATE) : (w == 1 ? INP(I_WUP) : INP(I_WDOWN))) + ((size_t)l * 16 + e) * 1024 * 1024 + (size_t)(kb * 64) * 1024 + nb * 32; d.N = 1024; d.ld = 1024; d.n0 = nb * 32;
      if (w < 2) { d.db = WSW(bf16, WS_WGU, l) + (size_t)e * 2048 * 1024 + kb * 64; d.kind = 2; d.add = w * 128; }
      else d.db = WSW(bf16, WS_WD, l) + (size_t)e * 1024 * 1024 + kb * 64; }
}
__device__ __forceinline__ void cw_load(const CwD& d, int lane, f32x4 (&v)[8]) {
#pragma unroll
    for (int i = 0; i < 8; ++i) { const int kk = 8 * i + (lane >> 3), nn = (lane & 7) * 4; v[i] = __builtin_nontemporal_load((const f32x4*)(d.src + (size_t)kk * d.N + nn)); }
}
__device__ __forceinline__ void cw_store(const CwD& d, const f32x4 (&v)[8], LAS float* scr, int lane) {
#pragma unroll
    for (int i = 0; i < 8; ++i) { const int kk = 8 * i + (lane >> 3), nn = (lane & 7) * 4;
        scr[kk * 33 + nn] = v[i][0]; scr[kk * 33 + nn + 1] = v[i][1]; scr[kk * 33 + nn + 2] = v[i][2]; scr[kk * 33 + nn + 3] = v[i][3]; }
    LDS_WAIT(); asm volatile("" ::: "memory");
    const int c = lane & 7;
#pragma unroll
    for (int j = 0; j < 4; ++j) { const int nl = (lane >> 3) + 8 * j; const LAS float* s = scr + (8 * c) * 33 + nl;
        v4u o; o.x = pk2(s[0 * 33], s[1 * 33]); o.y = pk2(s[2 * 33], s[3 * 33]); o.z = pk2(s[4 * 33], s[5 * 33]); o.w = pk2(s[6 * 33], s[7 * 33]);
        const int n = d.n0 + nl; int row = n; if (d.kind == 1) row = n < 1952 ? n : n + 96; if (d.kind == 2) row = (n >> 7) * 256 + (n & 127) + d.add;
        __builtin_nontemporal_store(o, (v4u*)(d.db + (size_t)row * d.ld + 8 * c)); }
    LDS_WAIT(); asm volatile("" ::: "memory");
}

__device__ __forceinline__ void conv_weights(const Ctx& Cc, int l, int f0, int f1, int wg0, int nwg) {
    Ctx C = Cc; C.lane = lane_id(); C.tid = C.wave * 64 + C.lane;
    LAS float* scr = (LAS float*)(C.lds + C.wave * 16384);
    if (C.bid < wg0) return;
    const int gw = (C.bid - wg0) * NWAVES + C.wave, NGW = nwg * NWAVES;
    constexpr int NITEMS = 16 * 189 + 4 * 24 + 2 * 32 + 3 * 8 * 32 + 16 * 32 + 48 * 16 * 32;
    bf16* WinT = WSW(bf16, WS_WIN, l);
    const int it0 = (int)((long)NITEMS * f0 / 100), it1 = (int)((long)NITEMS * f1 / 100);
    {
        CwD cur, nxt; f32x4 buf[8]; int it = it0 + gw;
        if (it < it1) { cw_decode(C, l, it, cur); cw_load(cur, C.lane, buf); }
        for (; it < it1; it += NGW) {
            f32x4 v[8];
#pragma unroll
            for (int i = 0; i < 8; ++i) v[i] = buf[i];
            const bool more = it + NGW < it1;
            if (more) { cw_decode(C, l, it + NGW, nxt); cw_load(nxt, C.lane, buf); }
            cw_store(cur, v, scr, C.lane);
            if (more) cur = nxt;
        }
    }
    if (f0 != 0) return;
    const int gt = (C.bid - wg0) * NTHREADS + C.tid, NGT = nwg * NTHREADS;
    unsigned zz_ = 0u; asm volatile("" : "+v"(zz_)); const v4u z = (v4u){zz_, zz_, zz_, zz_};
    for (int i = gt; i < 96 * 128; i += NGT) *((v4u*)(WinT + (size_t)1952 * 1024) + i) = z;
    for (int i = gt; i < 1024 * 16; i += NGT) { const int n = i >> 4, c = i & 15; *((v4u*)(WSW(bf16, WS_WUKV, l) + (size_t)n * 256 + 128) + c) = z; }
}

__device__ __forceinline__ void phase_mods(const Ctx& Cc) {
    Ctx C = Cc; OPAQUE(C.lane); OPAQUE(C.tid);
    LAS float* sc = (LAS float*)C.lds;
    LAS float* red = (LAS float*)(C.lds + 69632);
    for (int idx = C.tid; idx < 17 * 1024; idx += NTHREADS) { const int r = idx >> 10, k = idx & 1023; const float v = r < 16 ? INP(I_C)[r * 1024 + k] : INP(I_CCTX)[k]; sc[idx] = v / (1.f + __expf(-v)); }
    __syncthreads();
    float* MODS = WSP(float, WS_MODS);
    for (int item = C.bid; item < NL * 96; item += C.G) {
        const int l = item / 96, cb = item % 96, col = cb * 64 + C.lane;
        const float* W = INP(I_WADA) + (size_t)l * 1024 * 6144;
        float acc[17];
#pragma unroll
        for (int r = 0; r < 17; ++r) acc[r] = 0.f;
        for (int k = C.wave * 128; k < C.wave * 128 + 128; k += 4) { const float w0 = W[(size_t)k * 6144 + col], w1 = W[(size_t)(k + 1) * 6144 + col], w2 = W[(size_t)(k + 2) * 6144 + col], w3 = W[(size_t)(k + 3) * 6144 + col];
#pragma unroll
            for (int r = 0; r < 17; ++r) { const f32x4 sv = *(const LAS f32x4*)(sc + r * 1024 + k); acc[r] += (sv[0] * w0 + sv[1] * w1) + (sv[2] * w2 + sv[3] * w3); } }
#pragma unroll
        for (int r = 0; r < 17; ++r) red[(C.wave * 17 + r) * 64 + C.lane] = acc[r];
        __syncthreads();
        for (int o = C.tid; o < 17 * 64; o += NTHREADS) { const int r = o >> 6, cl = o & 63; float s = INP(I_BADA)[l * 6144 + cb * 64 + cl];
#pragma unroll
            for (int w = 0; w < 8; ++w) s += red[(w * 17 + r) * 64 + cl];
            MODS[((size_t)l * 17 + r) * 6144 + cb * 64 + cl] = s; }
        __syncthreads();
    }
    float* TAB = WSP(float, WS_TAB);
    const int gt = C.bid * NTHREADS + C.tid, NGT = C.G * NTHREADS;
    for (int idx = gt; idx < 2048 * 16; idx += NGT) { const int t = idx >> 4, j = idx & 15, which = j >> 3, i = j & 7;
        const float pos = (float)(which ? (t & 63) : (t >> 6)), invf = exp2f(-(float)i * (13.287712379549449f / 8.f)), ang = pos * invf;
        TAB[t * 32 + which * 16 + i] = __cosf(ang); TAB[t * 32 + which * 16 + 8 + i] = __sinf(ang); }
}

__device__ __forceinline__ void phase_mod0(const Ctx& Cc) {
    Ctx C = Cc; OPAQUE(C.lane);
    const int gw = C.bid * NWAVES + C.wave, NGW = C.G * NWAVES;
    const float* MODS = WSP(float, WS_MODS); float* X = WSP(float, WS_X); bf16* H = WSP(bf16, WS_HB);
    for (int row = gw; row < MT; row += NGW) {
        const float* src = row < ML ? INP(I_X) + (size_t)row * DM : INP(I_CTX) + (size_t)(row - ML) * DM;
        const int mr = row < ML ? (row >> 11) : 16; const float* md = MODS + (size_t)mr * 6144;
#pragma unroll
        for (int j = 0; j < 2; ++j) { const int c0 = 8 * (C.lane + 64 * j); f32x4 h[2];
#pragma unroll
            for (int q = 0; q < 2; ++q) { const int c = c0 + 4 * q; const f32x4 xv = *(const f32x4*)(src + c), sh = *(const f32x4*)(md + c), scl = *(const f32x4*)(md + 1024 + c);
                h[q] = xv * (scl + 1.f) + sh; }
            *(v4u*)(H + (size_t)row * DM + c0) = pg8::pack8(h[0], h[1]); }
    }
}

__device__ __forceinline__ void phase_prep(const Ctx& C, int l) {
    int lane = C.lane; OPAQUE(lane); const int gw = C.bid * NWAVES + C.wave, NGW = C.G * NWAVES;
    const bf16* PROJ = WSP(bf16, WS_R); bf16* CQN = WSP(bf16, WS_CQN); bf16* CKVN = WSP(bf16, WS_CKVN); bf16* KR = WSP(bf16, WS_KR);
    const float* TAB = WSP(float, WS_TAB);
    const f32x4 gq = *(const f32x4*)(INP(I_GQ) + l * 256 + 4 * lane); const f32x2 gkv = *(const f32x2*)(INP(I_GKV) + l * 128 + 2 * lane);
    for (int row = gw; row < MT; row += NGW) {
        const bf16* p = PROJ + (size_t)row * NP;
        { const v2u w = *(const v2u*)(p + C_CQ + 4 * lane); const float x0 = bflo(w.x), x1 = bfhi(w.x), x2 = bflo(w.y), x3 = bfhi(w.y);
          const float ss = wave_sum(x0 * x0 + x1 * x1 + x2 * x2 + x3 * x3), r = 1.f / sqrtf(ss * (1.f / 256.f) + RMS_EPS);
          v2u o; o.x = pk2(x0 * r * gq[0], x1 * r * gq[1]); o.y = pk2(x2 * r * gq[2], x3 * r * gq[3]); *(v2u*)(CQN + (size_t)row * 256 + 4 * lane) = o; }
        { const unsigned w = *(const unsigned*)(p + C_CKV + 2 * lane); const float x0 = bflo(w), x1 = bfhi(w);
          const float ss = wave_sum(x0 * x0 + x1 * x1), r = 1.f / sqrtf(ss * (1.f / 128.f) + RMS_EPS);
          *(unsigned*)(CKVN + (size_t)row * 256 + 2 * lane) = pk2(x0 * r * gkv[0], x1 * r * gkv[1]); *(unsigned*)(CKVN + (size_t)row * 256 + 128 + 2 * lane) = 0u; }
        if (lane < 16) { const int gi = lane >> 3, i = lane & 7; const float x1 = bf2f(p[C_KR + gi * 16 + i]), x2 = bf2f(p[C_KR + gi * 16 + 8 + i]); float o1 = x1, o2 = x2;
          if (row < ML) { const int t = row & 2047; const float cs = TAB[t * 32 + gi * 16 + i], sn = TAB[t * 32 + gi * 16 + 8 + i]; o1 = x1 * cs - x2 * sn; o2 = x2 * cs + x1 * sn; }
          KR[(size_t)row * 32 + gi * 16 + i] = (bf16)f2bf(o1); KR[(size_t)row * 32 + gi * 16 + 8 + i] = (bf16)f2bf(o2); }
    }
}

__device__ __forceinline__ void phase_conv(const Ctx& C, int l) {
    int tid = C.tid; OPAQUE(tid); const int lane = tid & 63, w = C.wave;
    LAS float* Wt = (LAS float*)C.lds;
    LAS unsigned char* Xt = C.lds + 63488;
    const bf16* PROJ = WSP(bf16, WS_R); bf16* U = WSP(bf16, WS_U);
    { const float* wdw = INP(I_WDW) + (size_t)l * 31 * 512;
      for (int i = tid; i < 31 * 128; i += NTHREADS) { const int j = i >> 7, c4 = i & 127, ln = c4 >> 1, hf = c4 & 1; *(LAS f32x4*)(Wt + ((j * 2 + hf) * 64 + ln) * 4) = *(const f32x4*)(wdw + j * 512 + 4 * c4); } }
    const f32x4 bd0 = *(const f32x4*)(INP(I_BDW) + l * 512 + 8 * lane), bd1 = *(const f32x4*)(INP(I_BDW) + l * 512 + 8 * lane + 4);
    const f32x4 gc0 = *(const f32x4*)(INP(I_GCN) + l * 512 + 8 * lane), gc1 = *(const f32x4*)(INP(I_GCN) + l * 512 + 8 * lane + 4);
    const f32x4 bc0 = *(const f32x4*)(INP(I_BCN) + l * 512 + 8 * lane), bc1 = *(const f32x4*)(INP(I_BCN) + l * 512 + 8 * lane + 4);
    const int ntile = (l == NL - 1 ? ML : MT) / 32;
    for (int tile = C.bid; tile < ntile; tile += C.G) {
        const int r0 = tile * 32, t0 = r0 < ML ? (r0 & 2047) : ((r0 - ML) & 255), L = r0 < ML ? 2048 : 256;
#pragma unroll
        for (int it = 0; it < 8; ++it) { const int idx = tid + 512 * it, rr = idx >> 6, ch = idx & 63, tt = t0 - 15 + rr;
            if (rr < 62) { v4u o = (v4u){0u, 0u, 0u, 0u};
                if (tt >= 0 && tt < L) { const bf16* p = PROJ + (size_t)(r0 - 15 + rr) * NP + C_CIN + 8 * ch; const v4u a = *(const v4u*)p, g = *(const v4u*)(p + 512);
                    o.x = pk2(bflo(a.x) * bflo(g.x), bfhi(a.x) * bfhi(g.x)); o.y = pk2(bflo(a.y) * bflo(g.y), bfhi(a.y) * bfhi(g.y));
                    o.z = pk2(bflo(a.z) * bflo(g.z), bfhi(a.z) * bfhi(g.z)); o.w = pk2(bflo(a.w) * bflo(g.w), bfhi(a.w) * bfhi(g.w)); }
                *(LAS v4u*)(Xt + rr * 1024 + ch * 16) = o; } }
        __syncthreads();
        f32x4 a0[4], a1[4];
#pragma unroll
        for (int tk = 0; tk < 4; ++tk) { a0[tk] = bd0; a1[tk] = bd1; }
        f32x4 wq0[4], wq1[4];
#pragma unroll
        for (int d = 0; d < 4; ++d) { wq0[d] = (f32x4){0.f, 0.f, 0.f, 0.f}; wq1[d] = (f32x4){0.f, 0.f, 0.f, 0.f}; }
#pragma unroll
        for (int rr = 0; rr < 34; ++rr) {
            if (rr <= 30) { wq0[0] = *(const LAS f32x4*)(Wt + ((rr * 2 + 0) * 64 + lane) * 4); wq1[0] = *(const LAS f32x4*)(Wt + ((rr * 2 + 1) * 64 + lane) * 4); }
            else { wq0[0] = (f32x4){0.f, 0.f, 0.f, 0.f}; wq1[0] = (f32x4){0.f, 0.f, 0.f, 0.f}; }
            const v4u g = *(const LAS v4u*)(Xt + (4 * w + rr) * 1024 + lane * 16);
            const f32x4 x0 = (f32x4){bflo(g.x), bfhi(g.x), bflo(g.y), bfhi(g.y)}, x1 = (f32x4){bflo(g.z), bfhi(g.z), bflo(g.w), bfhi(g.w)};
#pragma unroll
            for (int tk = 0; tk < 4; ++tk) { const int j = rr - tk; if (j >= 0 && j <= 30) { a0[tk] = a0[tk] + x0 * wq0[tk]; a1[tk] = a1[tk] + x1 * wq1[tk]; } }
            wq0[3] = wq0[2]; wq0[2] = wq0[1]; wq0[1] = wq0[0]; wq1[3] = wq1[2]; wq1[2] = wq1[1]; wq1[1] = wq1[0];
        }
#pragma unroll
        for (int tk = 0; tk < 4; ++tk) { f32x4 x0 = a0[tk], x1 = a1[tk];
            const float mean = wave_sum((x0[0] + x0[1]) + (x0[2] + x0[3]) + (x1[0] + x1[1]) + (x1[2] + x1[3])) * (1.f / 512.f);
            x0 = x0 - mean; x1 = x1 - mean;
            const float var = wave_sum((x0[0] * x0[0] + x0[1] * x0[1]) + (x0[2] * x0[2] + x0[3] * x0[3]) + (x1[0] * x1[0] + x1[1] * x1[1]) + (x1[2] * x1[2] + x1[3] * x1[3])) * (1.f / 512.f);
            const float rstd = 1.f / sqrtf(var + LN_EPS);
            f32x4 y0 = x0 * rstd * gc0 + bc0, y1 = x1 * rstd * gc1 + bc1;
#pragma unroll
            for (int q = 0; q < 4; ++q) { y0[q] = y0[q] / (1.f + __expf(-y0[q])); y1[q] = y1[q] / (1.f + __expf(-y1[q])); }
            v4u o; o.x = pk2(y0[0], y0[1]); o.y = pk2(y0[2], y0[3]); o.z = pk2(y1[0], y1[1]); o.w = pk2(y1[2], y1[3]);
            *(v4u*)(U + (size_t)(r0 + 4 * w + tk) * 512 + 8 * lane) = o; }
        __syncthreads();
    }
}

typedef float f32x16 __attribute__((ext_vector_type(16)));
typedef short v4i16 __attribute__((ext_vector_type(4)));
#define MFMA32(a, b, c) __builtin_amdgcn_mfma_f32_32x32x16_bf16(a, b, c, 0, 0, 0)
constexpr int AT_KBUF = 13312, AT_VBUF = 8192;
constexpr int AT_K0 = 0, AT_V0 = 3 * AT_KBUF, AT_RPB = AT_V0 + 3 * AT_VBUF, AT_QR = AT_RPB + 15 * 128 * 4, AT_END = AT_QR + 8 * 4096;
static_assert(AT_END <= RING_BYTES, "attention LDS map");
template <int MODE> __device__ __forceinline__ void attn_unit(const Ctx& C, int l, int unit) {
    constexpr bool MLA = MODE < 2; constexpr int DQK = MLA ? 96 : 64, KC = DQK / 8, KS = DQK / 16, RS = DQK * 2 + 16, NCH = 64 * KC + 512;
    constexpr int QT = (MODE == 0 || MODE == 2) ? 2 : 1;
    const int w = C.wave, lane = lane_id(), tid = w * 64 + lane, r = lane & 31, hh = lane >> 5;
    const bf16* PROJ = WSP(bf16, WS_R); const bf16* QB = WSP(bf16, WS_QB); const bf16* KVB = WSP(bf16, WS_KVB); const bf16* KR = WSP(bf16, WS_KR); const float* TAB = WSP(float, WS_TAB);
    bf16* Yo = WSP(bf16, MLA ? WS_YB : WS_YA);
    LAS unsigned char* lds = C.lds;
    int b, hd, q0, T, NB = 0, rs_min = 0, gi = 0;
    if (MODE == 0) { hd = unit & 7; const int qb = (unit >> 3) & 3; b = unit >> 5; q0 = b * 2048 + qb * 512; T = 36; }
    else if (MODE == 2) { hd = unit & 7; const int ib = (unit >> 3) & 3; b = unit >> 5; q0 = b * 2048 + ib * 512; gi = ib * 8 + w;
        rs_min = min(max(ib * 8 - 4, 0), 24); const int rs_max = min(max(ib * 8 + 3, 0), 24); NB = rs_max - rs_min + 8; T = NB + 4; }
    else { hd = unit & 7; b = unit >> 3; q0 = ML + b * 256; T = 4; }
    const int qrow0 = q0 + 32 * QT * w + r;
    constexpr int NKQ = (64 * (KC + 1)) / 64, NQ = NKQ + 8;
    auto tile_row0 = [&](int t) -> int {
        if (MODE == 0) return t < 4 ? ML + b * 256 + 64 * t : b * 2048 + 64 * (t - 4);
        if (MODE == 2) return t < NB ? b * 2048 + (rs_min + t) * 64 : ML + b * 256 + 64 * (t - NB);
        return ML + b * 256 + 64 * t; };
    int goff[3]; bool gkr[3]; int dblk[3]; bool dk[3];
#pragma unroll
    for (int j = 0; j < 3; ++j) { int q_ = w + 8 * j; if (q_ >= NQ) q_ -= 8; gkr[j] = false; dk[j] = q_ < NKQ; dblk[j] = (q_ < NKQ ? q_ : q_ - NKQ) * 1024;
        if (q_ < NKQ) { const int p_ = 64 * q_ + lane, key_ = p_ / (KC + 1), kc0_ = p_ - key_ * (KC + 1), kc_ = kc0_ == KC ? 0 : kc0_;
            if (MLA) { if (kc_ < 8) goff[j] = key_ * 1024 + hd * 128 + 8 * kc_; else { goff[j] = key_ * 32 + 8 * (kc_ - 8); gkr[j] = true; } } else goff[j] = key_ * NP + C_KA + hd * 64 + 8 * kc_; }
        else { const int p_ = 64 * (q_ - NKQ) + lane, dh_ = p_ >> 8, key_ = (p_ >> 2) & 63, vc_ = dh_ * 4 + (p_ & 3);
            goff[j] = MLA ? key_ * 1024 + hd * 128 + 64 + 8 * vc_ : key_ * NP + C_VA + hd * 64 + 8 * vc_; } }
#define AT_ISSUE(t, slot) do { const int row0_ = tile_row0(t); const bf16* bm_ = MLA ? KVB + (size_t)row0_ * 1024 : PROJ + (size_t)row0_ * NP; const bf16* br_ = KR + (size_t)row0_ * 32; \
        _Pragma("unroll") for (int j = 0; j < 3; ++j) { const bf16* g_ = ((MLA && gkr[j]) ? br_ : bm_) + goff[j]; \
            LAS unsigned char* d_ = lds + (dk[j] ? AT_K0 + (slot) * AT_KBUF : AT_V0 + (slot) * AT_VBUF) + dblk[j]; \
            __builtin_amdgcn_global_load_lds((const unsigned*)g_, (LAS unsigned*)d_, 16, 0, 0); } } while (0)
    constexpr int KSR = (MODE == 0) ? 4 : KS;
    bf16x8 qf[QT][KSR];
    LAS unsigned char* qrl = lds + AT_QR + w * 4096 + lane * 16;
#pragma unroll
    for (int qt = 0; qt < QT; ++qt) { const int qrow = qrow0 + 32 * qt;
        const bf16* qp = MLA ? QB + (size_t)qrow * 768 + hd * 96 : PROJ + (size_t)qrow * NP + C_QA + hd * 64;
#pragma unroll
        for (int ks = 0; ks < KSR; ++ks) qf[qt][ks] = *(const bf16x8*)(qp + 16 * ks + 8 * hh);
        if (MODE == 0) {
            const float* tb = TAB + (size_t)(qrow & 2047) * 32;
#pragma unroll
            for (int g = 0; g < 2; ++g) { const v4u own = *(const v4u*)(qp + 16 * (4 + g) + 8 * hh); v4u oth; oth.x = xshfl_u<32>(own.x); oth.y = xshfl_u<32>(own.y); oth.z = xshfl_u<32>(own.z); oth.w = xshfl_u<32>(own.w);
                const f32x4 c0 = *(const f32x4*)(tb + g * 16), c1 = *(const f32x4*)(tb + g * 16 + 4), s0 = *(const f32x4*)(tb + g * 16 + 8), s1 = *(const f32x4*)(tb + g * 16 + 12);
                const float sg = hh ? 1.f : -1.f; v4u nw;
                nw.x = pk2(bflo(own.x) * c0[0] + sg * bflo(oth.x) * s0[0], bfhi(own.x) * c0[1] + sg * bfhi(oth.x) * s0[1]); nw.y = pk2(bflo(own.y) * c0[2] + sg * bflo(oth.y) * s0[2], bfhi(own.y) * c0[3] + sg * bfhi(oth.y) * s0[3]);
                nw.z = pk2(bflo(own.z) * c1[0] + sg * bflo(oth.z) * s1[0], bfhi(own.z) * c1[1] + sg * bfhi(oth.z) * s1[1]); nw.w = pk2(bflo(own.w) * c1[2] + sg * bflo(oth.w) * s1[2], bfhi(own.w) * c1[3] + sg * bfhi(oth.w) * s1[3]);
                *(LAS v4u*)(qrl + (qt * 2 + g) * 1024) = nw; }
        } }
    if (MODE == 2) {
        LAS float* rt = (LAS float*)(lds + AT_RPB); const float* rpb = INP(I_RPB) + ((size_t)l * 8 + hd) * 15 * 31;
        for (int i = tid; i < 15 * 128; i += NTHREADS) { const int dr = i >> 7, dc = (i & 127) - 64; rt[i] = (dc >= -15 && dc <= 15) ? rpb[dr * 31 + dc + 15] * 1.4426950408889634f : 0.f; }
        asm volatile("s_waitcnt vmcnt(0) lgkmcnt(0)" ::: "memory");
    }
    constexpr float C2 = (MLA ? 0.10206207261596577f : 0.125f) * 1.4426950408889634f;
    f32x16 o[QT][2]; float m_[QT], l_[QT];
#pragma unroll
    for (int qt = 0; qt < QT; ++qt) { m_[qt] = -1e30f; l_[qt] = 0.f;
#pragma unroll
        for (int i = 0; i < 16; ++i) { o[qt][0][i] = 0.f; o[qt][1][i] = 0.f; } }
    const int rs_w = min(max(gi - 4, 0), 24);
    const int kroff = r * RS + hh * 16;
    const int vroff = ((lane >> 4) & 1) * 32 + ((lane & 15) >> 2) * 64 + (lane & 3) * 8 + hh * 4 * 64;
    AT_ISSUE(0, 0); AT_ISSUE(1, 1);
    int buf = 0, nbuf = 2;
    for (int t = 0; t < T; ++t) {
        if (t + 1 < T) asm volatile("s_waitcnt vmcnt(3)" ::: "memory"); else asm volatile("s_waitcnt vmcnt(0)" ::: "memory");
        __builtin_amdgcn_s_barrier(); asm volatile("" ::: "memory");
        if (t + 2 < T) AT_ISSUE(t + 2, nbuf);
        bool active = true; int kr = 0;
        if (MODE == 2 && t < NB) { kr = rs_min + t; active = (kr >= rs_w) && (kr < rs_w + 8); }
        if (active) {
            const LAS unsigned char* kb = lds + AT_K0 + buf * AT_KBUF + kroff; const LAS unsigned char* vb = lds + AT_V0 + buf * AT_VBUF + vroff;
            const bool band = (MODE == 2) && (t < NB);
#pragma unroll
            for (int kt = 0; kt < 2; ++kt) {
                if constexpr (QT == 2) { if (!band) {
                    const LAS unsigned char* kbt = kb + kt * 32 * RS;
                    auto qfrag = [&](int qt, int ks) -> bf16x8 { if (ks < KSR) return qf[qt][ks < KSR ? ks : 0]; return *(const LAS bf16x8*)(qrl + (qt * 2 + (ks - 4)) * 1024); };
                    auto softmax_nb = [&](f32x16& sv, int qt, bf16x8 (&pfo)[2], float& alpha) {
                        float mx = -1e30f, ps = 0.f;
#pragma unroll
                        for (int i = 0; i < 16; ++i) mx = fmaxf(mx, sv[i]);
                        mx = pair32_max(mx) * C2;
                        const float mn = fmaxf(m_[qt], mx); alpha = __builtin_amdgcn_exp2f(m_[qt] - mn); m_[qt] = mn;
#pragma unroll
                        for (int sx = 0; sx < 2; ++sx) { unsigned a[4];
#pragma unroll
                            for (int jj = 0; jj < 4; ++jj) { const int i = 8 * sx + 2 * jj;
                                const float p0 = __builtin_amdgcn_exp2f(fmaf(sv[i], C2, -mn)), p1 = __builtin_amdgcn_exp2f(fmaf(sv[i + 1], C2, -mn));
                                ps += p0 + p1; a[jj] = pk2(p0, p1); }
                            pfo[sx] = __builtin_bit_cast(bf16x8, (v4u){a[0], a[1], a[2], a[3]}); }
                        l_[qt] = l_[qt] * alpha + ps; };
                    f32x16 sA, sB;
#pragma unroll
                    for (int i = 0; i < 16; ++i) { sA[i] = 0.f; sB[i] = 0.f; }
                    bf16x8 kfr[KS];
#pragma unroll
                    for (int ks = 0; ks < KS; ++ks) { kfr[ks & 3] = *(const LAS bf16x8*)(kbt + ks * 32); sA = MFMA32(kfr[ks & 3], qfrag(0, ks), sA); }
                    __builtin_amdgcn_sched_barrier(0);
                    bf16x8 pfA[2], pfB[2]; float alA, alB;
                    bf16x8 kq[KS]; bf16x8 qq[KS];
#pragma unroll
                    for (int ks = 0; ks < KS; ++ks) { kq[ks] = *(const LAS bf16x8*)(kbt + ks * 32); qq[ks] = qfrag(1, ks); }
                    __builtin_amdgcn_sched_barrier(0);
#pragma unroll
                    for (int ks = 0; ks < KS; ++ks) sB = MFMA32(kq[ks], qq[ks], sB);
                    softmax_nb(sA, 0, pfA, alA);
#pragma unroll
                    for (int g = 0; g < KS; ++g) { __builtin_amdgcn_sched_group_barrier(0x008, 1, 0); __builtin_amdgcn_sched_group_barrier(0x002, 14, 0); }
                    __builtin_amdgcn_sched_barrier(0);
                    if (!__all(alA == 1.f)) {
#pragma unroll
                        for (int i = 0; i < 16; ++i) { o[0][0][i] *= alA; o[0][1][i] *= alA; } }
                    bf16x8 va[2], vc[2];
#pragma unroll
                    for (int sx = 0; sx < 2; ++sx) { const int rowb = (32 * kt + 16 * sx) * 64;
                        const v4i16 a00 = __builtin_amdgcn_ds_read_tr16_b64_v4i16((LAS v4i16*)(vb + rowb)), a01 = __builtin_amdgcn_ds_read_tr16_b64_v4i16((LAS v4i16*)(vb + rowb + 8 * 64));
                        const v4i16 a10 = __builtin_amdgcn_ds_read_tr16_b64_v4i16((LAS v4i16*)(vb + 4096 + rowb)), a11 = __builtin_amdgcn_ds_read_tr16_b64_v4i16((LAS v4i16*)(vb + 4096 + rowb + 8 * 64));
                        va[sx] = __builtin_shufflevector(a00, a01, 0, 1, 2, 3, 4, 5, 6, 7); vc[sx] = __builtin_shufflevector(a10, a11, 0, 1, 2, 3, 4, 5, 6, 7); }
                    __builtin_amdgcn_sched_barrier(0);
#pragma unroll
                    for (int sx = 0; sx < 2; ++sx) { o[0][0] = MFMA32(va[sx], pfA[sx], o[0][0]); o[0][1] = MFMA32(vc[sx], pfA[sx], o[0][1]); }
                    softmax_nb(sB, 1, pfB, alB);
#pragma unroll
                    for (int g = 0; g < 4; ++g) { __builtin_amdgcn_sched_group_barrier(0x008, 1, 0); __builtin_amdgcn_sched_group_barrier(0x002, 20, 0); }
                    __builtin_amdgcn_sched_barrier(0);
                    if (!__all(alB == 1.f)) {
#pragma unroll
                        for (int i = 0; i < 16; ++i) { o[1][0][i] *= alB; o[1][1][i] *= alB; } }
#pragma unroll
                    for (int sx = 0; sx < 2; ++sx) { o[1][0] = MFMA32(va[sx], pfB[sx], o[1][0]); o[1][1] = MFMA32(vc[sx], pfB[sx], o[1][1]); }
                    continue;
                } }
                f32x16 sc[QT];
#pragma unroll
                for (int qt = 0; qt < QT; ++qt)
#pragma unroll
                    for (int i = 0; i < 16; ++i) sc[qt][i] = 0.f;
#pragma unroll
                for (int ks = 0; ks < KS; ++ks) { const bf16x8 ka = *(const LAS bf16x8*)(kb + kt * 32 * RS + ks * 32);
#pragma unroll
                    for (int qt = 0; qt < QT; ++qt) { bf16x8 qb_; if (ks < KSR) qb_ = qf[qt][ks < KSR ? ks : 0]; else qb_ = *(const LAS bf16x8*)(qrl + (qt * 2 + (ks - 4)) * 1024);
                        sc[qt] = MFMA32(ka, qb_, sc[qt]); } }
                bf16x8 pf[QT][2];
#pragma unroll
                for (int qt = 0; qt < QT; ++qt) {
                    f32x16& s0 = sc[qt]; float mx = -1e30f, ps = 0.f, alpha;
                    if ((MODE == 2) && band) {
                        const bool part = qt != kt;
                        const int ilo = part ? (qt == 0 ? 0 : 12) : 0, ihi = part ? ilo + 4 : 16, sxv = qt == 0 ? 0 : 1;
                        const int ccol = 32 * qt + r; int cs = min(max(ccol - 8, 0), 48); asm volatile("" : "+v"(cs));
                        const LAS float* rt = (const LAS float*)(lds + AT_RPB) + (kr - gi + 7) * 128 + 64 - ccol + 32 * kt;
#pragma unroll
                        for (int i = 0; i < 16; ++i) if (i >= ilo && i < ihi) { const int k0 = 32 * kt + (i & 3) + 8 * (i >> 2) + 4 * hh; const bool v0 = (k0 >= cs) && (k0 < cs + 16);
                            s0[i] = v0 ? s0[i] * C2 + rt[(i & 3) + 8 * (i >> 2) + 4 * hh] : -1e30f; mx = fmaxf(mx, s0[i]); }
                        mx = pair32_max(mx);
                        const float mn = fmaxf(m_[qt], mx); alpha = __builtin_amdgcn_exp2f(m_[qt] - mn); m_[qt] = mn;
#pragma unroll
                        for (int sx = 0; sx < 2; ++sx) { if (part && sx != sxv) continue;
                            unsigned a[4];
#pragma unroll
                            for (int jj = 0; jj < 4; ++jj) { const int i = 8 * sx + 2 * jj;
                                if (!(i >= ilo && i < ihi)) { a[jj] = 0u; continue; }
                                float p0 = __builtin_amdgcn_exp2f(s0[i] - mn), p1 = __builtin_amdgcn_exp2f(s0[i + 1] - mn);
                                p0 = s0[i] > -1e29f ? p0 : 0.f; p1 = s0[i + 1] > -1e29f ? p1 : 0.f;
                                ps += p0 + p1; a[jj] = pk2(p0, p1); }
                            pf[qt][sx] = __builtin_bit_cast(bf16x8, (v4u){a[0], a[1], a[2], a[3]}); }
                    } else {
#pragma unroll
                        for (int i = 0; i < 16; ++i) mx = fmaxf(mx, s0[i]);
                        mx = pair32_max(mx) * C2;
                        const float mn = fmaxf(m_[qt], mx); alpha = __builtin_amdgcn_exp2f(m_[qt] - mn); m_[qt] = mn;
#pragma unroll
                        for (int sx = 0; sx < 2; ++sx) { unsigned a[4];
#pragma unroll
                            for (int jj = 0; jj < 4; ++jj) { const int i = 8 * sx + 2 * jj;
                                const float p0 = __builtin_amdgcn_exp2f(fmaf(s0[i], C2, -mn)), p1 = __builtin_amdgcn_exp2f(fmaf(s0[i + 1], C2, -mn));
                                ps += p0 + p1; a[jj] = pk2(p0, p1); }
                            pf[qt][sx] = __builtin_bit_cast(bf16x8, (v4u){a[0], a[1], a[2], a[3]}); }
                    }
                    l_[qt] = l_[qt] * alpha + ps;
                    if (!__all(alpha == 1.f)) {
#pragma unroll
                        for (int i = 0; i < 16; ++i) { o[qt][0][i] *= alpha; o[qt][1][i] *= alpha; } }
                }
#pragma unroll
                for (int sx = 0; sx < 2; ++sx) {
                    const int rowb = (32 * kt + 16 * sx) * 64;
                    const v4i16 a00 = __builtin_amdgcn_ds_read_tr16_b64_v4i16((LAS v4i16*)(vb + rowb)), a01 = __builtin_amdgcn_ds_read_tr16_b64_v4i16((LAS v4i16*)(vb + rowb + 8 * 64));
                    const v4i16 a10 = __builtin_amdgcn_ds_read_tr16_b64_v4i16((LAS v4i16*)(vb + 4096 + rowb)), a11 = __builtin_amdgcn_ds_read_tr16_b64_v4i16((LAS v4i16*)(vb + 4096 + rowb + 8 * 64));
                    const bf16x8 va = __builtin_shufflevector(a00, a01, 0, 1, 2, 3, 4, 5, 6, 7), vc = __builtin_shufflevector(a10, a11, 0, 1, 2, 3, 4, 5, 6, 7);
#pragma unroll
                    for (int qt = 0; qt < QT; ++qt) { if ((MODE == 2) && band && (qt != kt) && sx != (qt == 0 ? 0 : 1)) continue;
                        o[qt][0] = MFMA32(va, pf[qt][sx], o[qt][0]); o[qt][1] = MFMA32(vc, pf[qt][sx], o[qt][1]); } }
            }
        }
        buf = buf == 2 ? 0 : buf + 1; nbuf = nbuf == 2 ? 0 : nbuf + 1;
    }
#pragma unroll
    for (int qt = 0; qt < QT; ++qt) {
        const float lt = pair32_sum(l_[qt]), inv = 1.f / lt;
        bf16* op = Yo + (size_t)(qrow0 + 32 * qt) * 512 + hd * 64 + 4 * hh;
#pragma unroll
        for (int g4 = 0; g4 < 4; ++g4) { v2u w0, w1; w0.x = pk2(o[qt][0][4 * g4] * inv, o[qt][0][4 * g4 + 1] * inv); w0.y = pk2(o[qt][0][4 * g4 + 2] * inv, o[qt][0][4 * g4 + 3] * inv);
            w1.x = pk2(o[qt][1][4 * g4] * inv, o[qt][1][4 * g4 + 1] * inv); w1.y = pk2(o[qt][1][4 * g4 + 2] * inv, o[qt][1][4 * g4 + 3] * inv);
            *(v2u*)(op + 8 * g4) = w0; *(v2u*)(op + 32 + 8 * g4) = w1; } }
    __syncthreads();
#undef AT_ISSUE
}
__device__ __forceinline__ void phase_attn(const Ctx& C, int l) {
    { int b_ = C.bid; asm volatile("" : "+s"(b_)); if (l < NL - 1 && (b_ & 3) == 0) { conv_weights(C, l + 1, 0, 100, 0, C.G); __syncthreads(); } }
    for (int u = C.bid; u < 512; u += C.G) attn_unit<0>(C, l, u);
    { int b_ = C.bid; asm volatile("" : "+s"(b_)); if (l < NL - 1 && (b_ & 3) == 1) { conv_weights(C, l + 1, 0, 100, 0, C.G); __syncthreads(); } }
    for (int u = C.bid; u < 512; u += C.G) attn_unit<2>(C, l, u);
    { int b_ = C.bid; asm volatile("" : "+s"(b_)); if (l < NL - 1 && (b_ & 3) == 2) { conv_weights(C, l + 1, 0, 100, 0, C.G); __syncthreads(); } }
    if (l < NL - 1) for (int u = C.bid; u < 256; u += C.G) { if (u < 128) attn_unit<1>(C, l, u); else attn_unit<3>(C, l, u - 128); }
    { int b_ = C.bid; asm volatile("" : "+s"(b_)); if (l < NL - 1 && (b_ & 3) == 3) { conv_weights(C, l + 1, 0, 100, 0, C.G); __syncthreads(); } }
}

__device__ __forceinline__ float reduce16(float (&v)[16], int lane) {
#pragma unroll
    for (int i = 0; i < 8; ++i) { const bool hi = lane & 32; const float keep = hi ? v[i + 8] : v[i], send = hi ? v[i] : v[i + 8]; v[i] = keep + xshfl<32>(send); }
#pragma unroll
    for (int i = 0; i < 4; ++i) { const bool hi = lane & 16; const float keep = hi ? v[i + 4] : v[i], send = hi ? v[i] : v[i + 4]; v[i] = keep + xshfl<16>(send); }
#pragma unroll
    for (int i = 0; i < 2; ++i) { const bool hi = lane & 8; const float keep = hi ? v[i + 2] : v[i], send = hi ? v[i] : v[i + 2]; v[i] = keep + xshfl<8>(send); }
    { const bool hi = lane & 4; const float keep = hi ? v[1] : v[0], send = hi ? v[0] : v[1]; v[0] = keep + xshfl<4>(send); }
    v[0] += xshfl<2>(v[0]); v[0] += xshfl<1>(v[0]);
    return v[0];
}
__device__ __forceinline__ void phase_ln1(const Ctx& C, int l) {
    int lane = C.lane; OPAQUE(lane); const int gw = C.bid * NWAVES + C.wave, NGW = C.G * NWAVES;
    LAS float* Wr = (LAS float*)C.lds;
    const float* wr = INP(I_WROUTER) + (size_t)l * 1024 * 16;
    for (int idx = C.tid; idx < 16384; idx += NTHREADS) { const int c = idx >> 4, e = idx & 15; Wr[e * 1024 + c] = wr[idx]; }
    __syncthreads();
    const bf16* Yb = WSP(bf16, WS_YP); const float* X = WSP(float, WS_X); bf16* H2 = WSP(bf16, WS_HB); float* AFF = WSP(float, WS_AFF); float* STAT = WSP(float, WS_STAT);
    const float* XI = INP(I_X); const float* XC = INP(I_CTX) - (size_t)ML * DM;
    const float* MODS = WSP(float, WS_MODS) + (size_t)l * 17 * 6144;
    const float* lg = INP(I_LN1G) + l * 1024; const float* lb = INP(I_LN1B) + l * 1024;
    const int myexp = ((lane >> 5) & 1) * 8 + ((lane >> 4) & 1) * 4 + ((lane >> 3) & 1) * 2 + ((lane >> 2) & 1);
    const int nrp = (l == NL - 1 ? ML : MT) / 2;
    f32x4 nx[2][4]; v4u ny[2][2];
#define LN1_LOAD(rp_) do { const int r_ = 2 * (rp_); const float* xs_ = (l == 0 ? (r_ < ML ? XI : XC) : X) + (size_t)r_ * DM; _Pragma("unroll") for (int j = 0; j < 2; ++j) { const int c = 8 * (lane + 64 * j); \
        nx[0][2 * j] = *(const f32x4*)(xs_ + c); nx[0][2 * j + 1] = *(const f32x4*)(xs_ + c + 4); nx[1][2 * j] = *(const f32x4*)(xs_ + DM + c); nx[1][2 * j + 1] = *(const f32x4*)(xs_ + DM + c + 4); \
        ny[0][j] = *(const v4u*)(Yb + (size_t)r_ * DM + c); ny[1][j] = *(const v4u*)(Yb + (size_t)(r_ + 1) * DM + c); } } while (0)
    if (gw < nrp) LN1_LOAD(gw);
    for (int rp = gw; rp < nrp; rp += NGW) {
        const int row = 2 * rp; const int mr = row < ML ? (row >> 11) : 16; const float* md = MODS + (size_t)mr * 6144;
        f32x4 v[2][4]; float sa = 0.f, sb = 0.f;
#pragma unroll
        for (int j = 0; j < 2; ++j) { const int c = 8 * (lane + 64 * j); const f32x4 g1a = *(const f32x4*)(md + 2048 + c), g1b = *(const f32x4*)(md + 2048 + c + 4);
            v[0][2 * j] = nx[0][2 * j] * DN_ALPHA + g1a * pg8::unpack4((v2u){ny[0][j].x, ny[0][j].y}); v[0][2 * j + 1] = nx[0][2 * j + 1] * DN_ALPHA + g1b * pg8::unpack4((v2u){ny[0][j].z, ny[0][j].w});
            v[1][2 * j] = nx[1][2 * j] * DN_ALPHA + g1a * pg8::unpack4((v2u){ny[1][j].x, ny[1][j].y}); v[1][2 * j + 1] = nx[1][2 * j + 1] * DN_ALPHA + g1b * pg8::unpack4((v2u){ny[1][j].z, ny[1][j].w}); }
        if (rp + NGW < nrp) LN1_LOAD(rp + NGW);
#pragma unroll
        for (int j = 0; j < 4; ++j) { sa += (v[0][j][0] + v[0][j][1]) + (v[0][j][2] + v[0][j][3]); sb += (v[1][j][0] + v[1][j][1]) + (v[1][j][2] + v[1][j][3]); }
        const float mean0 = wave_sum(sa) * (1.f / 1024.f), mean1 = wave_sum(sb) * (1.f / 1024.f); float qa = 0.f, qb = 0.f;
#pragma unroll
        for (int j = 0; j < 4; ++j) { v[0][j] = v[0][j] - mean0; v[1][j] = v[1][j] - mean1;
            qa += (v[0][j][0] * v[0][j][0] + v[0][j][1] * v[0][j][1]) + (v[0][j][2] * v[0][j][2] + v[0][j][3] * v[0][j][3]);
            qb += (v[1][j][0] * v[1][j][0] + v[1][j][1] * v[1][j][1]) + (v[1][j][2] * v[1][j][2] + v[1][j][3] * v[1][j][3]); }
        const float rstd0 = 1.f / sqrtf(wave_sum(qa) * (1.f / 1024.f) + LN_EPS), rstd1 = 1.f / sqrtf(wave_sum(qb) * (1.f / 1024.f) + LN_EPS);
        if (lane == 0) *(f32x4*)(STAT + (size_t)row * 2) = (f32x4){mean0, rstd0, mean1, rstd1};
        float lg0[16], lg1[16];
#pragma unroll
        for (int e = 0; e < 16; ++e) { lg0[e] = 0.f; lg1[e] = 0.f; }
#pragma unroll
        for (int j = 0; j < 2; ++j) { const int c0 = 8 * (lane + 64 * j); f32x4 ha[2], hb[2];
#pragma unroll
            for (int h = 0; h < 2; ++h) { const int c = c0 + 4 * h;
                const f32x4 gg = *(const f32x4*)(lg + c), bb = *(const f32x4*)(lb + c), scl = *(const f32x4*)(md + 4096 + c) + 1.f, shf = *(const f32x4*)(md + 3072 + c);
                const f32x4 xa = v[0][2 * j + h] * rstd0 * gg + bb, xb = v[1][2 * j + h] * rstd1 * gg + bb;
                ha[h] = xa * scl + shf; hb[h] = xb * scl + shf; }
            *(v4u*)(H2 + (size_t)row * DM + c0) = pg8::pack8(ha[0], ha[1]); *(v4u*)(H2 + (size_t)(row + 1) * DM + c0) = pg8::pack8(hb[0], hb[1]);
#pragma unroll
            for (int h = 0; h < 2; ++h) {
#pragma unroll
                for (int e = 0; e < 16; ++e) { const f32x4 wv = *(const LAS f32x4*)(Wr + e * 1024 + c0 + 4 * h);
                    lg0[e] += (ha[h][0] * wv[0] + ha[h][1] * wv[1]) + (ha[h][2] * wv[2] + ha[h][3] * wv[3]); lg1[e] += (hb[h][0] * wv[0] + hb[h][1] * wv[1]) + (hb[h][2] * wv[2] + hb[h][3] * wv[3]); }
                asm volatile("" ::: "memory"); } }
        const float t0 = reduce16(lg0, lane), t1 = reduce16(lg1, lane);
        float m0 = t0, m1 = t1;
        m0 = fmaxf(m0, xshfl<4>(m0)); m1 = fmaxf(m1, xshfl<4>(m1)); m0 = fmaxf(m0, xshfl<8>(m0)); m1 = fmaxf(m1, xshfl<8>(m1)); m0 = fmaxf(m0, xshfl<16>(m0)); m1 = fmaxf(m1, xshfl<16>(m1)); m0 = pair32_max(m0); m1 = pair32_max(m1);
        const float p0 = expf(t0 - m0), p1 = expf(t1 - m1); float d0 = p0, d1 = p1;
        d0 += xshfl<4>(d0); d1 += xshfl<4>(d1); d0 += xshfl<8>(d0); d1 += xshfl<8>(d1); d0 += xshfl<16>(d0); d1 += xshfl<16>(d1); d0 = pair32_sum(d0); d1 = pair32_sum(d1);
        if ((lane & 3) == 0) { AFF[(size_t)row * 16 + myexp] = p0 / d0; AFF[(size_t)(row + 1) * 16 + myexp] = p1 / d1; }
    }
#undef LN1_LOAD
}

__device__ __forceinline__ void phase_topk(const Ctx& Cc, int l) {
    Ctx C = Cc; OPAQUE(C.tid);
    LAS unsigned long long* a = (LAS unsigned long long*)C.lds;
    const float* AFF = WSP(float, WS_AFF); int* SEL = WSP(int, WS_SEL); int* IDX = WSP(int, WS_IDX);
    const int nitem = l == NL - 1 ? 256 : 512;
    for (int item = C.bid; item < nitem; item += C.G) {
        const bool lat = item < 256; const int it = lat ? item : item - 256, b = it >> 4, e = it & 15;
        const int N = lat ? 2048 : 256, cap = lat ? CAPL : CAPC, base = lat ? b * 2048 : ML + b * 256, slotbase = lat ? b * CAPL : NBATCH * CAPL + b * CAPC;
        for (int t = C.tid; t < N; t += NTHREADS) a[t] = ((unsigned long long)__float_as_uint(AFF[(size_t)(base + t) * 16 + e]) << 32) | (unsigned long long)(0xFFFFFFFFu - (unsigned)t);
        __syncthreads();
        for (int k = 2; k <= N; k <<= 1)
            for (int j = k >> 1; j > 0; j >>= 1) {
                for (int p = C.tid; p < N / 2; p += NTHREADS) {
                    const int i = ((p & ~(j - 1)) << 1) | (p & (j - 1)), ij = i | j;
                    const unsigned long long x = a[i], y = a[ij];
                    const bool desc = (i & k) == 0;
                    if (desc ? (x < y) : (x > y)) { a[i] = y; a[ij] = x; }
                }
                __syncthreads();
            }
        for (int p = C.tid; p < N; p += NTHREADS) { const int tok = (int)(0xFFFFFFFFu - (unsigned)a[p]);
            SEL[(size_t)(base + tok) * 16 + e] = p < cap ? p : -1;
            if (p < cap) IDX[e * ROWS_E + slotbase + p] = base + tok; }
        __syncthreads();
    }
}

__device__ __forceinline__ void phase_gather(const Ctx& C) {
    int lane = C.lane; OPAQUE(lane); const int gw = C.bid * NWAVES + C.wave, NGW = C.G * NWAVES;
    const int* IDX = WSP(int, WS_IDX); const bf16* H2 = WSP(bf16, WS_HB); bf16* XG = WSP(bf16, WS_XG);
    for (int r = gw; r < MG; r += NGW) { const int src = IDX[r]; const v4u* s = (const v4u*)(H2 + (size_t)src * DM); v4u* d = (v4u*)(XG + (size_t)r * DM);
        const v4u a = s[lane], b = s[lane + 64]; d[lane] = a; d[lane + 64] = b; }
}

__device__ __forceinline__ void phase_combine(const Ctx& C, int l) {
    int lane = C.lane; OPAQUE(lane); const int gw = C.bid * NWAVES + C.wave, NGW = C.G * NWAVES;
    const bf16* Y = WSP(bf16, WS_Y); float* X = WSP(float, WS_X); bf16* H = WSP(bf16, WS_HB); const float* AFF = WSP(float, WS_AFF); const int* SEL = WSP(int, WS_SEL);
    const bf16* Yp = WSP(bf16, WS_YP); const float* STAT = WSP(float, WS_STAT); const float* l1g = INP(I_LN1G) + l * 1024; const float* l1b = INP(I_LN1B) + l * 1024;
    const float* XI = INP(I_X); const float* XC = INP(I_CTX) - (size_t)ML * DM;
    const float* MODS = WSP(float, WS_MODS) + (size_t)l * 17 * 6144; const float* MODN = MODS + 17 * 6144;
    const float* lg = INP(I_LN2G) + l * 1024; const float* lb = INP(I_LN2B) + l * 1024;
    const int nrp = (l == NL - 1 ? ML : MT) / 2;
    f32x4 nxa[4], nxb[4]; v4u nya[2], nyb[2]; f32x4 nst = (f32x4){0.f, 0.f, 0.f, 0.f}; int nsel = 0; float naff = 0.f;
#define CMB_LOAD(rp_) do { const int r_ = 2 * (rp_); nsel = SEL[(size_t)r_ * 16 + (lane & 31)]; naff = AFF[(size_t)r_ * 16 + (lane & 31)]; nst = *(const f32x4*)(STAT + (size_t)r_ * 2); \
        const float* xs_ = (l == 0 ? (r_ < ML ? XI : XC) : (const float*)X) + (size_t)r_ * DM; \
        _Pragma("unroll") for (int j = 0; j < 2; ++j) { nya[j] = *(const v4u*)(Yp + (size_t)r_ * DM + 8 * (lane + 64 * j)); nyb[j] = *(const v4u*)(Yp + (size_t)(r_ + 1) * DM + 8 * (lane + 64 * j)); \
            _Pragma("unroll") for (int h = 0; h < 2; ++h) { const int c = 8 * (lane + 64 * j) + 4 * h; nxa[2 * j + h] = *(const f32x4*)(xs_ + c); nxb[2 * j + h] = *(const f32x4*)(xs_ + DM + c); } } } while (0)
    if (gw < nrp) CMB_LOAD(gw);
    for (int rp = gw; rp < nrp; rp += NGW) {
        const int row = 2 * rp; const bool lat = row < ML; const int mr = lat ? (row >> 11) : 16; const float* md = MODS + (size_t)mr * 6144;
        const int rb = lat ? (row >> 11) * CAPL : NBATCH * CAPL + ((row - ML) >> 8) * CAPC;
        const int selv = nsel; const float affv = naff;
        f32x4 xa[4], xb[4];
        {
            const f32x4 st = nst;
#pragma unroll
            for (int j = 0; j < 2; ++j) { const int c = 8 * (lane + 64 * j); const f32x4 g1a = *(const f32x4*)(md + 2048 + c), g1b = *(const f32x4*)(md + 2048 + c + 4);
                const f32x4 gga = *(const f32x4*)(l1g + c), ggb = *(const f32x4*)(l1g + c + 4), bba = *(const f32x4*)(l1b + c), bbb = *(const f32x4*)(l1b + c + 4);
                xa[2 * j] = ((nxa[2 * j] * DN_ALPHA + g1a * pg8::unpack4((v2u){nya[j].x, nya[j].y})) - st[0]) * st[1] * gga + bba; xa[2 * j + 1] = ((nxa[2 * j + 1] * DN_ALPHA + g1b * pg8::unpack4((v2u){nya[j].z, nya[j].w})) - st[0]) * st[1] * ggb + bbb;
                xb[2 * j] = ((nxb[2 * j] * DN_ALPHA + g1a * pg8::unpack4((v2u){nyb[j].x, nyb[j].y})) - st[2]) * st[3] * gga + bba; xb[2 * j + 1] = ((nxb[2 * j + 1] * DN_ALPHA + g1b * pg8::unpack4((v2u){nyb[j].z, nyb[j].w})) - st[2]) * st[3] * ggb + bbb; }
        }
        if (rp + NGW < nrp) CMB_LOAD(rp + NGW);
        unsigned long long bal = __ballot(selv >= 0);
        unsigned ma = (unsigned)(bal & 0xffffu), mb = (unsigned)((bal >> 16) & 0xffffu);
        f32x4 acca[4], accb[4];
#pragma unroll
        for (int j = 0; j < 4; ++j) { acca[j] = (f32x4){0.f, 0.f, 0.f, 0.f}; accb[j] = (f32x4){0.f, 0.f, 0.f, 0.f}; }
        while (ma | mb) {
            const int ea = ma ? __builtin_ctz(ma) : 0, eb = mb ? __builtin_ctz(mb) : 0;
            const int sa = __builtin_amdgcn_readlane(selv, ea), sb = __builtin_amdgcn_readlane(selv, 16 + eb); float fa = __uint_as_float(__builtin_amdgcn_readlane(__float_as_uint(affv), ea)), fb = __uint_as_float(__builtin_amdgcn_readlane(__float_as_uint(affv), 16 + eb));
            if (!ma) fa = 0.f; if (!mb) fb = 0.f;
            const bf16* ya = Y + ((size_t)ea * ROWS_E + rb + (ma ? sa : 0)) * DM; const bf16* yb = Y + ((size_t)eb * ROWS_E + rb + (mb ? sb : 0)) * DM;
            v4u wa[2], wb[2];
#pragma unroll
            for (int j = 0; j < 2; ++j) { wa[j] = *(const v4u*)(ya + 8 * (lane + 64 * j)); wb[j] = *(const v4u*)(yb + 8 * (lane + 64 * j)); }
#pragma unroll
            for (int j = 0; j < 2; ++j) { acca[2 * j] = acca[2 * j] + pg8::unpack4((v2u){wa[j].x, wa[j].y}) * fa; acca[2 * j + 1] = acca[2 * j + 1] + pg8::unpack4((v2u){wa[j].z, wa[j].w}) * fa;
                accb[2 * j] = accb[2 * j] + pg8::unpack4((v2u){wb[j].x, wb[j].y}) * fb; accb[2 * j + 1] = accb[2 * j + 1] + pg8::unpack4((v2u){wb[j].z, wb[j].w}) * fb; }
            ma &= ma - 1; mb &= mb - 1;
        }
        float sma = 0.f, smb = 0.f;
#pragma unroll
        for (int j = 0; j < 2; ++j)
#pragma unroll
            for (int h = 0; h < 2; ++h) { const int q = 2 * j + h; const f32x4 g2 = *(const f32x4*)(md + 5120 + 8 * (lane + 64 * j) + 4 * h); xa[q] = xa[q] * DN_ALPHA + g2 * acca[q]; xb[q] = xb[q] * DN_ALPHA + g2 * accb[q];
                sma += (xa[q][0] + xa[q][1]) + (xa[q][2] + xa[q][3]); smb += (xb[q][0] + xb[q][1]) + (xb[q][2] + xb[q][3]); }
        const float mean0 = wave_sum(sma) * (1.f / 1024.f), mean1 = wave_sum(smb) * (1.f / 1024.f); float qa = 0.f, qb = 0.f;
#pragma unroll
        for (int j = 0; j < 4; ++j) { xa[j] = xa[j] - mean0; xb[j] = xb[j] - mean1;
            qa += (xa[j][0] * xa[j][0] + xa[j][1] * xa[j][1]) + (xa[j][2] * xa[j][2] + xa[j][3] * xa[j][3]); qb += (xb[j][0] * xb[j][0] + xb[j][1] * xb[j][1]) + (xb[j][2] * xb[j][2] + xb[j][3] * xb[j][3]); }
        const float rstd0 = 1.f / sqrtf(wave_sum(qa) * (1.f / 1024.f) + LN_EPS), rstd1 = 1.f / sqrtf(wave_sum(qb) * (1.f / 1024.f) + LN_EPS);
#pragma unroll
        for (int j = 0; j < 2; ++j) { const int c0 = 8 * (lane + 64 * j); f32x4 ya[2], yb[2];
#pragma unroll
            for (int h = 0; h < 2; ++h) { const int c = c0 + 4 * h; const f32x4 gg = *(const f32x4*)(lg + c), bb = *(const f32x4*)(lb + c);
                ya[h] = xa[2 * j + h] * rstd0 * gg + bb; yb[h] = xb[2 * j + h] * rstd1 * gg + bb; }
            if (l < NL - 1) { const float* mn = MODN + (size_t)mr * 6144; f32x4 ha[2], hb[2];
#pragma unroll
                for (int h = 0; h < 2; ++h) { const int c = c0 + 4 * h; *(f32x4*)(X + (size_t)row * DM + c) = ya[h]; *(f32x4*)(X + (size_t)(row + 1) * DM + c) = yb[h];
                    const f32x4 scl = *(const f32x4*)(mn + 1024 + c) + 1.f, shf = *(const f32x4*)(mn + c); ha[h] = ya[h] * scl + shf; hb[h] = yb[h] * scl + shf; }
                *(v4u*)(H + (size_t)row * DM + c0) = pg8::pack8(ha[0], ha[1]); *(v4u*)(H + (size_t)(row + 1) * DM + c0) = pg8::pack8(hb[0], hb[1]); }
            else if (lat) {
#pragma unroll
                for (int h = 0; h < 2; ++h) { const int c = c0 + 4 * h; *(f32x4*)(C.out + (size_t)row * DM + c) = ya[h]; *(f32x4*)(C.out + (size_t)(row + 1) * DM + c) = yb[h]; } } }
    }
#undef CMB_LOAD
}

enum { PH_MODS = 0, PH_MOD0, PH_WIN, PH_PREP, PH_CONV, PH_UQ, PH_UKV, PH_ATTN, PH_MERGE, PH_WOUT, PH_LN1, PH_TOPK, PH_GATHER, PH_GU, PH_DOWN, PH_COMB, PH_COUNT };
template <int PH> __device__ __forceinline__ void run_phase(const Ctx& C, int l) {
    if constexpr (PH == PH_MODS) { phase_mods(C); __syncthreads(); conv_weights(C, 0, 0, 100, 0, C.G); }
    if constexpr (PH == PH_MOD0) { phase_mod0(C); }
    if constexpr (PH == PH_WIN) { pg8::ProbPlain P{WSP(bf16, WS_HB), WSW(bf16, WS_WIN, l), 1024, 1024, 1024}; pg8::EpiWin E{WSP(bf16, WS_R)};
        if (l == NL - 1) { pg8::OrderWinLast S; S.init(C.G, C.bid); pg8::gemm_phase(C.lds, P, S, E, C.wave); }
        else { pg8::Order<1> S; S.init(MT / 256, NP / 256, C.G, C.bid); pg8::gemm_phase(C.lds, P, S, E, C.wave); } }
    if constexpr (PH == PH_PREP) { phase_prep(C, l); }
    if constexpr (PH == PH_CONV) { phase_conv(C, l); }
    if constexpr (PH == PH_UQ) { pg8::ProbUp2 P{WSP(bf16, WS_CQN), WSP(bf16, WS_CKVN), WSW(bf16, WS_WUQ, l), WSW(bf16, WS_WUKV, l), 256, 256, 256};
        pg8::OrderUp2 S; S.init((l == NL - 1 ? ML : MT) / 256, C.G, C.bid); pg8::EpiUp2 E{WSP(bf16, WS_QB), WSP(bf16, WS_KVB)}; pg8::gemm_phase(C.lds, P, S, E, C.wave); }
    if constexpr (PH == PH_ATTN) { phase_attn(C, l); }
    if constexpr (PH == PH_MERGE) { pg8::ProbSeg3 P{WSP(bf16, WS_YA), WSW(bf16, WS_WOA, l), 512, 512, 512, (size_t)(36 * MiB / 2), (size_t)(1 * MiB / 2)};
        pg8::Order<3> S; S.init((l == NL - 1 ? ML : MT) / 256, 4, C.G, C.bid); pg8::EpiMerge E{WSP(bf16, WS_R), WSP(bf16, WS_HB)}; pg8::gemm_phase(C.lds, P, S, E, C.wave); }
    if constexpr (PH == PH_WOUT) { pg8::ProbPlain P{WSP(bf16, WS_HB), WSW(bf16, WS_WOUT, l), 1024, 1024, 1024}; pg8::Order<1> S; S.init((l == NL - 1 ? ML : MT) / 256, 4, C.G, C.bid);
        pg8::EpiBf16 E{WSP(bf16, WS_YP), 1024}; pg8::gemm_phase(C.lds, P, S, E, C.wave); }
    if constexpr (PH == PH_LN1) { phase_ln1(C, l); }
    if constexpr (PH == PH_TOPK) { phase_topk(C, l); }
    if constexpr (PH == PH_GATHER) { phase_gather(C); }
    if constexpr (PH == PH_GU) { pg8::OrderOrd S; S.o.init(l == NL - 1 ? 256 : 288, 8, C.G, C.bid, l == NL - 1 ? 16 : 0);
        LAS int* lidx = (LAS int*)(C.lds + LIDX_OFF); const int* IDXg = WSP(int, WS_IDX);
        { pg8::Unit uu; for (int i = 0; i < 10 && S.next(i, uu); ++i) if (C.tid < 256) lidx[i * 256 + C.tid] = IDXg[uu.pm * 256 + C.tid]; }
        __syncthreads();
        pg8::ProbMoEGather P{WSP(bf16, WS_HB), WSW(bf16, WS_WGU, l), lidx, 1024, 1024, 1024, 2048};
        pg8::EpiSwiGLU E{WSP(bf16, WS_HID)}; pg8::gemm_phase(C.lds, P, S, E, C.wave); }
    if constexpr (PH == PH_DOWN) { pg8::ProbMoE P{WSP(bf16, WS_HID), WSW(bf16, WS_WD, l), 1024, 1024, 1024, 1024}; pg8::Order<1> S; S.init(l == NL - 1 ? 256 : 288, 4, C.G, C.bid, l == NL - 1 ? 16 : 0);
        pg8::EpiBf16 E{WSP(bf16, WS_Y), 1024}; pg8::gemm_phase(C.lds, P, S, E, C.wave); }
    if constexpr (PH == PH_COMB) { phase_combine(C, l); }
}
template <int PH> __device__ __forceinline__ void call_phase(const Ctx& Cin, int l) { Ctx C = Cin; C.lane = lane_id(); OPAQUE(C.lane); asm volatile("" : "+s"(C.wave)); C.tid = C.wave * 64 + C.lane; asm volatile("" : "+s"(l)); asm volatile("" : "+s"(C.G)); asm volatile("" : "+s"(C.bid)); { unsigned long long w_ = (unsigned long long)C.ws; unsigned lo_ = (unsigned)w_, hi_ = (unsigned)(w_ >> 32); asm volatile("" : "+s"(lo_)); asm volatile("" : "+s"(hi_)); C.ws = (unsigned char*)(GAS unsigned char*)(((unsigned long long)hi_ << 32) | lo_); } run_phase<PH>(C, l); }
__global__ void __launch_bounds__(NTHREADS, 2) mega_fwd(Args args) {
    extern __shared__ __attribute__((aligned(16))) unsigned char lds_raw[];
    Ctx C;
    C.lds = (LAS unsigned char*)lds_raw;
    C.tid = threadIdx.x; C.lane = C.tid & 63; C.wave = __builtin_amdgcn_readfirstlane(C.tid >> 6);
    C.G = gridDim.x; C.bid = blockIdx.x;
    C.in = args.in; C.ws = (unsigned char*)(GAS unsigned char*)args.ws; C.out = (float*)(GAS float*)args.out;
    volatile LAS unsigned* MISC = (volatile LAS unsigned*)(C.lds + MISC_OFF);
    for (int u = C.tid; u < (LDS_BYTES - LDSCTL_OFF) / 4; u += NTHREADS) ((LAS unsigned*)(C.lds + LDSCTL_OFF))[u] = 0u;
    __syncthreads();
    XcdBarrier bar = xcd_barrier_post((unsigned*)(C.ws + WS_CTL) + 4096, MISC + 8, C.wave);
    call_phase<PH_MODS>(C, 0); xcd_barrier(bar);
    call_phase<PH_MOD0>(C, 0); xcd_barrier(bar);
    for (int l = 0; l < NL; ++l) {
        call_phase<PH_WIN>(C, l); xcd_barrier(bar);
        call_phase<PH_PREP>(C, l); xcd_barrier(bar);
        call_phase<PH_CONV>(C, l); __syncthreads(); call_phase<PH_UQ>(C, l); xcd_barrier(bar);
        call_phase<PH_ATTN>(C, l); xcd_barrier(bar);
        call_phase<PH_MERGE>(C, l); xcd_barrier(bar);
        call_phase<PH_WOUT>(C, l); xcd_barrier(bar);
        call_phase<PH_LN1>(C, l); xcd_barrier(bar);
        call_phase<PH_TOPK>(C, l); xcd_barrier(bar);
        call_phase<PH_GU>(C, l); xcd_barrier(bar);
        call_phase<PH_DOWN>(C, l); xcd_barrier(bar);
        call_phase<PH_COMB>(C, l); if (l < NL - 1) xcd_barrier(bar);
    }
}

extern "C" void kernel_launch(void* const* d_in, const int* in_sizes, int n_in, void* d_out, int out_size, void* d_ws, size_t ws_size, hipStream_t stream) {
    static int grid = 0;
    if (grid == 0) {
        if (n_in != 28 || out_size != ML * DM || ws_size < WS_END) { fprintf(stderr, "kernel_launch: unexpected shapes: n_in %d out %d ws %zu (need %zu)\n", n_in, out_size, ws_size, (size_t)WS_END); grid = -1; return; }
        int dev = 0, cus = 0, per_cu = 0;
        if (hipGetDevice(&dev) != hipSuccess || hipDeviceGetAttribute(&cus, hipDeviceAttributeMultiprocessorCount, dev) != hipSuccess) { grid = -1; return; }
        if (hipFuncSetAttribute((const void*)mega_fwd, hipFuncAttributeMaxDynamicSharedMemorySize, LDS_BYTES) != hipSuccess) { fprintf(stderr, "kernel_launch: hipFuncSetAttribute failed\n"); grid = -1; return; }
        if (hipOccupancyMaxActiveBlocksPerMultiprocessor(&per_cu, (const void*)mega_fwd, NTHREADS, LDS_BYTES) != hipSuccess || per_cu < 1) { fprintf(stderr, "kernel_launch: occupancy query says %d\n", per_cu); grid = -1; return; }
        (void)hipGetLastError();
        grid = cus;
    }
    if (grid < 0) return;
    (void)hipMemsetAsync((char*)d_ws + WS_CTL, 0, CTL_ZERO_BYTES, stream);
    Args a{};
    for (int i = 0; i < 28; ++i) a.in[i] = (const float*)d_in[i];
    a.out = (float*)d_out; a.ws = (unsigned char*)d_ws;
    hipLaunchKernelGGL(mega_fwd, dim3(grid), dim3(NTHREADS), LDS_BYTES, stream, a);
}
```

```cpp
#include <hip/hip_runtime.h>
#include <cstdio>
#include <cstdint>
#include <utility>

#ifndef MK_ONE_LAUNCH
#define MK_ONE_LAUNCH 0
#endif

#define GAS __attribute__((address_space(1)))
#define LAS __attribute__((address_space(3)))
typedef unsigned short bf16;
typedef unsigned v4u __attribute__((ext_vector_type(4)));
typedef unsigned v2u __attribute__((ext_vector_type(2)));
typedef float f32x4 __attribute__((ext_vector_type(4)));
typedef float f32x2 __attribute__((ext_vector_type(2)));
typedef short bf16x8 __attribute__((ext_vector_type(8)));

constexpr int NL = 4, DM = 1024, NBATCH = 16, SQ = 2048, CL = 256;
constexpr int ML = NBATCH * SQ, MC = NBATCH * CL, MT = ML + MC;
constexpr int NP = 6144;
constexpr int C_QA = 0, C_KA = 512, C_VA = 1024, C_CQ = 1536, C_CKV = 1792, C_KR = 1920, C_CIN = 2048, C_GT = 3072;
constexpr int NE = 16, CAPL = 256, CAPC = 32, ROWS_E = NBATCH * CAPL + NBATCH * CAPC, MG = NE * ROWS_E;
constexpr float LN_EPS = 1e-5f, RMS_EPS = 1e-6f, DN_ALPHA = 1.681792830507429f;
constexpr int NWAVES = 8, NTHREADS = 512;

constexpr size_t MiB = 1u << 20;
constexpr size_t WS_CTL = 0, CTL_ZERO_BYTES = 1 * MiB;
constexpr size_t WS_MODS = 1 * MiB;
constexpr size_t WS_TAB = 3 * MiB;
constexpr size_t WS_AFF = 4 * MiB;
constexpr size_t WS_SEL = 7 * MiB;
constexpr size_t WS_IDX = 10 * MiB;
constexpr size_t WS_KR = 11 * MiB;
constexpr size_t WS_WIN = 14 * MiB;
constexpr size_t WS_WUQ = 26 * MiB;
constexpr size_t WS_WUKV = 26 * MiB + 512 * 1024;
constexpr size_t WS_WOA = 27 * MiB, WS_WOB = 28 * MiB, WS_WPW2 = 29 * MiB;
constexpr size_t WS_WOUT = 30 * MiB;
constexpr size_t WS_WGU = 32 * MiB;
constexpr size_t WS_WD = 96 * MiB;
constexpr size_t WS_X = 128 * MiB;
constexpr size_t WS_HB = 272 * MiB;
constexpr size_t WS_QB = 344 * MiB;
constexpr size_t WS_KVB = 398 * MiB;
constexpr size_t WS_U = 542 * MiB;
constexpr size_t WS_YA = 470 * MiB;
constexpr size_t WS_YB = 506 * MiB;
constexpr size_t WS_CQN = WS_YB, WS_CKVN = WS_YB + 18 * MiB;
constexpr size_t WS_R = 578 * MiB;
constexpr size_t WS_XG = WS_R, WS_HID = WS_R + 144 * MiB, WS_Y = WS_R + 288 * MiB;
constexpr size_t WS_YP = WS_R;
constexpr size_t WS_STAT = 13 * MiB + 512 * 1024;
constexpr size_t WS_WSET = 996 * MiB;
constexpr size_t WS_END = WS_R + 432 * MiB + 114 * MiB;

constexpr int RING_BYTES = 131072, LDSCTL_OFF = RING_BYTES, MISC_OFF = LDSCTL_OFF + 320, LIDX_OFF = RING_BYTES + 1024, LDS_BYTES = 147456;

#define LDS_WAIT() asm volatile("s_waitcnt lgkmcnt(0)" ::: "memory")
#define VM_WAIT() asm volatile("s_waitcnt vmcnt(0)" ::: "memory")
__device__ __forceinline__ int lane_id() { int r; asm volatile("v_mbcnt_lo_u32_b32 %0, -1, 0\n\tv_mbcnt_hi_u32_b32 %0, -1, %0" : "=v"(r)); return r; }
__device__ __forceinline__ unsigned f2bf(float f) { unsigned u = __builtin_bit_cast(unsigned, f); return (u + 0x7fffu + ((u >> 16) & 1u)) >> 16; }
__device__ __forceinline__ unsigned pk2(float lo, float hi) { unsigned r; asm("v_cvt_pk_bf16_f32 %0, %1, %2" : "=v"(r) : "v"(lo), "v"(hi)); return r; }
__device__ __forceinline__ float bflo(unsigned w) { return __uint_as_float(w << 16); }
__device__ __forceinline__ float bfhi(unsigned w) { return __uint_as_float(w & 0xffff0000u); }
__device__ __forceinline__ float bf2f(bf16 v) { return __uint_as_float(((unsigned)v) << 16); }
template <int O> __device__ __forceinline__ unsigned xshfl_u(unsigned v) {
    if constexpr (O == 32) { const auto t = __builtin_amdgcn_permlane32_swap(v, v, false, false); return (lane_id() & 32) ? t[0] : t[1]; }
    else return (unsigned)__builtin_amdgcn_ds_swizzle((int)v, (O << 10) | 0x1f);
}
template <int O> __device__ __forceinline__ float xshfl(float v) { return __uint_as_float(xshfl_u<O>(__float_as_uint(v))); }
template <int CTRL> __device__ __forceinline__ float dppf(float x) { return __builtin_bit_cast(float, __builtin_amdgcn_mov_dpp(__builtin_bit_cast(int, x), CTRL, 0xf, 0xf, true)); }
__device__ __forceinline__ float wave_sum(float x) {
    x += dppf<0xB1>(x); x += dppf<0x4E>(x); x += dppf<0x141>(x); x += dppf<0x128>(x);
    const auto s = __builtin_amdgcn_permlane16_swap(__float_as_uint(x), __float_as_uint(x), false, false); x = __uint_as_float(s[0]) + __uint_as_float(s[1]);
    const auto t = __builtin_amdgcn_permlane32_swap(__float_as_uint(x), __float_as_uint(x), false, false); return __uint_as_float(t[0]) + __uint_as_float(t[1]);
}
__device__ __forceinline__ float pair32_max(float x) { const auto t = __builtin_amdgcn_permlane32_swap(__float_as_uint(x), __float_as_uint(x), false, false); return fmaxf(__uint_as_float(t[0]), __uint_as_float(t[1])); }
__device__ __forceinline__ float pair32_sum(float x) { const auto t = __builtin_amdgcn_permlane32_swap(__float_as_uint(x), __float_as_uint(x), false, false); return __uint_as_float(t[0]) + __uint_as_float(t[1]); }
__device__ __forceinline__ float sigmoidf_(float x) { return 1.f / (1.f + __expf(-x)); }

namespace pg8 {
constexpr int BM = 256, BK = 64, HALF = 128, HTB = HALF * BK * 2, STAGE_BYTES = 8 * HTB, NXCD = 8, WGM = 8;
__host__ __device__ __forceinline__ int lds_byte(int r, int c) { const int st = (r >> 4) * 2 + (c >> 5), rr = r & 15, cc = c & 31, ob = rr * 64 + cc * 2; return st * 1024 + (ob ^ (((ob >> 9) & 1) << 5)); }
__host__ __device__ __forceinline__ void stage_rc(int b, int& R, int& C) { const int st = b / 1024, sb = b % 1024, swz = sb ^ (((sb >> 9) & 1) << 5); R = (st >> 1) * 16 + swz / 64; C = (st & 1) * 32 + (swz % 64) / 2; }

__host__ __device__ __forceinline__ int perm32(int rho) { const int n = rho >> 4, i = rho & 15; return 8 * (i >> 2) + 4 * n + (i & 3); }
struct Unit { int pm, pn, sg; };

template <int SEG> struct Order {
    int nM, nN, nwg, G, c, md;
    __device__ __forceinline__ void init(int nM_, int nN_, int G_, int c_, int md_ = 0) { nM = nM_; nN = nN_; nwg = nM * nN; G = G_; c = c_; md = md_; }
    __device__ __forceinline__ bool next(int i, Unit& u) const {
        const int it = i / SEG; u.sg = i - it * SEG;
        const long L = (long)it * G + c; if (L >= nwg) return false;
        int wgid = (int)L; { const int q = nwg / NXCD, r = nwg % NXCD, xcd = wgid % NXCD, off = wgid / NXCD; wgid = (xcd < r ? xcd * (q + 1) : r * (q + 1) + (xcd - r) * q) + off; }
        const int nig = WGM * nN, gid = wgid / nig, fm = gid * WGM, gsz = (nM - fm) < WGM ? (nM - fm) : WGM;
        u.pm = fm + ((wgid % nig) % gsz); u.pn = (wgid % nig) / gsz;
        if (md > 0) u.pm = (u.pm / md) * 18 + (u.pm % md);
        return true;
    }
};

template <class Prob, class Epi, class Sched>
__device__ __forceinline__ void gemm_phase(LAS unsigned char* lds, const Prob& P, const Sched& S, const Epi& E, int wid) {
    int lane_ = lane_id(); asm volatile("" : "+v"(lane_));
    const int lane = lane_, tid = wid * 64 + lane, wr = wid >> 2, wc = wid & 3, fr = lane & 15, fq = lane >> 4;
    const int K = P.K, nt = K / BK;
    unsigned voffA[2][2], voffN[2][2], voffB[2]; int stR[2], stC[2];
#pragma unroll
    for (int i = 0; i < 2; ++i) { stage_rc(tid * 16 + i * 8192, stR[i], stC[i]); const int Rb = (stR[i] & ~31) + perm32(stR[i] & 31); voffB[i] = (unsigned)(Rb * P.ldb + stC[i]) * 2u; }
    const size_t kstep = (size_t)(BK * 2);
    const size_t hstepB = (size_t)HALF * P.ldb * 2;
#define PG8_AOFF(dst, u) do { _Pragma("unroll") for (int h_ = 0; h_ < 2; ++h_) _Pragma("unroll") for (int i_ = 0; i_ < 2; ++i_) \
        dst[h_][i_] = (unsigned)(P.arow(u, h_ * HALF + stR[i_]) * P.lda + stC[i_]) * 2u; } while (0)
    const unsigned ldsw = (unsigned)wid * 1024u;
    const int aoff = lds_byte(wr * 64 + fr, fq * 8), boff = lds_byte(wc * 32 + fr, fq * 8);
#define PG8_SA(b, h) (((b) * 2 + (h)) * HTB)
#define PG8_SB(b, h) ((4 + (b) * 2 + (h)) * HTB)
#define PG8_STAGE(bufoff, gbase, voff) do { _Pragma("unroll") for (int _i = 0; _i < 2; ++_i) \
        __builtin_amdgcn_global_load_lds((const unsigned*)((const char*)(gbase) + (voff)[_i]), (LAS unsigned*)(lds + (bufoff) + ldsw + _i * 8192), 16, 0, 0); } while (0)
#define PG8_LDA(dst, b, h) do { _Pragma("unroll") for (int m = 0; m < 4; ++m) _Pragma("unroll") for (int k = 0; k < 2; ++k) dst[m][k] = *(const LAS bf16x8*)(lds + PG8_SA(b, h) + aoff + m * 2048 + k * 1024); } while (0)
#define PG8_LDB(dst, b, h) do { _Pragma("unroll") for (int n = 0; n < 2; ++n) _Pragma("unroll") for (int k = 0; k < 2; ++k) dst[n][k] = *(const LAS bf16x8*)(lds + PG8_SB(b, h) + boff + n * 2048 + k * 1024); } while (0)
#define PG8_MMA(ai, bj, At, Bt) do { __builtin_amdgcn_s_setprio(1); _Pragma("unroll") for (int m = 0; m < 4; ++m) _Pragma("unroll") for (int n = 0; n < 2; ++n) _Pragma("unroll") for (int k = 0; k < 2; ++k) \
        acc[ai][bj][m][n] = __builtin_amdgcn_mfma_f32_16x16x32_bf16(Bt[n][k], At[m][k], acc[ai][bj][m][n], 0, 0, 0); __builtin_amdgcn_s_setprio(0); } while (0)
#define PG8_WAIT_V(n) asm volatile("s_waitcnt vmcnt(" #n ")" ::: "memory")
#define PG8_WAIT_L(n) asm volatile("s_waitcnt lgkmcnt(" #n ")" ::: "memory")
#define PG8_BAR __builtin_amdgcn_s_barrier()
#define PG8_SCHED __builtin_amdgcn_sched_barrier(0)
    Unit cur, nxt; int ui = 0;
    if (!S.next(0, cur)) return;
    f32x4 acc[2][2][4][2];
#pragma unroll
    for (int a = 0; a < 2; ++a)
#pragma unroll
        for (int b = 0; b < 2; ++b)
#pragma unroll
            for (int m = 0; m < 4; ++m)
#pragma unroll
                for (int n = 0; n < 2; ++n) acc[a][b][m][n] = (f32x4){0.f, 0.f, 0.f, 0.f};
    bf16x8 At[4][2], B0[2][2], B1[2][2];
    const char* cA = P.ap(cur); const char* cB = P.bp(cur);
    PG8_AOFF(voffA, cur);
    PG8_STAGE(PG8_SB(0, 0), cB, voffB); PG8_STAGE(PG8_SB(0, 1), cB + hstepB, voffB); PG8_STAGE(PG8_SA(0, 0), cA, voffA[0]); PG8_STAGE(PG8_SA(0, 1), cA, voffA[1]);
    if (wr == 1) PG8_BAR;
    PG8_WAIT_V(2); PG8_BAR;
    PG8_STAGE(PG8_SB(1, 0), cB + kstep, voffB); PG8_STAGE(PG8_SA(1, 0), cA + kstep, voffA[0]); PG8_STAGE(PG8_SB(1, 1), cB + hstepB + kstep, voffB);
    PG8_WAIT_V(6); PG8_BAR;
    for (;;) {
        const bool has_next = S.next(ui + 1, nxt);
        const char* nA = has_next ? P.ap(nxt) : cA; const char* nB = has_next ? P.bp(nxt) : cB;
        if constexpr (Prob::GATHER) { if (has_next) PG8_AOFF(voffN, nxt); else { _Pragma("unroll") for (int h_ = 0; h_ < 2; ++h_) _Pragma("unroll") for (int i_ = 0; i_ < 2; ++i_) voffN[h_][i_] = voffA[h_][i_]; } }
        for (int t = 0; t < nt; t += 2) {
            const bool last = (t == nt - 2);
            const char* a1 = cA + (size_t)(t + 1) * kstep;
            const char* a2 = last ? nA : cA + (size_t)(t + 2) * kstep; const char* b2 = last ? nB : cB + (size_t)(t + 2) * kstep;
            const char* a3 = a2 + kstep; const char* b3 = b2 + kstep;
            unsigned vo2[2][2];
#pragma unroll
            for (int h_ = 0; h_ < 2; ++h_)
#pragma unroll
                for (int i_ = 0; i_ < 2; ++i_) vo2[h_][i_] = (Prob::GATHER && last) ? voffN[h_][i_] : voffA[h_][i_];
            PG8_LDB(B0, 0, 0); PG8_LDB(B1, 0, 1); PG8_SCHED; PG8_LDA(At, 0, 0); PG8_STAGE(PG8_SA(1, 1), a1, voffA[1]);
            PG8_WAIT_V(8); PG8_WAIT_L(0); PG8_BAR; PG8_MMA(0, 0, At, B0); PG8_MMA(0, 1, At, B1); PG8_BAR; PG8_SCHED;
            PG8_LDA(At, 0, 1); PG8_STAGE(PG8_SB(0, 0), b2, voffB); PG8_STAGE(PG8_SB(0, 1), b2 + hstepB, voffB); PG8_STAGE(PG8_SA(0, 0), a2, vo2[0]);
            PG8_WAIT_V(8); PG8_WAIT_L(0); PG8_BAR; PG8_MMA(1, 0, At, B0); PG8_MMA(1, 1, At, B1); PG8_BAR; PG8_SCHED;
            PG8_LDB(B0, 1, 0); PG8_LDB(B1, 1, 1); PG8_SCHED; PG8_LDA(At, 1, 0); PG8_STAGE(PG8_SA(0, 1), a2, vo2[1]);
            PG8_WAIT_V(8); PG8_WAIT_L(0); PG8_BAR; PG8_MMA(0, 0, At, B0); PG8_MMA(0, 1, At, B1); PG8_BAR; PG8_SCHED;
            PG8_LDA(At, 1, 1); PG8_STAGE(PG8_SB(1, 0), b3, voffB); PG8_STAGE(PG8_SB(1, 1), b3 + hstepB, voffB); PG8_STAGE(PG8_SA(1, 0), a3, vo2[0]);
            PG8_WAIT_V(8); PG8_WAIT_L(0); PG8_BAR; PG8_MMA(1, 0, At, B0); PG8_MMA(1, 1, At, B1); PG8_BAR; PG8_SCHED;
        }
        if (wr == 0) PG8_BAR;
        const bool z = E(acc, cur, wr, wc, fr, fq);
        if (!has_next) break;
        if (z) {
#pragma unroll
            for (int a = 0; a < 2; ++a)
#pragma unroll
                for (int b = 0; b < 2; ++b)
#pragma unroll
                    for (int m = 0; m < 4; ++m)
#pragma unroll
                        for (int n = 0; n < 2; ++n) acc[a][b][m][n] = (f32x4){0.f, 0.f, 0.f, 0.f};
        }
        cur = nxt; cA = nA; cB = nB; ++ui;
        if constexpr (Prob::GATHER) { _Pragma("unroll") for (int h_ = 0; h_ < 2; ++h_) _Pragma("unroll") for (int i_ = 0; i_ < 2; ++i_) voffA[h_][i_] = voffN[h_][i_]; }
        if (wr == 1) PG8_BAR;
    }
    PG8_WAIT_V(0);
    PG8_BAR;
#undef PG8_AOFF
#undef PG8_SA
#undef PG8_SB
#undef PG8_STAGE
#undef PG8_LDA
#undef PG8_LDB
#undef PG8_MMA
#undef PG8_WAIT_V
#undef PG8_WAIT_L
#undef PG8_BAR
#undef PG8_SCHED
}

struct ProbPlain { static constexpr bool GATHER = false; const bf16* A; const bf16* B; int K, lda, ldb;
    __device__ __forceinline__ const char* ap(const Unit& u) const { return (const char*)(A + (size_t)u.pm * 256 * lda); }
    __device__ __forceinline__ int arow(const Unit&, int rr) const { return rr; }
    __device__ __forceinline__ const char* bp(const Unit& u) const { return (const char*)(B + (size_t)u.pn * 256 * ldb); } };
struct ProbSeg3 { static constexpr bool GATHER = false; const bf16* A; const bf16* B; int K, lda, ldb; size_t sA, sB;
    __device__ __forceinline__ const char* ap(const Unit& u) const { return (const char*)(A + (size_t)u.sg * sA + (size_t)u.pm * 256 * lda); }
    __device__ __forceinline__ int arow(const Unit&, int rr) const { return rr; }
    __device__ __forceinline__ const char* bp(const Unit& u) const { return (const char*)(B + (size_t)u.sg * sB + (size_t)u.pn * 256 * ldb); } };
struct ProbUp2 { static constexpr bool GATHER = false; const bf16* A0; const bf16* A1; const bf16* B0; const bf16* B1; int K, lda, ldb;
    __device__ __forceinline__ const char* ap(const Unit& u) const { return (const char*)((u.sg ? A1 : A0) + (size_t)u.pm * 256 * lda); }
    __device__ __forceinline__ int arow(const Unit&, int rr) const { return rr; }
    __device__ __forceinline__ const char* bp(const Unit& u) const { return (const char*)((u.sg ? B1 : B0) + (size_t)u.pn * 256 * ldb); } };
struct OrderUp2 { int n0, nwg, G, c, nM0;
    __device__ __forceinline__ void init(int nM0_, int G_, int c_) { nM0 = nM0_; n0 = nM0_ * 3; nwg = n0 + (MT / 256) * 4; G = G_; c = c_; }
    __device__ __forceinline__ bool next(int i, Unit& u) const { const int L = i * G + c; if (L >= nwg) return false;
        if (L < n0) { u.sg = 0; u.pm = L / 3; u.pn = L - u.pm * 3; } else { const int r = L - n0; u.sg = 1; u.pm = r >> 2; u.pn = r & 3; } return true; } };
struct OrderWinLast { int G, c;
    __device__ __forceinline__ void init(int G_, int c_) { G = G_; c = c_; }
    __device__ __forceinline__ bool next(int i, Unit& u) const { const int L = i * G + c; u.sg = 0; if (L >= 128 * 24 + 16 * 5) return false;
        if (L < 128 * 24) { const int g = L / (8 * 24), q = L - g * 8 * 24; u.pm = g * 8 + (q & 7); u.pn = q >> 3; }
        else { const int r = L - 128 * 24, t = r % 5; u.pm = 128 + r / 5; u.pn = t < 4 ? 2 + t : 7; } return true; } };
struct ProbMoE { static constexpr bool GATHER = false; const bf16* A; const bf16* B; int K, lda, ldb; int nrowsB;
    __device__ __forceinline__ const char* ap(const Unit& u) const { return (const char*)(A + (size_t)u.pm * 256 * lda); }
    __device__ __forceinline__ int arow(const Unit&, int rr) const { return rr; }
    __device__ __forceinline__ const char* bp(const Unit& u) const { return (const char*)(B + ((size_t)(u.pm / 18) * nrowsB + (size_t)u.pn * 256) * ldb); } };
struct ProbMoEGather { static constexpr bool GATHER = true; const bf16* A; const bf16* B; const LAS int* lidx; int K, lda, ldb; int nrowsB;
    __device__ __forceinline__ const char* ap(const Unit&) const { return (const char*)A; }
    __device__ __forceinline__ int arow(const Unit& u, int rr) const { return lidx[u.sg * 256 + rr]; }
    __device__ __forceinline__ const char* bp(const Unit& u) const { return (const char*)(B + ((size_t)(u.pm / 18) * nrowsB + (size_t)u.pn * 256) * ldb); } };
struct OrderOrd { Order<1> o;
    __device__ __forceinline__ bool next(int i, Unit& u) const { const bool r = o.next(i, u); u.sg = i; return r; } };

#define EPI_ROWS(...) _Pragma("unroll") for (int ai = 0; ai < 2; ++ai) _Pragma("unroll") for (int m = 0; m < 4; ++m) { const int row = u.pm * 256 + ai * 128 + wr * 64 + m * 16 + fr; __VA_ARGS__ }
#define EPI_COLS8(...) _Pragma("unroll") for (int bj = 0; bj < 2; ++bj) { const int col = u.pn * 256 + bj * 128 + wc * 32 + 8 * fq; __VA_ARGS__ }
#define EPI_LANE() int t_ = lane_id(); asm volatile("" : "+v"(t_)); const int fr = t_ & 15, fq = t_ >> 4
__device__ __forceinline__ v4u pack8(const f32x4& a, const f32x4& b) { v4u w; w.x = pk2(a[0], a[1]); w.y = pk2(a[2], a[3]); w.z = pk2(b[0], b[1]); w.w = pk2(b[2], b[3]); return w; }
__device__ __forceinline__ f32x4 unpack4(v2u w) { return (f32x4){bflo(w.x), bfhi(w.x), bflo(w.y), bfhi(w.y)}; }
struct EpiBf16 { bf16* O; int ldc;
    __device__ __forceinline__ bool operator()(f32x4 (&acc)[2][2][4][2], const Unit& u, int wr, int wc, int fr_, int fq_) const {
        EPI_LANE();
        EPI_ROWS( bf16* rp = O + (size_t)row * ldc; EPI_COLS8( *(v4u*)(rp + col) = pack8(acc[ai][bj][m][0], acc[ai][bj][m][1]); ) )
        return true; } };
__device__ __forceinline__ f32x4 sigmoid4(const f32x4& v) { return (f32x4){__builtin_amdgcn_rcpf(1.f + __expf(-v[0])), __builtin_amdgcn_rcpf(1.f + __expf(-v[1])), __builtin_amdgcn_rcpf(1.f + __expf(-v[2])), __builtin_amdgcn_rcpf(1.f + __expf(-v[3]))}; }
struct EpiUp2 { bf16* O0; bf16* O1;
    __device__ __forceinline__ bool operator()(f32x4 (&acc)[2][2][4][2], const Unit& u, int wr, int wc, int fr_, int fq_) const {
        EPI_LANE();
        bf16* O = u.sg ? O1 : O0; const int ldc = u.sg ? 1024 : 768;
        EPI_ROWS( bf16* rp = O + (size_t)row * ldc; EPI_COLS8( *(v4u*)(rp + col) = pack8(acc[ai][bj][m][0], acc[ai][bj][m][1]); ) )
        return true; } };
struct EpiWin { bf16* O;
    __device__ __forceinline__ bool operator()(f32x4 (&acc)[2][2][4][2], const Unit& u, int wr, int wc, int fr_, int fq_) const {
        EPI_LANE();
        const bool sg = u.pn >= 10;
        EPI_ROWS( bf16* rp = O + (size_t)row * NP; EPI_COLS8( f32x4 v0 = acc[ai][bj][m][0], v1 = acc[ai][bj][m][1];
            if (sg) { v0 = sigmoid4(v0); v1 = sigmoid4(v1); }
            *(v4u*)(rp + col) = pack8(v0, v1); ) )
        return true; } };
__device__ __forceinline__ f32x4 gate_ratio(v2u a, v2u b, bool fin) { const f32x4 x = unpack4(a), y = unpack4(b);
    return (f32x4){x[0] * (fin ? 1.f : __builtin_amdgcn_rcpf(fmaxf(y[0], 1e-20f))), x[1] * (fin ? 1.f : __builtin_amdgcn_rcpf(fmaxf(y[1], 1e-20f))), x[2] * (fin ? 1.f : __builtin_amdgcn_rcpf(fmaxf(y[2], 1e-20f))), x[3] * (fin ? 1.f : __builtin_amdgcn_rcpf(fmaxf(y[3], 1e-20f)))}; }
struct EpiMerge { const bf16* PROJ; bf16* O;
    __device__ __forceinline__ bool operator()(f32x4 (&acc)[2][2][4][2], const Unit& u, int wr, int wc, int fr_, int fq_) const {
        EPI_LANE();
        const int sg = u.sg; const bool fin = sg == 2; const int sgb = fin ? 2 : sg + 1;
        _Pragma("unroll") for (int ai = 0; ai < 2; ++ai) {
            _Pragma("unroll") for (int m = 0; m < 4; ++m) { const int row = u.pm * 256 + ai * 128 + wr * 64 + m * 16 + fr;
                const bf16* gp = PROJ + (size_t)row * NP + C_GT; bf16* rp = O + (size_t)row * DM;
                EPI_COLS8( const v4u ga = *(const v4u*)(gp + sg * 1024 + col), gb = *(const v4u*)(gp + sgb * 1024 + col);
                    const f32x4 v0 = acc[ai][bj][m][0] * gate_ratio((v2u){ga.x, ga.y}, (v2u){gb.x, gb.y}, fin), v1 = acc[ai][bj][m][1] * gate_ratio((v2u){ga.z, ga.w}, (v2u){gb.z, gb.w}, fin);
                    acc[ai][bj][m][0] = v0; acc[ai][bj][m][1] = v1;
                    if (fin) *(v4u*)(rp + col) = pack8(v0, v1); ) }
            asm volatile("" ::: "memory"); }
        return fin; } };
struct EpiSwiGLU { bf16* HID;
    __device__ __forceinline__ bool operator()(f32x4 (&acc)[2][2][4][2], const Unit& u, int wr, int wc, int fr_, int fq_) const {
        EPI_LANE();
        EPI_ROWS( bf16* rp = HID + (size_t)row * 1024 + u.pn * 128 + wc * 32 + 8 * fq; f32x4 h[2];
            _Pragma("unroll") for (int n = 0; n < 2; ++n) { const f32x4 g = acc[ai][0][m][n], up = acc[ai][1][m][n];
                h[n] = (f32x4){g[0] * __builtin_amdgcn_rcpf(1.f + __expf(-g[0])) * up[0], g[1] * __builtin_amdgcn_rcpf(1.f + __expf(-g[1])) * up[1], g[2] * __builtin_amdgcn_rcpf(1.f + __expf(-g[2])) * up[2], g[3] * __builtin_amdgcn_rcpf(1.f + __expf(-g[3])) * up[3]}; }
            *(v4u*)rp = pack8(h[0], h[1]); )
        return true; } };
}

#define XB_TMO      128
#define XB_XCNT(j)  (256  + 64 * (j))
#define XB_XSUB(j)  (1280 + 64 * (j))
#define XB_XGEN(j)  (2304 + 64 * (j))
#define XB_TOP      3328
#define XB_TOPGEN   3392
#define XCD_BAR_WORDS 3456
#define XB_SPIN_CAP (1u << 22)
__device__ __forceinline__ unsigned xb_ld(unsigned* p)              { return __hip_atomic_load(p, __ATOMIC_RELAXED, __HIP_MEMORY_SCOPE_AGENT); }
__device__ __forceinline__ unsigned xb_add(unsigned* p, unsigned v) { return __hip_atomic_fetch_add(p, v, __ATOMIC_RELAXED, __HIP_MEMORY_SCOPE_AGENT); }
__device__ __forceinline__ unsigned xb_xcc_id() { return (unsigned)__builtin_amdgcn_s_getreg((3 << 11) | 20) & 0xFu; }
#define XB_SPIN(cond, bar) do { unsigned _sp = 0; while (cond) { __builtin_amdgcn_s_sleep(1); \
    if ((++_sp & 255u) == 0u) { if (xb_ld(&(bar)[XB_TMO])) break; if (_sp > XB_SPIN_CAP) { atomicAdd(&(bar)[XB_TMO], 1u); break; } } } } while (0)
struct XcdBarrier { unsigned* bar; unsigned x; volatile LAS unsigned* st; int wv; };
__device__ __forceinline__ XcdBarrier xcd_barrier_post(unsigned* bar, volatile LAS unsigned* st, int wv) {
    XcdBarrier b; b.bar = bar; b.x = xb_xcc_id(); b.st = st; b.wv = wv;
    if (wv == 0 && lane_id() == 0) (void)xb_add(&bar[XB_XCNT(b.x)], 1u);
    return b;
}
__device__ __forceinline__ void xcd_barrier_complete(unsigned* bar, unsigned x, unsigned& nloc, unsigned& nx) {
    const unsigned G = gridDim.x * gridDim.y * gridDim.z;
    unsigned sum, cnt, mine, sp = 0u;
    for (;;) {
        sum = 0u; cnt = 0u; mine = 0u;
#pragma unroll
        for (unsigned j = 0; j < 16; ++j) { const unsigned c = xb_ld(&bar[XB_XCNT(j)]); sum += c; cnt += (c > 0u) ? 1u : 0u; mine = (j == x) ? c : mine; }
        if (sum == G) break;
        __builtin_amdgcn_s_sleep(1);
        if ((++sp & 255u) == 0u) { if (xb_ld(&bar[XB_TMO])) break; if (sp > XB_SPIN_CAP) { atomicAdd(&bar[XB_TMO], 1u); break; } }
    }
    nloc = mine > 0u ? mine : 1u; nx = cnt > 0u ? cnt : 1u;
}
__device__ __forceinline__ void xcd_barrier(const XcdBarrier& b) {
    asm volatile("s_waitcnt vmcnt(0)" ::: "memory");
    __syncthreads();
    if (b.wv == 0 && lane_id() == 0) {
        unsigned* bar = b.bar; unsigned bx_ = b.x; asm volatile("" : "+s"(bx_)); asm volatile("" : "+s"(bar));
        __builtin_amdgcn_s_waitcnt(0);
        unsigned nloc = b.st[0], nx = b.st[1];
        if (nloc == 0u) { xcd_barrier_complete(bar, bx_, nloc, nx); b.st[0] = nloc; b.st[1] = nx; }
        const unsigned old = xb_add(&bar[XB_XSUB(bx_)], 1u);
        const unsigned gen = old / nloc;
        if (old + 1u == (gen + 1u) * nloc) {
            __builtin_amdgcn_fence(__ATOMIC_RELEASE, "agent");
            asm volatile("s_waitcnt vmcnt(0)" ::: "memory");
            const unsigned og = xb_add(&bar[XB_TOP], 1u);
            const unsigned tg = og / nx;
            if (og + 1u == (tg + 1u) * nx) xb_add(&bar[XB_TOPGEN], 1u);
            else XB_SPIN(xb_ld(&bar[XB_TOPGEN]) == tg, bar);
            __builtin_amdgcn_fence(__ATOMIC_ACQUIRE, "agent");
            xb_add(&bar[XB_XGEN(bx_)], 1u);
            asm volatile("s_waitcnt vmcnt(0)" ::: "memory");
        } else {
            XB_SPIN(xb_ld(&bar[XB_XGEN(bx_)]) == gen, bar);
            __builtin_amdgcn_fence(__ATOMIC_ACQUIRE, "agent");
            asm volatile("s_waitcnt vmcnt(0)" ::: "memory");
        }
    }
    __syncthreads();
}

struct Args { const float* in[28]; float* out; unsigned char* ws; };
enum { I_X = 0, I_C, I_CTX, I_CCTX, I_WADA, I_BADA, I_WIN, I_GQ, I_WUQ, I_GKV, I_WUKV, I_RPB, I_WDW, I_BDW, I_GCN, I_BCN, I_WPW2, I_WOA, I_WOB, I_WOUT, I_LN1G, I_LN1B, I_WROUTER, I_WGATE, I_WUP, I_WDOWN, I_LN2G, I_LN2B };

#define OPAQUE(v) asm volatile("" : "+v"(v))
struct Ctx {
    LAS unsigned char* lds;
    int tid, lane, wave, G, bid;
    const float* const* in;
    unsigned char* ws;
    float* out;
};
#define INP(i) ((const float*)(const GAS float*)C.in[i])
#define WSP(T, off) ((T*)(C.ws + (off)))
#define WSW(T, off, l) ((T*)(C.ws + (off) + (size_t)((l) & 1) * WS_WSET))

struct CwD { const float* src; bf16* db; int N, ld, kind, add, n0; };
__device__ __forceinline__ void cw_decode(const Ctx& C, int l, int it, CwD& d) {
    constexpr int I_IN = 16 * 189, I_UQ = 4 * 24, I_UKV = 2 * 32, I_PW = 8 * 32, I_OUT = 16 * 32, I_EX = 16 * 32;
    int r = it; d.kind = 0; d.add = 0;
    if (r < I_IN) { const int kb = r / 189, nb = r % 189; d.src = INP(I_WIN) + (size_t)l * 1024 * 6048 + (size_t)(kb * 64) * 6048 + nb * 32; d.N = 6048; d.db = WSW(bf16, WS_WIN, l) + kb * 64; d.ld = 1024; d.kind = 1; d.n0 = nb * 32; return; } r -= I_IN;
    if (r < I_UQ) { const int kb = r / 24, nb = r % 24; d.src = INP(I_WUQ) + (size_t)l * 256 * 768 + (size_t)(kb * 64) * 768 + nb * 32; d.N = 768; d.db = WSW(bf16, WS_WUQ, l) + kb * 64; d.ld = 256; d.n0 = nb * 32; return; } r -= I_UQ;
    if (r < I_UKV) { const int kb = r / 32, nb = r % 32; d.src = INP(I_WUKV) + (size_t)l * 128 * 1024 + (size_t)(kb * 64) * 1024 + nb * 32; d.N = 1024; d.db = WSW(bf16, WS_WUKV, l) + kb * 64; d.ld = 256; d.n0 = nb * 32; return; } r -= I_UKV;
    if (r < 3 * I_PW) { const int w = r / I_PW, q = r % I_PW, kb = q / 32, nb = q % 32;
        d.src = (w == 0 ? INP(I_WPW2) : (w == 1 ? INP(I_WOA) : INP(I_WOB))) + (size_t)l * 512 * 1024 + (size_t)(kb * 64) * 1024 + nb * 32; d.N = 1024;
        d.db = WSW(bf16, w == 0 ? WS_WPW2 : (w == 1 ? WS_WOA : WS_WOB), l) + kb * 64; d.ld = 512; d.n0 = nb * 32; return; } r -= 3 * I_PW;
    if (r < I_OUT) { const int kb = r / 32, nb = r % 32; d.src = INP(I_WOUT) + (size_t)l * 1024 * 1024 + (size_t)(kb * 64) * 1024 + nb * 32; d.N = 1024; d.db = WSW(bf16, WS_WOUT, l) + kb * 64; d.ld = 1024; d.n0 = nb * 32; return; } r -= I_OUT;
    { const int mat = r / I_EX, q = r % I_EX, kb = q / 32, nb = q % 32, w = mat / 16, e = mat % 16;
      d.src = (w == 0 ? INP(I_WGATE) : (w == 1 ? INP(I_WUP) : INP(I_WDOWN))) + ((size_t)l * 16 + e) * 1024 * 1024 + (size_t)(kb * 64) * 1024 + nb * 32; d.N = 1024; d.ld = 1024; d.n0 = nb * 32;
      if (w < 2) { d.db = WSW(bf16, WS_WGU, l) + (size_t)e * 2048 * 1024 + kb * 64; d.kind = 2; d.add = w * 128; }
      else d.db = WSW(bf16, WS_WD, l) + (size_t)e * 1024 * 1024 + kb * 64; }
}
__device__ __forceinline__ void cw_load(const CwD& d, int lane, f32x4 (&v)[8]) {
#pragma unroll
    for (int i = 0; i < 8; ++i) { const int kk = 8 * i + (lane >> 3), nn = (lane & 7) * 4; v[i] = __builtin_nontemporal_load((const f32x4*)(d.src + (size_t)kk * d.N + nn)); }
}
__device__ __forceinline__ void cw_store(const CwD& d, const f32x4 (&v)[8], LAS float* scr, int lane) {
#pragma unroll
    for (int i = 0; i < 8; ++i) { const int kk = 8 * i + (lane >> 3), nn = (lane & 7) * 4;
        scr[kk * 33 + nn] = v[i][0]; scr[kk * 33 + nn + 1] = v[i][1]; scr[kk * 33 + nn + 2] = v[i][2]; scr[kk * 33 + nn + 3] = v[i][3]; }
    LDS_WAIT(); asm volatile("" ::: "memory");
    const int c = lane & 7;
#pragma unroll
    for (int j = 0; j < 4; ++j) { const int nl = (lane >> 3) + 8 * j; const LAS float* s = scr + (8 * c) * 33 + nl;
        v4u o; o.x = pk2(s[0 * 33], s[1 * 33]); o.y = pk2(s[2 * 33], s[3 * 33]); o.z = pk2(s[4 * 33], s[5 * 33]); o.w = pk2(s[6 * 33], s[7 * 33]);
        const int n = d.n0 + nl; int row = n; if (d.kind == 1) row = n < 1952 ? n : n + 96; if (d.kind == 2) row = (n >> 7) * 256 + (n & 127) + d.add;
        __builtin_nontemporal_store(o, (v4u*)(d.db + (size_t)row * d.ld + 8 * c)); }
    LDS_WAIT(); asm volatile("" ::: "memory");
}

__device__ __forceinline__ void conv_weights(const Ctx& Cc, int l, int f0, int f1, int wg0, int nwg) {
    Ctx C = Cc; C.lane = lane_id(); C.tid = C.wave * 64 + C.lane;
    LAS float* scr = (LAS float*)(C.lds + C.wave * 16384);
    if (C.bid < wg0) return;
    const int gw = (C.bid - wg0) * NWAVES + C.wave, NGW = nwg * NWAVES;
    constexpr int NITEMS = 16 * 189 + 4 * 24 + 2 * 32 + 3 * 8 * 32 + 16 * 32 + 48 * 16 * 32;
    bf16* WinT = WSW(bf16, WS_WIN, l);
    const int it0 = (int)((long)NITEMS * f0 / 100), it1 = (int)((long)NITEMS * f1 / 100);
    {
        CwD cur, nxt; f32x4 buf[8]; int it = it0 + gw;
        if (it < it1) { cw_decode(C, l, it, cur); cw_load(cur, C.lane, buf); }
        for (; it < it1; it += NGW) {
            f32x4 v[8];
#pragma unroll
            for (int i = 0; i < 8; ++i) v[i] = buf[i];
            const bool more = it + NGW < it1;
            if (more) { cw_decode(C, l, it + NGW, nxt); cw_load(nxt, C.lane, buf); }
            cw_store(cur, v, scr, C.lane);
            if (more) cur = nxt;
        }
    }
    if (f0 != 0) return;
    const int gt = (C.bid - wg0) * NTHREADS + C.tid, NGT = nwg * NTHREADS;
    unsigned zz_ = 0u; asm volatile("" : "+v"(zz_)); const v4u z = (v4u){zz_, zz_, zz_, zz_};
    for (int i = gt; i < 96 * 128; i += NGT) *((v4u*)(WinT + (size_t)1952 * 1024) + i) = z;
    for (int i = gt; i < 1024 * 16; i += NGT) { const int n = i >> 4, c = i & 15; *((v4u*)(WSW(bf16, WS_WUKV, l) + (size_t)n * 256 + 128) + c) = z; }
}

__device__ __forceinline__ void phase_mods(const Ctx& Cc) {
    Ctx C = Cc; OPAQUE(C.lane); OPAQUE(C.tid);
    LAS float* sc = (LAS float*)C.lds;
    LAS float* red = (LAS float*)(C.lds + 69632);
    for (int idx = C.tid; idx < 17 * 1024; idx += NTHREADS) { const int r = idx >> 10, k = idx & 1023; const float v = r < 16 ? INP(I_C)[r * 1024 + k] : INP(I_CCTX)[k]; sc[idx] = v / (1.f + __expf(-v)); }
    __syncthreads();
    float* MODS = WSP(float, WS_MODS);
    for (int item = C.bid; item < NL * 96; item += C.G) {
        const int l = item / 96, cb = item % 96, col = cb * 64 + C.lane;
        const float* W = INP(I_WADA) + (size_t)l * 1024 * 6144;
        float acc[17];
#pragma unroll
        for (int r = 0; r < 17; ++r) acc[r] = 0.f;
        for (int k = C.wave * 128; k < C.wave * 128 + 128; k += 4) { const float w0 = W[(size_t)k * 6144 + col], w1 = W[(size_t)(k + 1) * 6144 + col], w2 = W[(size_t)(k + 2) * 6144 + col], w3 = W[(size_t)(k + 3) * 6144 + col];
#pragma unroll
            for (int r = 0; r < 17; ++r) { const f32x4 sv = *(const LAS f32x4*)(sc + r * 1024 + k); acc[r] += (sv[0] * w0 + sv[1] * w1) + (sv[2] * w2 + sv[3] * w3); } }
#pragma unroll
        for (int r = 0; r < 17; ++r) red[(C.wave * 17 + r) * 64 + C.lane] = acc[r];
        __syncthreads();
        for (int o = C.tid; o < 17 * 64; o += NTHREADS) { const int r = o >> 6, cl = o & 63; float s = INP(I_BADA)[l * 6144 + cb * 64 + cl];
#pragma unroll
            for (int w = 0; w < 8; ++w) s += red[(w * 17 + r) * 64 + cl];
            MODS[((size_t)l * 17 + r) * 6144 + cb * 64 + cl] = s; }
        __syncthreads();
    }
    float* TAB = WSP(float, WS_TAB);
    const int gt = C.bid * NTHREADS + C.tid, NGT = C.G * NTHREADS;
    for (int idx = gt; idx < 2048 * 16; idx += NGT) { const int t = idx >> 4, j = idx & 15, which = j >> 3, i = j & 7;
        const float pos = (float)(which ? (t & 63) : (t >> 6)), invf = exp2f(-(float)i * (13.287712379549449f / 8.f)), ang = pos * invf;
        TAB[t * 32 + which * 16 + i] = __cosf(ang); TAB[t * 32 + which * 16 + 8 + i] = __sinf(ang); }
}

__device__ __forceinline__ void phase_mod0(const Ctx& Cc) {
    Ctx C = Cc; OPAQUE(C.lane);
    const int gw = C.bid * NWAVES + C.wave, NGW = C.G * NWAVES;
    const float* MODS = WSP(float, WS_MODS); float* X = WSP(float, WS_X); bf16* H = WSP(bf16, WS_HB);
    for (int row = gw; row < MT; row += NGW) {
        const float* src = row < ML ? INP(I_X) + (size_t)row * DM : INP(I_CTX) + (size_t)(row - ML) * DM;
        const int mr = row < ML ? (row >> 11) : 16; const float* md = MODS + (size_t)mr * 6144;
#pragma unroll
        for (int j = 0; j < 2; ++j) { const int c0 = 8 * (C.lane + 64 * j); f32x4 h[2];
#pragma unroll
            for (int q = 0; q < 2; ++q) { const int c = c0 + 4 * q; const f32x4 xv = *(const f32x4*)(src + c), sh = *(const f32x4*)(md + c), scl = *(const f32x4*)(md + 1024 + c);
                h[q] = xv * (scl + 1.f) + sh; }
            *(v4u*)(H + (size_t)row * DM + c0) = pg8::pack8(h[0], h[1]); }
    }
}

__device__ __forceinline__ void phase_prep(const Ctx& C, int l) {
    int lane = C.lane; OPAQUE(lane); const int gw = C.bid * NWAVES + C.wave, NGW = C.G * NWAVES;
    const bf16* PROJ = WSP(bf16, WS_R); bf16* CQN = WSP(bf16, WS_CQN); bf16* CKVN = WSP(bf16, WS_CKVN); bf16* KR = WSP(bf16, WS_KR);
    const float* TAB = WSP(float, WS_TAB);
    const f32x4 gq = *(const f32x4*)(INP(I_GQ) + l * 256 + 4 * lane); const f32x2 gkv = *(const f32x2*)(INP(I_GKV) + l * 128 + 2 * lane);
    for (int row = gw; row < MT; row += NGW) {
        const bf16* p = PROJ + (size_t)row * NP;
        { const v2u w = *(const v2u*)(p + C_CQ + 4 * lane); const float x0 = bflo(w.x), x1 = bfhi(w.x), x2 = bflo(w.y), x3 = bfhi(w.y);
          const float ss = wave_sum(x0 * x0 + x1 * x1 + x2 * x2 + x3 * x3), r = 1.f / sqrtf(ss * (1.f / 256.f) + RMS_EPS);
          v2u o; o.x = pk2(x0 * r * gq[0], x1 * r * gq[1]); o.y = pk2(x2 * r * gq[2], x3 * r * gq[3]); *(v2u*)(CQN + (size_t)row * 256 + 4 * lane) = o; }
        { const unsigned w = *(const unsigned*)(p + C_CKV + 2 * lane); const float x0 = bflo(w), x1 = bfhi(w);
          const float ss = wave_sum(x0 * x0 + x1 * x1), r = 1.f / sqrtf(ss * (1.f / 128.f) + RMS_EPS);
          *(unsigned*)(CKVN + (size_t)row * 256 + 2 * lane) = pk2(x0 * r * gkv[0], x1 * r * gkv[1]); *(unsigned*)(CKVN + (size_t)row * 256 + 128 + 2 * lane) = 0u; }
        if (lane < 16) { const int gi = lane >> 3, i = lane & 7; const float x1 = bf2f(p[C_KR + gi * 16 + i]), x2 = bf2f(p[C_KR + gi * 16 + 8 + i]); float o1 = x1, o2 = x2;
          if (row < ML) { const int t = row & 2047; const float cs = TAB[t * 32 + gi * 16 + i], sn = TAB[t * 32 + gi * 16 + 8 + i]; o1 = x1 * cs - x2 * sn; o2 = x2 * cs + x1 * sn; }
          KR[(size_t)row * 32 + gi * 16 + i] = (bf16)f2bf(o1); KR[(size_t)row * 32 + gi * 16 + 8 + i] = (bf16)f2bf(o2); }
    }
}

__device__ __forceinline__ void phase_conv(const Ctx& C, int l) {
    int tid = C.tid; OPAQUE(tid); const int lane = tid & 63, w = C.wave;
    LAS float* Wt = (LAS float*)C.lds;
    LAS unsigned char* Xt = C.lds + 63488;
    const bf16* PROJ = WSP(bf16, WS_R); bf16* U = WSP(bf16, WS_U);
    { const float* wdw = INP(I_WDW) + (size_t)l * 31 * 512;
      for (int i = tid; i < 31 * 128; i += NTHREADS) { const int j = i >> 7, c4 = i & 127, ln = c4 >> 1, hf = c4 & 1; *(LAS f32x4*)(Wt + ((j * 2 + hf) * 64 + ln) * 4) = *(const f32x4*)(wdw + j * 512 + 4 * c4); } }
    const f32x4 bd0 = *(const f32x4*)(INP(I_BDW) + l * 512 + 8 * lane), bd1 = *(const f32x4*)(INP(I_BDW) + l * 512 + 8 * lane + 4);
    const f32x4 gc0 = *(const f32x4*)(INP(I_GCN) + l * 512 + 8 * lane), gc1 = *(const f32x4*)(INP(I_GCN) + l * 512 + 8 * lane + 4);
    const f32x4 bc0 = *(const f32x4*)(INP(I_BCN) + l * 512 + 8 * lane), bc1 = *(const f32x4*)(INP(I_BCN) + l * 512 + 8 * lane + 4);
    const int ntile = (l == NL - 1 ? ML : MT) / 32;
    for (int tile = C.bid; tile < ntile; tile += C.G) {
        const int r0 = tile * 32, t0 = r0 < ML ? (r0 & 2047) : ((r0 - ML) & 255), L = r0 < ML ? 2048 : 256;
#pragma unroll
        for (int it = 0; it < 8; ++it) { const int idx = tid + 512 * it, rr = idx >> 6, ch = idx & 63, tt = t0 - 15 + rr;
            if (rr < 62) { v4u o = (v4u){0u, 0u, 0u, 0u};
                if (tt >= 0 && tt < L) { const bf16* p = PROJ + (size_t)(r0 - 15 + rr) * NP + C_CIN + 8 * ch; const v4u a = *(const v4u*)p, g = *(const v4u*)(p + 512);
                    o.x = pk2(bflo(a.x) * bflo(g.x), bfhi(a.x) * bfhi(g.x)); o.y = pk2(bflo(a.y) * bflo(g.y), bfhi(a.y) * bfhi(g.y));
                    o.z = pk2(bflo(a.z) * bflo(g.z), bfhi(a.z) * bfhi(g.z)); o.w = pk2(bflo(a.w) * bflo(g.w), bfhi(a.w) * bfhi(g.w)); }
                *(LAS v4u*)(Xt + rr * 1024 + ch * 16) = o; } }
        __syncthreads();
        f32x4 a0[4], a1[4];
#pragma unroll
        for (int tk = 0; tk < 4; ++tk) { a0[tk] = bd0; a1[tk] = bd1; }
        f32x4 wq0[4], wq1[4];
#pragma unroll
        for (int d = 0; d < 4; ++d) { wq0[d] = (f32x4){0.f, 0.f, 0.f, 0.f}; wq1[d] = (f32x4){0.f, 0.f, 0.f, 0.f}; }
#pragma unroll
        for (int rr = 0; rr < 34; ++rr) {
            if (rr <= 30) { wq0[0] = *(const LAS f32x4*)(Wt + ((rr * 2 + 0) * 64 + lane) * 4); wq1[0] = *(const LAS f32x4*)(Wt + ((rr * 2 + 1) * 64 + lane) * 4); }
            else { wq0[0] = (f32x4){0.f, 0.f, 0.f, 0.f}; wq1[0] = (f32x4){0.f, 0.f, 0.f, 0.f}; }
            const v4u g = *(const LAS v4u*)(Xt + (4 * w + rr) * 1024 + lane * 16);
            const f32x4 x0 = (f32x4){bflo(g.x), bfhi(g.x), bflo(g.y), bfhi(g.y)}, x1 = (f32x4){bflo(g.z), bfhi(g.z), bflo(g.w), bfhi(g.w)};
#pragma unroll
            for (int tk = 0; tk < 4; ++tk) { const int j = rr - tk; if (j >= 0 && j <= 30) { a0[tk] = a0[tk] + x0 * wq0[tk]; a1[tk] = a1[tk] + x1 * wq1[tk]; } }
            wq0[3] = wq0[2]; wq0[2] = wq0[1]; wq0[1] = wq0[0]; wq1[3] = wq1[2]; wq1[2] = wq1[1]; wq1[1] = wq1[0];
        }
#pragma unroll
        for (int tk = 0; tk < 4; ++tk) { f32x4 x0 = a0[tk], x1 = a1[tk];
            const float mean = wave_sum((x0[0] + x0[1]) + (x0[2] + x0[3]) + (x1[0] + x1[1]) + (x1[2] + x1[3])) * (1.f / 512.f);
            x0 = x0 - mean; x1 = x1 - mean;
            const float var = wave_sum((x0[0] * x0[0] + x0[1] * x0[1]) + (x0[2] * x0[2] + x0[3] * x0[3]) + (x1[0] * x1[0] + x1[1] * x1[1]) + (x1[2] * x1[2] + x1[3] * x1[3])) * (1.f / 512.f);
            const float rstd = 1.f / sqrtf(var + LN_EPS);
            f32x4 y0 = x0 * rstd * gc0 + bc0, y1 = x1 * rstd * gc1 + bc1;
#pragma unroll
            for (int q = 0; q < 4; ++q) { y0[q] = y0[q] / (1.f + __expf(-y0[q])); y1[q] = y1[q] / (1.f + __expf(-y1[q])); }
            v4u o; o.x = pk2(y0[0], y0[1]); o.y = pk2(y0[2], y0[3]); o.z = pk2(y1[0], y1[1]); o.w = pk2(y1[2], y1[3]);
            *(v4u*)(U + (size_t)(r0 + 4 * w + tk) * 512 + 8 * lane) = o; }
        __syncthreads();
    }
}

typedef float f32x16 __attribute__((ext_vector_type(16)));
typedef short v4i16 __attribute__((ext_vector_type(4)));
#define MFMA32(a, b, c) __builtin_amdgcn_mfma_f32_32x32x16_bf16(a, b, c, 0, 0, 0)
constexpr int AT_KBUF = 13312, AT_VBUF = 8192;
constexpr int AT_K0 = 0, AT_V0 = 3 * AT_KBUF, AT_RPB = AT_V0 + 3 * AT_VBUF, AT_QR = AT_RPB + 15 * 128 * 4, AT_END = AT_QR + 8 * 4096;
static_assert(AT_END <= RING_BYTES, "attention LDS map");
template <int MODE> __device__ __forceinline__ void attn_unit(const Ctx& C, int l, int unit) {
    constexpr bool MLA = MODE < 2; constexpr int DQK = MLA ? 96 : 64, KC = DQK / 8, KS = DQK / 16, RS = DQK * 2 + 16, NCH = 64 * KC + 512;
    constexpr int QT = (MODE == 0 || MODE == 2) ? 2 : 1;
    const int w = C.wave, lane = lane_id(), tid = w * 64 + lane, r = lane & 31, hh = lane >> 5;
    const bf16* PROJ = WSP(bf16, WS_R); const bf16* QB = WSP(bf16, WS_QB); const bf16* KVB = WSP(bf16, WS_KVB); const bf16* KR = WSP(bf16, WS_KR); const float* TAB = WSP(float, WS_TAB);
    bf16* Yo = WSP(bf16, MLA ? WS_YB : WS_YA);
    LAS unsigned char* lds = C.lds;
    int b, hd, q0, T, NB = 0, rs_min = 0, gi = 0;
    if (MODE == 0) { hd = unit & 7; const int qb = (unit >> 3) & 3; b = unit >> 5; q0 = b * 2048 + qb * 512; T = 36; }
    else if (MODE == 2) { hd = unit & 7; const int ib = (unit >> 3) & 3; b = unit >> 5; q0 = b * 2048 + ib * 512; gi = ib * 8 + w;
        rs_min = min(max(ib * 8 - 4, 0), 24); const int rs_max = min(max(ib * 8 + 3, 0), 24); NB = rs_max - rs_min + 8; T = NB + 4; }
    else { hd = unit & 7; b = unit >> 3; q0 = ML + b * 256; T = 4; }
    const int qrow0 = q0 + 32 * QT * w + r;
    constexpr int NKQ = (64 * (KC + 1)) / 64, NQ = NKQ + 8;
    auto tile_row0 = [&](int t) -> int {
        if (MODE == 0) return t < 4 ? ML + b * 256 + 64 * t : b * 2048 + 64 * (t - 4);
        if (MODE == 2) return t < NB ? b * 2048 + (rs_min + t) * 64 : ML + b * 256 + 64 * (t - NB);
        return ML + b * 256 + 64 * t; };
    int goff[3]; bool gkr[3]; int dblk[3]; bool dk[3];
#pragma unroll
    for (int j = 0; j < 3; ++j) { int q_ = w + 8 * j; if (q_ >= NQ) q_ -= 8; gkr[j] = false; dk[j] = q_ < NKQ; dblk[j] = (q_ < NKQ ? q_ : q_ - NKQ) * 1024;
        if (q_ < NKQ) { const int p_ = 64 * q_ + lane, key_ = p_ / (KC + 1), kc0_ = p_ - key_ * (KC + 1), kc_ = kc0_ == KC ? 0 : kc0_;
            if (MLA) { if (kc_ < 8) goff[j] = key_ * 1024 + hd * 128 + 8 * kc_; else { goff[j] = key_ * 32 + 8 * (kc_ - 8); gkr[j] = true; } } else goff[j] = key_ * NP + C_KA + hd * 64 + 8 * kc_; }
        else { const int p_ = 64 * (q_ - NKQ) + lane, dh_ = p_ >> 8, key_ = (p_ >> 2) & 63, vc_ = dh_ * 4 + (p_ & 3);
            goff[j] = MLA ? key_ * 1024 + hd * 128 + 64 + 8 * vc_ : key_ * NP + C_VA + hd * 64 + 8 * vc_; } }
#define AT_ISSUE(t, slot) do { const int row0_ = tile_row0(t); const bf16* bm_ = MLA ? KVB + (size_t)row0_ * 1024 : PROJ + (size_t)row0_ * NP; const bf16* br_ = KR + (size_t)row0_ * 32; \
        _Pragma("unroll") for (int j = 0; j < 3; ++j) { const bf16* g_ = ((MLA && gkr[j]) ? br_ : bm_) + goff[j]; \
            LAS unsigned char* d_ = lds + (dk[j] ? AT_K0 + (slot) * AT_KBUF : AT_V0 + (slot) * AT_VBUF) + dblk[j]; \
            __builtin_amdgcn_global_load_lds((const unsigned*)g_, (LAS unsigned*)d_, 16, 0, 0); } } while (0)
    constexpr int KSR = (MODE == 0) ? 4 : KS;
    bf16x8 qf[QT][KSR];
    LAS unsigned char* qrl = lds + AT_QR + w * 4096 + lane * 16;
#pragma unroll
    for (int qt = 0; qt < QT; ++qt) { const int qrow = qrow0 + 32 * qt;
        const bf16* qp = MLA ? QB + (size_t)qrow * 768 + hd * 96 : PROJ + (size_t)qrow * NP + C_QA + hd * 64;
#pragma unroll
        for (int ks = 0; ks < KSR; ++ks) qf[qt][ks] = *(const bf16x8*)(qp + 16 * ks + 8 * hh);
        if (MODE == 0) {
            const float* tb = TAB + (size_t)(qrow & 2047) * 32;
#pragma unroll
            for (int g = 0; g < 2; ++g) { const v4u own = *(const v4u*)(qp + 16 * (4 + g) + 8 * hh); v4u oth; oth.x = xshfl_u<32>(own.x); oth.y = xshfl_u<32>(own.y); oth.z = xshfl_u<32>(own.z); oth.w = xshfl_u<32>(own.w);
                const f32x4 c0 = *(const f32x4*)(tb + g * 16), c1 = *(const f32x4*)(tb + g * 16 + 4), s0 = *(const f32x4*)(tb + g * 16 + 8), s1 = *(const f32x4*)(tb + g * 16 + 12);
                const float sg = hh ? 1.f : -1.f; v4u nw;
                nw.x = pk2(bflo(own.x) * c0[0] + sg * bflo(oth.x) * s0[0], bfhi(own.x) * c0[1] + sg * bfhi(oth.x) * s0[1]); nw.y = pk2(bflo(own.y) * c0[2] + sg * bflo(oth.y) * s0[2], bfhi(own.y) * c0[3] + sg * bfhi(oth.y) * s0[3]);
                nw.z = pk2(bflo(own.z) * c1[0] + sg * bflo(oth.z) * s1[0], bfhi(own.z) * c1[1] + sg * bfhi(oth.z) * s1[1]); nw.w = pk2(bflo(own.w) * c1[2] + sg * bflo(oth.w) * s1[2], bfhi(own.w) * c1[3] + sg * bfhi(oth.w) * s1[3]);
                *(LAS v4u*)(qrl + (qt * 2 + g) * 1024) = nw; }
        } }
    if (MODE == 2) {
        LAS float* rt = (LAS float*)(lds + AT_RPB); const float* rpb = INP(I_RPB) + ((size_t)l * 8 + hd) * 15 * 31;
        for (int i = tid; i < 15 * 128; i += NTHREADS) { const int dr = i >> 7, dc = (i & 127) - 64; rt[i] = (dc >= -15 && dc <= 15) ? rpb[dr * 31 + dc + 15] * 1.4426950408889634f : 0.f; }
        asm volatile("s_waitcnt vmcnt(0) lgkmcnt(0)" ::: "memory");
    }
    constexpr float C2 = (MLA ? 0.10206207261596577f : 0.125f) * 1.4426950408889634f;
    f32x16 o[QT][2]; float m_[QT], l_[QT];
#pragma unroll
    for (int qt = 0; qt < QT; ++qt) { m_[qt] = -1e30f; l_[qt] = 0.f;
#pragma unroll
        for (int i = 0; i < 16; ++i) { o[qt][0][i] = 0.f; o[qt][1][i] = 0.f; } }
    const int rs_w = min(max(gi - 4, 0), 24);
    const int kroff = r * RS + hh * 16;
    const int vroff = ((lane >> 4) & 1) * 32 + ((lane & 15) >> 2) * 64 + (lane & 3) * 8 + hh * 4 * 64;
    AT_ISSUE(0, 0); AT_ISSUE(1, 1);
    int buf = 0, nbuf = 2;
    for (int t = 0; t < T; ++t) {
        if (t + 1 < T) asm volatile("s_waitcnt vmcnt(3)" ::: "memory"); else asm volatile("s_waitcnt vmcnt(0)" ::: "memory");
        __builtin_amdgcn_s_barrier(); asm volatile("" ::: "memory");
        if (t + 2 < T) AT_ISSUE(t + 2, nbuf);
        bool active = true; int kr = 0;
        if (MODE == 2 && t < NB) { kr = rs_min + t; active = (kr >= rs_w) && (kr < rs_w + 8); }
        if (active) {
            const LAS unsigned char* kb = lds + AT_K0 + buf * AT_KBUF + kroff; const LAS unsigned char* vb = lds + AT_V0 + buf * AT_VBUF + vroff;
            const bool band = (MODE == 2) && (t < NB);
#pragma unroll
            for (int kt = 0; kt < 2; ++kt) {
                if constexpr (QT == 2) { if (!band) {
                    const LAS unsigned char* kbt = kb + kt * 32 * RS;
                    auto qfrag = [&](int qt, int ks) -> bf16x8 { if (ks < KSR) return qf[qt][ks < KSR ? ks : 0]; return *(const LAS bf16x8*)(qrl + (qt * 2 + (ks - 4)) * 1024); };
                    auto softmax_nb = [&](f32x16& sv, int qt, bf16x8 (&pfo)[2], float& alpha) {
                        float mx = -1e30f, ps = 0.f;
#pragma unroll
                        for (int i = 0; i < 16; ++i) mx = fmaxf(mx, sv[i]);
                        mx = pair32_max(mx) * C2;
                        const float mn = fmaxf(m_[qt], mx); alpha = __builtin_amdgcn_exp2f(m_[qt] - mn); m_[qt] = mn;
#pragma unroll
                        for (int sx = 0; sx < 2; ++sx) { unsigned a[4];
#pragma unroll
                            for (int jj = 0; jj < 4; ++jj) { const int i = 8 * sx + 2 * jj;
                                const float p0 = __builtin_amdgcn_exp2f(fmaf(sv[i], C2, -mn)), p1 = __builtin_amdgcn_exp2f(fmaf(sv[i + 1], C2, -mn));
                                ps += p0 + p1; a[jj] = pk2(p0, p1); }
                            pfo[sx] = __builtin_bit_cast(bf16x8, (v4u){a[0], a[1], a[2], a[3]}); }
                        l_[qt] = l_[qt] * alpha + ps; };
                    f32x16 sA, sB;
#pragma unroll
                    for (int i = 0; i < 16; ++i) { sA[i] = 0.f; sB[i] = 0.f; }
                    bf16x8 kfr[KS];
#pragma unroll
                    for (int ks = 0; ks < KS; ++ks) { kfr[ks & 3] = *(const LAS bf16x8*)(kbt + ks * 32); sA = MFMA32(kfr[ks & 3], qfrag(0, ks), sA); }
                    __builtin_amdgcn_sched_barrier(0);
                    bf16x8 pfA[2], pfB[2]; float alA, alB;
                    bf16x8 kq[KS]; bf16x8 qq[KS];
#pragma unroll
                    for (int ks = 0; ks < KS; ++ks) { kq[ks] = *(const LAS bf16x8*)(kbt + ks * 32); qq[ks] = qfrag(1, ks); }
                    __builtin_amdgcn_sched_barrier(0);
#pragma unroll
                    for (int ks = 0; ks < KS; ++ks) sB = MFMA32(kq[ks], qq[ks], sB);
                    softmax_nb(sA, 0, pfA, alA);
#pragma unroll
                    for (int g = 0; g < KS; ++g) { __builtin_amdgcn_sched_group_barrier(0x008, 1, 0); __builtin_amdgcn_sched_group_barrier(0x002, 14, 0); }
                    __builtin_amdgcn_sched_barrier(0);
                    if (!__all(alA == 1.f)) {
#pragma unroll
                        for (int i = 0; i < 16; ++i) { o[0][0][i] *= alA; o[0][1][i] *= alA; } }
                    bf16x8 va[2], vc[2];
#pragma unroll
                    for (int sx = 0; sx < 2; ++sx) { const int rowb = (32 * kt + 16 * sx) * 64;
                        const v4i16 a00 = __builtin_amdgcn_ds_read_tr16_b64_v4i16((LAS v4i16*)(vb + rowb)), a01 = __builtin_amdgcn_ds_read_tr16_b64_v4i16((LAS v4i16*)(vb + rowb + 8 * 64));
                        const v4i16 a10 = __builtin_amdgcn_ds_read_tr16_b64_v4i16((LAS v4i16*)(vb + 4096 + rowb)), a11 = __builtin_amdgcn_ds_read_tr16_b64_v4i16((LAS v4i16*)(vb + 4096 + rowb + 8 * 64));
                        va[sx] = __builtin_shufflevector(a00, a01, 0, 1, 2, 3, 4, 5, 6, 7); vc[sx] = __builtin_shufflevector(a10, a11, 0, 1, 2, 3, 4, 5, 6, 7); }
                    __builtin_amdgcn_sched_barrier(0);
#pragma unroll
                    for (int sx = 0; sx < 2; ++sx) { o[0][0] = MFMA32(va[sx], pfA[sx], o[0][0]); o[0][1] = MFMA32(vc[sx], pfA[sx], o[0][1]); }
                    softmax_nb(sB, 1, pfB, alB);
#pragma unroll
                    for (int g = 0; g < 4; ++g) { __builtin_amdgcn_sched_group_barrier(0x008, 1, 0); __builtin_amdgcn_sched_group_barrier(0x002, 20, 0); }
                    __builtin_amdgcn_sched_barrier(0);
                    if (!__all(alB == 1.f)) {
#pragma unroll
                        for (int i = 0; i < 16; ++i) { o[1][0][i] *= alB; o[1][1][i] *= alB; } }
#pragma unroll
                    for (int sx = 0; sx < 2; ++sx) { o[1][0] = MFMA32(va[sx], pfB[sx], o[1][0]); o[1][1] = MFMA32(vc[sx], pfB[sx], o[1][1]); }
                    continue;
                } }
                f32x16 sc[QT];
#pragma unroll
                for (int qt = 0; qt < QT; ++qt)
#pragma unroll
                    for (int i = 0; i < 16; ++i) sc[qt][i] = 0.f;
#pragma unroll
                for (int ks = 0; ks < KS; ++ks) { const bf16x8 ka = *(const LAS bf16x8*)(kb + kt * 32 * RS + ks * 32);
#pragma unroll
                    for (int qt = 0; qt < QT; ++qt) { bf16x8 qb_; if (ks < KSR) qb_ = qf[qt][ks < KSR ? ks : 0]; else qb_ = *(const LAS bf16x8*)(qrl + (qt * 2 + (ks - 4)) * 1024);
                        sc[qt] = MFMA32(ka, qb_, sc[qt]); } }
                bf16x8 pf[QT][2];
#pragma unroll
                for (int qt = 0; qt < QT; ++qt) {
                    f32x16& s0 = sc[qt]; float mx = -1e30f, ps = 0.f, alpha;
                    if ((MODE == 2) && band) {
                        const bool part = qt != kt;
                        const int ilo = part ? (qt == 0 ? 0 : 12) : 0, ihi = part ? ilo + 4 : 16, sxv = qt == 0 ? 0 : 1;
                        const int ccol = 32 * qt + r; int cs = min(max(ccol - 8, 0), 48); asm volatile("" : "+v"(cs));
                        const LAS float* rt = (const LAS float*)(lds + AT_RPB) + (kr - gi + 7) * 128 + 64 - ccol + 32 * kt;
                        float bv[16];
#pragma unroll
                        for (int i = 0; i < 16; ++i) if (i >= ilo && i < ihi) bv[i] = rt[(i & 3) + 8 * (i >> 2) + 4 * hh];
#pragma unroll
                        for (int i = 0; i < 16; ++i) if (i >= ilo && i < ihi) { const int k0 = 32 * kt + (i & 3) + 8 * (i >> 2) + 4 * hh; const bool v0 = (k0 >= cs) && (k0 < cs + 16);
                            s0[i] = v0 ? fmaf(s0[i], C2, bv[i]) : -1e30f; mx = fmaxf(mx, s0[i]); }
                        mx = pair32_max(mx);
                        const float mn = fmaxf(m_[qt], mx); alpha = __builtin_amdgcn_exp2f(m_[qt] - mn); m_[qt] = mn;
#pragma unroll
                        for (int sx = 0; sx < 2; ++sx) { if (part && sx != sxv) continue;
                            unsigned a[4];
#pragma unroll
                            for (int jj = 0; jj < 4; ++jj) { const int i = 8 * sx + 2 * jj;
                                if (!(i >= ilo && i < ihi)) { a[jj] = 0u; continue; }
                                float p0 = __builtin_amdgcn_exp2f(s0[i] - mn), p1 = __builtin_amdgcn_exp2f(s0[i + 1] - mn);
                                p0 = s0[i] > -1e29f ? p0 : 0.f; p1 = s0[i + 1] > -1e29f ? p1 : 0.f;
                                ps += p0 + p1; a[jj] = pk2(p0, p1); }
                            pf[qt][sx] = __builtin_bit_cast(bf16x8, (v4u){a[0], a[1], a[2], a[3]}); }
                    } else {
#pragma unroll
                        for (int i = 0; i < 16; ++i) mx = fmaxf(mx, s0[i]);
                        mx = pair32_max(mx) * C2;
                        const float mn = fmaxf(m_[qt], mx); alpha = __builtin_amdgcn_exp2f(m_[qt] - mn); m_[qt] = mn;
#pragma unroll
                        for (int sx = 0; sx < 2; ++sx) { unsigned a[4];
#pragma unroll
                            for (int jj = 0; jj < 4; ++jj) { const int i = 8 * sx + 2 * jj;
                                const float p0 = __builtin_amdgcn_exp2f(fmaf(s0[i], C2, -mn)), p1 = __builtin_amdgcn_exp2f(fmaf(s0[i + 1], C2, -mn));
                                ps += p0 + p1; a[jj] = pk2(p0, p1); }
                            pf[qt][sx] = __builtin_bit_cast(bf16x8, (v4u){a[0], a[1], a[2], a[3]}); }
                    }
                    l_[qt] = l_[qt] * alpha + ps;
                    if (!__all(alpha == 1.f)) {
#pragma unroll
                        for (int i = 0; i < 16; ++i) { o[qt][0][i] *= alpha; o[qt][1][i] *= alpha; } }
                }
#pragma unroll
                for (int sx = 0; sx < 2; ++sx) {
                    const int rowb = (32 * kt + 16 * sx) * 64;
                    const v4i16 a00 = __builtin_amdgcn_ds_read_tr16_b64_v4i16((LAS v4i16*)(vb + rowb)), a01 = __builtin_amdgcn_ds_read_tr16_b64_v4i16((LAS v4i16*)(vb + rowb + 8 * 64));
                    const v4i16 a10 = __builtin_amdgcn_ds_read_tr16_b64_v4i16((LAS v4i16*)(vb + 4096 + rowb)), a11 = __builtin_amdgcn_ds_read_tr16_b64_v4i16((LAS v4i16*)(vb + 4096 + rowb + 8 * 64));
                    const bf16x8 va = __builtin_shufflevector(a00, a01, 0, 1, 2, 3, 4, 5, 6, 7), vc = __builtin_shufflevector(a10, a11, 0, 1, 2, 3, 4, 5, 6, 7);
#pragma unroll
                    for (int qt = 0; qt < QT; ++qt) { if ((MODE == 2) && band && (qt != kt) && sx != (qt == 0 ? 0 : 1)) continue;
                        o[qt][0] = MFMA32(va, pf[qt][sx], o[qt][0]); o[qt][1] = MFMA32(vc, pf[qt][sx], o[qt][1]); } }
            }
        }
        buf = buf == 2 ? 0 : buf + 1; nbuf = nbuf == 2 ? 0 : nbuf + 1;
    }
#pragma unroll
    for (int qt = 0; qt < QT; ++qt) {
        const float lt = pair32_sum(l_[qt]), inv = 1.f / lt;
        bf16* op = Yo + (size_t)(qrow0 + 32 * qt) * 512 + hd * 64 + 4 * hh;
#pragma unroll
        for (int g4 = 0; g4 < 4; ++g4) { v2u w0, w1; w0.x = pk2(o[qt][0][4 * g4] * inv, o[qt][0][4 * g4 + 1] * inv); w0.y = pk2(o[qt][0][4 * g4 + 2] * inv, o[qt][0][4 * g4 + 3] * inv);
            w1.x = pk2(o[qt][1][4 * g4] * inv, o[qt][1][4 * g4 + 1] * inv); w1.y = pk2(o[qt][1][4 * g4 + 2] * inv, o[qt][1][4 * g4 + 3] * inv);
            *(v2u*)(op + 8 * g4) = w0; *(v2u*)(op + 32 + 8 * g4) = w1; } }
    __syncthreads();
#undef AT_ISSUE
}
__device__ __forceinline__ void phase_attn(const Ctx& C, int l) {
    { int b_ = C.bid; asm volatile("" : "+s"(b_)); if (l < NL - 1 && (b_ & 3) == 0) { conv_weights(C, l + 1, 0, 100, 0, C.G); __syncthreads(); } }
    for (int u = C.bid; u < 512; u += C.G) attn_unit<0>(C, l, u);
    { int b_ = C.bid; asm volatile("" : "+s"(b_)); if (l < NL - 1 && (b_ & 3) == 1) { conv_weights(C, l + 1, 0, 100, 0, C.G); __syncthreads(); } }
    for (int u = C.bid; u < 512; u += C.G) attn_unit<2>(C, l, u);
    { int b_ = C.bid; asm volatile("" : "+s"(b_)); if (l < NL - 1 && (b_ & 3) == 2) { conv_weights(C, l + 1, 0, 100, 0, C.G); __syncthreads(); } }
    if (l < NL - 1) for (int u = C.bid; u < 256; u += C.G) { if (u < 128) attn_unit<1>(C, l, u); else attn_unit<3>(C, l, u - 128); }
    { int b_ = C.bid; asm volatile("" : "+s"(b_)); if (l < NL - 1 && (b_ & 3) == 3) { conv_weights(C, l + 1, 0, 100, 0, C.G); __syncthreads(); } }
}

__device__ __forceinline__ float reduce16(float (&v)[16], int lane) {
#pragma unroll
    for (int i = 0; i < 8; ++i) { const bool hi = lane & 32; const float keep = hi ? v[i + 8] : v[i], send = hi ? v[i] : v[i + 8]; v[i] = keep + xshfl<32>(send); }
#pragma unroll
    for (int i = 0; i < 4; ++i) { const bool hi = lane & 16; const float keep = hi ? v[i + 4] : v[i], send = hi ? v[i] : v[i + 4]; v[i] = keep + xshfl<16>(send); }
#pragma unroll
    for (int i = 0; i < 2; ++i) { const bool hi = lane & 8; const float keep = hi ? v[i + 2] : v[i], send = hi ? v[i] : v[i + 2]; v[i] = keep + xshfl<8>(send); }
    { const bool hi = lane & 4; const float keep = hi ? v[1] : v[0], send = hi ? v[0] : v[1]; v[0] = keep + xshfl<4>(send); }
    v[0] += xshfl<2>(v[0]); v[0] += xshfl<1>(v[0]);
    return v[0];
}
__device__ __forceinline__ void phase_ln1(const Ctx& C, int l) {
    int lane = C.lane; OPAQUE(lane); const int gw = C.bid * NWAVES + C.wave, NGW = C.G * NWAVES;
    LAS float* Wr = (LAS float*)C.lds;
    const float* wr = INP(I_WROUTER) + (size_t)l * 1024 * 16;
    for (int idx = C.tid; idx < 16384; idx += NTHREADS) { const int c = idx >> 4, e = idx & 15; Wr[e * 1024 + c] = wr[idx]; }
    __syncthreads();
    const bf16* Yb = WSP(bf16, WS_YP); const float* X = WSP(float, WS_X); bf16* H2 = WSP(bf16, WS_HB); float* AFF = WSP(float, WS_AFF); float* STAT = WSP(float, WS_STAT);
    const float* XI = INP(I_X); const float* XC = INP(I_CTX) - (size_t)ML * DM;
    const float* MODS = WSP(float, WS_MODS) + (size_t)l * 17 * 6144;
    const float* lg = INP(I_LN1G) + l * 1024; const float* lb = INP(I_LN1B) + l * 1024;
    const int myexp = ((lane >> 5) & 1) * 8 + ((lane >> 4) & 1) * 4 + ((lane >> 3) & 1) * 2 + ((lane >> 2) & 1);
    const int nrp = (l == NL - 1 ? ML : MT) / 2;
    f32x4 nx[2][4]; v4u ny[2][2];
#define LN1_LOAD(rp_) do { const int r_ = 2 * (rp_); const float* xs_ = (l == 0 ? (r_ < ML ? XI : XC) : X) + (size_t)r_ * DM; _Pragma("unroll") for (int j = 0; j < 2; ++j) { const int c = 8 * (lane + 64 * j); \
        nx[0][2 * j] = *(const f32x4*)(xs_ + c); nx[0][2 * j + 1] = *(const f32x4*)(xs_ + c + 4); nx[1][2 * j] = *(const f32x4*)(xs_ + DM + c); nx[1][2 * j + 1] = *(const f32x4*)(xs_ + DM + c + 4); \
        ny[0][j] = *(const v4u*)(Yb + (size_t)r_ * DM + c); ny[1][j] = *(const v4u*)(Yb + (size_t)(r_ + 1) * DM + c); } } while (0)
    if (gw < nrp) LN1_LOAD(gw);
    for (int rp = gw; rp < nrp; rp += NGW) {
        const int row = 2 * rp; const int mr = row < ML ? (row >> 11) : 16; const float* md = MODS + (size_t)mr * 6144;
        f32x4 v[2][4]; float sa = 0.f, sb = 0.f;
#pragma unroll
        for (int j = 0; j < 2; ++j) { const int c = 8 * (lane + 64 * j); const f32x4 g1a = *(const f32x4*)(md + 2048 + c), g1b = *(const f32x4*)(md + 2048 + c + 4);
            v[0][2 * j] = nx[0][2 * j] * DN_ALPHA + g1a * pg8::unpack4((v2u){ny[0][j].x, ny[0][j].y}); v[0][2 * j + 1] = nx[0][2 * j + 1] * DN_ALPHA + g1b * pg8::unpack4((v2u){ny[0][j].z, ny[0][j].w});
            v[1][2 * j] = nx[1][2 * j] * DN_ALPHA + g1a * pg8::unpack4((v2u){ny[1][j].x, ny[1][j].y}); v[1][2 * j + 1] = nx[1][2 * j + 1] * DN_ALPHA + g1b * pg8::unpack4((v2u){ny[1][j].z, ny[1][j].w}); }
        if (rp + NGW < nrp) LN1_LOAD(rp + NGW);
#pragma unroll
        for (int j = 0; j < 4; ++j) { sa += (v[0][j][0] + v[0][j][1]) + (v[0][j][2] + v[0][j][3]); sb += (v[1][j][0] + v[1][j][1]) + (v[1][j][2] + v[1][j][3]); }
        const float mean0 = wave_sum(sa) * (1.f / 1024.f), mean1 = wave_sum(sb) * (1.f / 1024.f); float qa = 0.f, qb = 0.f;
#pragma unroll
        for (int j = 0; j < 4; ++j) { v[0][j] = v[0][j] - mean0; v[1][j] = v[1][j] - mean1;
            qa += (v[0][j][0] * v[0][j][0] + v[0][j][1] * v[0][j][1]) + (v[0][j][2] * v[0][j][2] + v[0][j][3] * v[0][j][3]);
            qb += (v[1][j][0] * v[1][j][0] + v[1][j][1] * v[1][j][1]) + (v[1][j][2] * v[1][j][2] + v[1][j][3] * v[1][j][3]); }
        const float rstd0 = 1.f / sqrtf(wave_sum(qa) * (1.f / 1024.f) + LN_EPS), rstd1 = 1.f / sqrtf(wave_sum(qb) * (1.f / 1024.f) + LN_EPS);
        if (lane == 0) *(f32x4*)(STAT + (size_t)row * 2) = (f32x4){mean0, rstd0, mean1, rstd1};
        float lg0[16], lg1[16];
#pragma unroll
        for (int e = 0; e < 16; ++e) { lg0[e] = 0.f; lg1[e] = 0.f; }
#pragma unroll
        for (int j = 0; j < 2; ++j) { const int c0 = 8 * (lane + 64 * j); f32x4 ha[2], hb[2];
#pragma unroll
            for (int h = 0; h < 2; ++h) { const int c = c0 + 4 * h;
                const f32x4 gg = *(const f32x4*)(lg + c), bb = *(const f32x4*)(lb + c), scl = *(const f32x4*)(md + 4096 + c) + 1.f, shf = *(const f32x4*)(md + 3072 + c);
                const f32x4 xa = v[0][2 * j + h] * rstd0 * gg + bb, xb = v[1][2 * j + h] * rstd1 * gg + bb;
                ha[h] = xa * scl + shf; hb[h] = xb * scl + shf; }
            *(v4u*)(H2 + (size_t)row * DM + c0) = pg8::pack8(ha[0], ha[1]); *(v4u*)(H2 + (size_t)(row + 1) * DM + c0) = pg8::pack8(hb[0], hb[1]);
#pragma unroll
            for (int h = 0; h < 2; ++h) {
#pragma unroll
                for (int e = 0; e < 16; ++e) { const f32x4 wv = *(const LAS f32x4*)(Wr + e * 1024 + c0 + 4 * h);
                    lg0[e] += (ha[h][0] * wv[0] + ha[h][1] * wv[1]) + (ha[h][2] * wv[2] + ha[h][3] * wv[3]); lg1[e] += (hb[h][0] * wv[0] + hb[h][1] * wv[1]) + (hb[h][2] * wv[2] + hb[h][3] * wv[3]); }
                asm volatile("" ::: "memory"); } }
        const float t0 = reduce16(lg0, lane), t1 = reduce16(lg1, lane);
        float m0 = t0, m1 = t1;
        m0 = fmaxf(m0, xshfl<4>(m0)); m1 = fmaxf(m1, xshfl<4>(m1)); m0 = fmaxf(m0, xshfl<8>(m0)); m1 = fmaxf(m1, xshfl<8>(m1)); m0 = fmaxf(m0, xshfl<16>(m0)); m1 = fmaxf(m1, xshfl<16>(m1)); m0 = pair32_max(m0); m1 = pair32_max(m1);
        const float p0 = expf(t0 - m0), p1 = expf(t1 - m1); float d0 = p0, d1 = p1;
        d0 += xshfl<4>(d0); d1 += xshfl<4>(d1); d0 += xshfl<8>(d0); d1 += xshfl<8>(d1); d0 += xshfl<16>(d0); d1 += xshfl<16>(d1); d0 = pair32_sum(d0); d1 = pair32_sum(d1);
        if ((lane & 3) == 0) { AFF[(size_t)row * 16 + myexp] = p0 / d0; AFF[(size_t)(row + 1) * 16 + myexp] = p1 / d1; }
    }
#undef LN1_LOAD
}

__device__ __forceinline__ void phase_topk(const Ctx& Cc, int l) {
    Ctx C = Cc; OPAQUE(C.tid);
    LAS unsigned long long* a = (LAS unsigned long long*)C.lds;
    const float* AFF = WSP(float, WS_AFF); int* SEL = WSP(int, WS_SEL); int* IDX = WSP(int, WS_IDX);
    const int nitem = l == NL - 1 ? 256 : 512;
    for (int item = C.bid; item < nitem; item += C.G) {
        const bool lat = item < 256; const int it = lat ? item : item - 256, b = it >> 4, e = it & 15;
        const int N = lat ? 2048 : 256, cap = lat ? CAPL : CAPC, base = lat ? b * 2048 : ML + b * 256, slotbase = lat ? b * CAPL : NBATCH * CAPL + b * CAPC;
        for (int t = C.tid; t < N; t += NTHREADS) a[t] = ((unsigned long long)__float_as_uint(AFF[(size_t)(base + t) * 16 + e]) << 32) | (unsigned long long)(0xFFFFFFFFu - (unsigned)t);
        __syncthreads();
        for (int k = 2; k <= N; k <<= 1)
            for (int j = k >> 1; j > 0; j >>= 1) {
                for (int p = C.tid; p < N / 2; p += NTHREADS) {
                    const int i = ((p & ~(j - 1)) << 1) | (p & (j - 1)), ij = i | j;
                    const unsigned long long x = a[i], y = a[ij];
                    const bool desc = (i & k) == 0;
                    if (desc ? (x < y) : (x > y)) { a[i] = y; a[ij] = x; }
                }
                __syncthreads();
            }
        for (int p = C.tid; p < N; p += NTHREADS) { const int tok = (int)(0xFFFFFFFFu - (unsigned)a[p]);
            SEL[(size_t)(base + tok) * 16 + e] = p < cap ? p : -1;
            if (p < cap) IDX[e * ROWS_E + slotbase + p] = base + tok; }
        __syncthreads();
    }
}

__device__ __forceinline__ void phase_gather(const Ctx& C) {
    int lane = C.lane; OPAQUE(lane); const int gw = C.bid * NWAVES + C.wave, NGW = C.G * NWAVES;
    const int* IDX = WSP(int, WS_IDX); const bf16* H2 = WSP(bf16, WS_HB); bf16* XG = WSP(bf16, WS_XG);
    for (int r = gw; r < MG; r += NGW) { const int src = IDX[r]; const v4u* s = (const v4u*)(H2 + (size_t)src * DM); v4u* d = (v4u*)(XG + (size_t)r * DM);
        const v4u a = s[lane], b = s[lane + 64]; d[lane] = a; d[lane + 64] = b; }
}

__device__ __forceinline__ void phase_combine(const Ctx& C, int l) {
    int lane = C.lane; OPAQUE(lane); const int gw = C.bid * NWAVES + C.wave, NGW = C.G * NWAVES;
    const bf16* Y = WSP(bf16, WS_Y); float* X = WSP(float, WS_X); bf16* H = WSP(bf16, WS_HB); const float* AFF = WSP(float, WS_AFF); const int* SEL = WSP(int, WS_SEL);
    const bf16* Yp = WSP(bf16, WS_YP); const float* STAT = WSP(float, WS_STAT); const float* l1g = INP(I_LN1G) + l * 1024; const float* l1b = INP(I_LN1B) + l * 1024;
    const float* XI = INP(I_X); const float* XC = INP(I_CTX) - (size_t)ML * DM;
    const float* MODS = WSP(float, WS_MODS) + (size_t)l * 17 * 6144; const float* MODN = MODS + 17 * 6144;
    const float* lg = INP(I_LN2G) + l * 1024; const float* lb = INP(I_LN2B) + l * 1024;
    const int nrp = (l == NL - 1 ? ML : MT) / 2;
    f32x4 nxa[4], nxb[4]; v4u nya[2], nyb[2]; f32x4 nst = (f32x4){0.f, 0.f, 0.f, 0.f}; int nsel = 0; float naff = 0.f;
#define CMB_LOAD(rp_) do { const int r_ = 2 * (rp_); nsel = SEL[(size_t)r_ * 16 + (lane & 31)]; naff = AFF[(size_t)r_ * 16 + (lane & 31)]; nst = *(const f32x4*)(STAT + (size_t)r_ * 2); \
        const float* xs_ = (l == 0 ? (r_ < ML ? XI : XC) : (const float*)X) + (size_t)r_ * DM; \
        _Pragma("unroll") for (int j = 0; j < 2; ++j) { nya[j] = *(const v4u*)(Yp + (size_t)r_ * DM + 8 * (lane + 64 * j)); nyb[j] = *(const v4u*)(Yp + (size_t)(r_ + 1) * DM + 8 * (lane + 64 * j)); \
            _Pragma("unroll") for (int h = 0; h < 2; ++h) { const int c = 8 * (lane + 64 * j) + 4 * h; nxa[2 * j + h] = *(const f32x4*)(xs_ + c); nxb[2 * j + h] = *(const f32x4*)(xs_ + DM + c); } } } while (0)
    if (gw < nrp) CMB_LOAD(gw);
    for (int rp = gw; rp < nrp; rp += NGW) {
        const int row = 2 * rp; const bool lat = row < ML; const int mr = lat ? (row >> 11) : 16; const float* md = MODS + (size_t)mr * 6144;
        const int rb = lat ? (row >> 11) * CAPL : NBATCH * CAPL + ((row - ML) >> 8) * CAPC;
        const int selv = nsel; const float affv = naff;
        f32x4 xa[4], xb[4];
        {
            const f32x4 st = nst;
#pragma unroll
            for (int j = 0; j < 2; ++j) { const int c = 8 * (lane + 64 * j); const f32x4 g1a = *(const f32x4*)(md + 2048 + c), g1b = *(const f32x4*)(md + 2048 + c + 4);
                const f32x4 gga = *(const f32x4*)(l1g + c), ggb = *(const f32x4*)(l1g + c + 4), bba = *(const f32x4*)(l1b + c), bbb = *(const f32x4*)(l1b + c + 4);
                xa[2 * j] = ((nxa[2 * j] * DN_ALPHA + g1a * pg8::unpack4((v2u){nya[j].x, nya[j].y})) - st[0]) * st[1] * gga + bba; xa[2 * j + 1] = ((nxa[2 * j + 1] * DN_ALPHA + g1b * pg8::unpack4((v2u){nya[j].z, nya[j].w})) - st[0]) * st[1] * ggb + bbb;
                xb[2 * j] = ((nxb[2 * j] * DN_ALPHA + g1a * pg8::unpack4((v2u){nyb[j].x, nyb[j].y})) - st[2]) * st[3] * gga + bba; xb[2 * j + 1] = ((nxb[2 * j + 1] * DN_ALPHA + g1b * pg8::unpack4((v2u){nyb[j].z, nyb[j].w})) - st[2]) * st[3] * ggb + bbb; }
        }
        if (rp + NGW < nrp) CMB_LOAD(rp + NGW);
        unsigned long long bal = __ballot(selv >= 0);
        unsigned ma = (unsigned)(bal & 0xffffu), mb = (unsigned)((bal >> 16) & 0xffffu);
        f32x4 acca[4], accb[4];
#pragma unroll
        for (int j = 0; j < 4; ++j) { acca[j] = (f32x4){0.f, 0.f, 0.f, 0.f}; accb[j] = (f32x4){0.f, 0.f, 0.f, 0.f}; }
        while (ma | mb) {
            const int ea = ma ? __builtin_ctz(ma) : 0, eb = mb ? __builtin_ctz(mb) : 0;
            const int sa = __builtin_amdgcn_readlane(selv, ea), sb = __builtin_amdgcn_readlane(selv, 16 + eb); float fa = __uint_as_float(__builtin_amdgcn_readlane(__float_as_uint(affv), ea)), fb = __uint_as_float(__builtin_amdgcn_readlane(__float_as_uint(affv), 16 + eb));
            if (!ma) fa = 0.f; if (!mb) fb = 0.f;
            const bf16* ya = Y + ((size_t)ea * ROWS_E + rb + (ma ? sa : 0)) * DM; const bf16* yb = Y + ((size_t)eb * ROWS_E + rb + (mb ? sb : 0)) * DM;
            v4u wa[2], wb[2];
#pragma unroll
            for (int j = 0; j < 2; ++j) { wa[j] = *(const v4u*)(ya + 8 * (lane + 64 * j)); wb[j] = *(const v4u*)(yb + 8 * (lane + 64 * j)); }
#pragma unroll
            for (int j = 0; j < 2; ++j) { acca[2 * j] = acca[2 * j] + pg8::unpack4((v2u){wa[j].x, wa[j].y}) * fa; acca[2 * j + 1] = acca[2 * j + 1] + pg8::unpack4((v2u){wa[j].z, wa[j].w}) * fa;
                accb[2 * j] = accb[2 * j] + pg8::unpack4((v2u){wb[j].x, wb[j].y}) * fb; accb[2 * j + 1] = accb[2 * j + 1] + pg8::unpack4((v2u){wb[j].z, wb[j].w}) * fb; }
            ma &= ma - 1; mb &= mb - 1;
        }
        float sma = 0.f, smb = 0.f;
#pragma unroll
        for (int j = 0; j < 2; ++j)
#pragma unroll
            for (int h = 0; h < 2; ++h) { const int q = 2 * j + h; const f32x4 g2 = *(const f32x4*)(md + 5120 + 8 * (lane + 64 * j) + 4 * h); xa[q] = xa[q] * DN_ALPHA + g2 * acca[q]; xb[q] = xb[q] * DN_ALPHA + g2 * accb[q];
                sma += (xa[q][0] + xa[q][1]) + (xa[q][2] + xa[q][3]); smb += (xb[q][0] + xb[q][1]) + (xb[q][2] + xb[q][3]); }
        const float mean0 = wave_sum(sma) * (1.f / 1024.f), mean1 = wave_sum(smb) * (1.f / 1024.f); float qa = 0.f, qb = 0.f;
#pragma unroll
        for (int j = 0; j < 4; ++j) { xa[j] = xa[j] - mean0; xb[j] = xb[j] - mean1;
            qa += (xa[j][0] * xa[j][0] + xa[j][1] * xa[j][1]) + (xa[j][2] * xa[j][2] + xa[j][3] * xa[j][3]); qb += (xb[j][0] * xb[j][0] + xb[j][1] * xb[j][1]) + (xb[j][2] * xb[j][2] + xb[j][3] * xb[j][3]); }
        const float rstd0 = 1.f / sqrtf(wave_sum(qa) * (1.f / 1024.f) + LN_EPS), rstd1 = 1.f / sqrtf(wave_sum(qb) * (1.f / 1024.f) + LN_EPS);
#pragma unroll
        for (int j = 0; j < 2; ++j) { const int c0 = 8 * (lane + 64 * j); f32x4 ya[2], yb[2];
#pragma unroll
            for (int h = 0; h < 2; ++h) { const int c = c0 + 4 * h; const f32x4 gg = *(const f32x4*)(lg + c), bb = *(const f32x4*)(lb + c);
                ya[h] = xa[2 * j + h] * rstd0 * gg + bb; yb[h] = xb[2 * j + h] * rstd1 * gg + bb; }
            if (l < NL - 1) { const float* mn = MODN + (size_t)mr * 6144; f32x4 ha[2], hb[2];
#pragma unroll
                for (int h = 0; h < 2; ++h) { const int c = c0 + 4 * h; *(f32x4*)(X + (size_t)row * DM + c) = ya[h]; *(f32x4*)(X + (size_t)(row + 1) * DM + c) = yb[h];
                    const f32x4 scl = *(const f32x4*)(mn + 1024 + c) + 1.f, shf = *(const f32x4*)(mn + c); ha[h] = ya[h] * scl + shf; hb[h] = yb[h] * scl + shf; }
                *(v4u*)(H + (size_t)row * DM + c0) = pg8::pack8(ha[0], ha[1]); *(v4u*)(H + (size_t)(row + 1) * DM + c0) = pg8::pack8(hb[0], hb[1]); }
            else if (lat) {
#pragma unroll
                for (int h = 0; h < 2; ++h) { const int c = c0 + 4 * h; *(f32x4*)(C.out + (size_t)row * DM + c) = ya[h]; *(f32x4*)(C.out + (size_t)(row + 1) * DM + c) = yb[h]; } } }
    }
#undef CMB_LOAD
}

enum { PH_MODS = 0, PH_MOD0, PH_WIN, PH_PREP, PH_CONV, PH_UQ, PH_UKV, PH_ATTN, PH_MERGE, PH_WOUT, PH_LN1, PH_TOPK, PH_GATHER, PH_GU, PH_DOWN, PH_COMB, PH_COUNT };
template <int PH> __device__ __forceinline__ void run_phase(const Ctx& C, int l) {
    if constexpr (PH == PH_MODS) { phase_mods(C); __syncthreads(); conv_weights(C, 0, 0, 100, 0, C.G); }
    if constexpr (PH == PH_MOD0) { phase_mod0(C); }
    if constexpr (PH == PH_WIN) { pg8::ProbPlain P{WSP(bf16, WS_HB), WSW(bf16, WS_WIN, l), 1024, 1024, 1024}; pg8::EpiWin E{WSP(bf16, WS_R)};
        if (l == NL - 1) { pg8::OrderWinLast S; S.init(C.G, C.bid); pg8::gemm_phase(C.lds, P, S, E, C.wave); }
        else { pg8::Order<1> S; S.init(MT / 256, NP / 256, C.G, C.bid); pg8::gemm_phase(C.lds, P, S, E, C.wave); } }
    if constexpr (PH == PH_PREP) { phase_prep(C, l); }
    if constexpr (PH == PH_CONV) { phase_conv(C, l); }
    if constexpr (PH == PH_UQ) { pg8::ProbUp2 P{WSP(bf16, WS_CQN), WSP(bf16, WS_CKVN), WSW(bf16, WS_WUQ, l), WSW(bf16, WS_WUKV, l), 256, 256, 256};
        pg8::OrderUp2 S; S.init((l == NL - 1 ? ML : MT) / 256, C.G, C.bid); pg8::EpiUp2 E{WSP(bf16, WS_QB), WSP(bf16, WS_KVB)}; pg8::gemm_phase(C.lds, P, S, E, C.wave); }
    if constexpr (PH == PH_ATTN) { phase_attn(C, l); }
    if constexpr (PH == PH_MERGE) { pg8::ProbSeg3 P{WSP(bf16, WS_YA), WSW(bf16, WS_WOA, l), 512, 512, 512, (size_t)(36 * MiB / 2), (size_t)(1 * MiB / 2)};
        pg8::Order<3> S; S.init((l == NL - 1 ? ML : MT) / 256, 4, C.G, C.bid); pg8::EpiMerge E{WSP(bf16, WS_R), WSP(bf16, WS_HB)}; pg8::gemm_phase(C.lds, P, S, E, C.wave); }
    if constexpr (PH == PH_WOUT) { pg8::ProbPlain P{WSP(bf16, WS_HB), WSW(bf16, WS_WOUT, l), 1024, 1024, 1024}; pg8::Order<1> S; S.init((l == NL - 1 ? ML : MT) / 256, 4, C.G, C.bid);
        pg8::EpiBf16 E{WSP(bf16, WS_YP), 1024}; pg8::gemm_phase(C.lds, P, S, E, C.wave); }
    if constexpr (PH == PH_LN1) { phase_ln1(C, l); }
    if constexpr (PH == PH_TOPK) { phase_topk(C, l); }
    if constexpr (PH == PH_GATHER) { phase_gather(C); }
    if constexpr (PH == PH_GU) { pg8::OrderOrd S; S.o.init(l == NL - 1 ? 256 : 288, 8, C.G, C.bid, l == NL - 1 ? 16 : 0);
        LAS int* lidx = (LAS int*)(C.lds + LIDX_OFF); const int* IDXg = WSP(int, WS_IDX);
        { pg8::Unit uu; for (int i = 0; i < 10 && S.next(i, uu); ++i) if (C.tid < 256) lidx[i * 256 + C.tid] = IDXg[uu.pm * 256 + C.tid]; }
        __syncthreads();
        pg8::ProbMoEGather P{WSP(bf16, WS_HB), WSW(bf16, WS_WGU, l), lidx, 1024, 1024, 1024, 2048};
        pg8::EpiSwiGLU E{WSP(bf16, WS_HID)}; pg8::gemm_phase(C.lds, P, S, E, C.wave); }
    if constexpr (PH == PH_DOWN) { pg8::ProbMoE P{WSP(bf16, WS_HID), WSW(bf16, WS_WD, l), 1024, 1024, 1024, 1024}; pg8::Order<1> S; S.init(l == NL - 1 ? 256 : 288, 4, C.G, C.bid, l == NL - 1 ? 16 : 0);
        pg8::EpiBf16 E{WSP(bf16, WS_Y), 1024}; pg8::gemm_phase(C.lds, P, S, E, C.wave); }
    if constexpr (PH == PH_COMB) { phase_combine(C, l); }
}
template <int PH> __device__ __forceinline__ void call_phase(const Ctx& Cin, int l) { Ctx C = Cin; C.lane = lane_id(); OPAQUE(C.lane); asm volatile("" : "+s"(C.wave)); C.tid = C.wave * 64 + C.lane; asm volatile("" : "+s"(l)); asm volatile("" : "+s"(C.G)); asm volatile("" : "+s"(C.bid)); { unsigned long long w_ = (unsigned long long)C.ws; unsigned lo_ = (unsigned)w_, hi_ = (unsigned)(w_ >> 32); asm volatile("" : "+s"(lo_)); asm volatile("" : "+s"(hi_)); C.ws = (unsigned char*)(GAS unsigned char*)(((unsigned long long)hi_ << 32) | lo_); } run_phase<PH>(C, l); }
__global__ void __launch_bounds__(NTHREADS, 2) mega_fwd(Args args) {
    extern __shared__ __attribute__((aligned(16))) unsigned char lds_raw[];
    Ctx C;
    C.lds = (LAS unsigned char*)lds_raw;
    C.tid = threadIdx.x; C.lane = C.tid & 63; C.wave = __builtin_amdgcn_readfirstlane(C.tid >> 6);
    C.G = gridDim.x; C.bid = blockIdx.x;
    C.in = args.in; C.ws = (unsigned char*)(GAS unsigned char*)args.ws; C.out = (float*)(GAS float*)args.out;
    volatile LAS unsigned* MISC = (volatile LAS unsigned*)(C.lds + MISC_OFF);
    for (int u = C.tid; u < (LDS_BYTES - LDSCTL_OFF) / 4; u += NTHREADS) ((LAS unsigned*)(C.lds + LDSCTL_OFF))[u] = 0u;
    __syncthreads();
    XcdBarrier bar = xcd_barrier_post((unsigned*)(C.ws + WS_CTL) + 4096, MISC + 8, C.wave);
    call_phase<PH_MODS>(C, 0); xcd_barrier(bar);
    call_phase<PH_MOD0>(C, 0); xcd_barrier(bar);
    for (int l = 0; l < NL; ++l) {
        call_phase<PH_WIN>(C, l); xcd_barrier(bar);
        call_phase<PH_PREP>(C, l); xcd_barrier(bar);
        call_phase<PH_CONV>(C, l); __syncthreads(); call_phase<PH_UQ>(C, l); xcd_barrier(bar);
        call_phase<PH_ATTN>(C, l); xcd_barrier(bar);
        call_phase<PH_MERGE>(C, l); xcd_barrier(bar);
        call_phase<PH_WOUT>(C, l); xcd_barrier(bar);
        call_phase<PH_LN1>(C, l); xcd_barrier(bar);
        call_phase<PH_TOPK>(C, l); xcd_barrier(bar);
        call_phase<PH_GU>(C, l); xcd_barrier(bar);
        call_phase<PH_DOWN>(C, l); xcd_barrier(bar);
        call_phase<PH_COMB>(C, l); if (l < NL - 1) xcd_barrier(bar);
    }
}

extern "C" void kernel_launch(void* const* d_in, const int* in_sizes, int n_in, void* d_out, int out_size, void* d_ws, size_t ws_size, hipStream_t stream) {
    static int grid = 0;
    if (grid == 0) {
        if (n_in != 28 || out_size != ML * DM || ws_size < WS_END) { fprintf(stderr, "kernel_launch: unexpected shapes: n_in %d out %d ws %zu (need %zu)\n", n_in, out_size, ws_size, (size_t)WS_END); grid = -1; return; }
        int dev = 0, cus = 0, per_cu = 0;
        if (hipGetDevice(&dev) != hipSuccess || hipDeviceGetAttribute(&cus, hipDeviceAttributeMultiprocessorCount, dev) != hipSuccess) { grid = -1; return; }
        if (hipFuncSetAttribute((const void*)mega_fwd, hipFuncAttributeMaxDynamicSharedMemorySize, LDS_BYTES) != hipSuccess) { fprintf(stderr, "kernel_launch: hipFuncSetAttribute failed\n"); grid = -1; return; }
        if (hipOccupancyMaxActiveBlocksPerMultiprocessor(&per_cu, (const void*)mega_fwd, NTHREADS, LDS_BYTES) != hipSuccess || per_cu < 1) { fprintf(stderr, "kernel_launch: occupancy query says %d\n", per_cu); grid = -1; return; }
        (void)hipGetLastError();
        grid = cus;
    }
    if (grid < 0) return;
    (void)hipMemsetAsync((char*)d_ws + WS_CTL, 0, CTL_ZERO_BYTES, stream);
    Args a{};
    for (int i = 0; i < 28; ++i) a.in[i] = (const float*)d_in[i];
    a.out = (float*)d_out; a.ws = (unsigned char*)d_ws;
    hipLaunchKernelGGL(mega_fwd, dim3(grid), dim3(NTHREADS), LDS_BYTES, stream, a);
}
```

```cpp
#include <hip/hip_runtime.h>
#include <cstdio>
#include <cstdint>
#include <utility>

#ifndef MK_ONE_LAUNCH
#define MK_ONE_LAUNCH 0
#endif

#define GAS __attribute__((address_space(1)))
#define LAS __attribute__((address_space(3)))
typedef unsigned short bf16;
typedef unsigned v4u __attribute__((ext_vector_type(4)));
typedef unsigned v2u __attribute__((ext_vector_type(2)));
typedef float f32x4 __attribute__((ext_vector_type(4)));
typedef float f32x2 __attribute__((ext_vector_type(2)));
typedef short bf16x8 __attribute__((ext_vector_type(8)));

constexpr int NL = 4, DM = 1024, NBATCH = 16, SQ = 2048, CL = 256;
constexpr int ML = NBATCH * SQ, MC = NBATCH * CL, MT = ML + MC;
constexpr int NP = 6144;
constexpr int C_QA = 0, C_KA = 512, C_VA = 1024, C_CQ = 1536, C_CKV = 1792, C_KR = 1920, C_CIN = 2048, C_GT = 3072;
constexpr int NE = 16, CAPL = 256, CAPC = 32, ROWS_E = NBATCH * CAPL + NBATCH * CAPC, MG = NE * ROWS_E;
constexpr float LN_EPS = 1e-5f, RMS_EPS = 1e-6f, DN_ALPHA = 1.681792830507429f;
constexpr int NWAVES = 8, NTHREADS = 512;

constexpr size_t MiB = 1u << 20;
constexpr size_t WS_CTL = 0, CTL_ZERO_BYTES = 1 * MiB;
constexpr size_t WS_MODS = 1 * MiB;
constexpr size_t WS_TAB = 3 * MiB;
constexpr size_t WS_AFF = 4 * MiB;
constexpr size_t WS_SEL = 7 * MiB;
constexpr size_t WS_IDX = 10 * MiB;
constexpr size_t WS_KR = 11 * MiB;
constexpr size_t WS_WIN = 14 * MiB;
constexpr size_t WS_WUQ = 26 * MiB;
constexpr size_t WS_WUKV = 26 * MiB + 512 * 1024;
constexpr size_t WS_WOA = 27 * MiB, WS_WOB = 28 * MiB, WS_WPW2 = 29 * MiB;
constexpr size_t WS_WOUT = 30 * MiB;
constexpr size_t WS_WGU = 32 * MiB;
constexpr size_t WS_WD = 96 * MiB;
constexpr size_t WS_X = 128 * MiB;
constexpr size_t WS_HB = 272 * MiB;
constexpr size_t WS_QB = 344 * MiB;
constexpr size_t WS_KVB = 398 * MiB;
constexpr size_t WS_U = 542 * MiB;
constexpr size_t WS_YA = 470 * MiB;
constexpr size_t WS_YB = 506 * MiB;
constexpr size_t WS_CQN = WS_YB, WS_CKVN = WS_YB + 18 * MiB;
constexpr size_t WS_R = 578 * MiB;
constexpr size_t WS_XG = WS_R, WS_HID = WS_R + 144 * MiB, WS_Y = WS_R + 288 * MiB;
constexpr size_t WS_YP = WS_R;
constexpr size_t WS_STAT = 13 * MiB + 512 * 1024;
constexpr size_t WS_WSET = 996 * MiB;
constexpr size_t WS_END = WS_R + 432 * MiB + 114 * MiB;

constexpr int RING_BYTES = 131072, LDSCTL_OFF = RING_BYTES, MISC_OFF = LDSCTL_OFF + 320, LIDX_OFF = RING_BYTES + 1024, LDS_BYTES = 147456;

#define LDS_WAIT() asm volatile("s_waitcnt lgkmcnt(0)" ::: "memory")
#define VM_WAIT() asm volatile("s_waitcnt vmcnt(0)" ::: "memory")
__device__ __forceinline__ int lane_id() { int r; asm volatile("v_mbcnt_lo_u32_b32 %0, -1, 0\n\tv_mbcnt_hi_u32_b32 %0, -1, %0" : "=v"(r)); return r; }
__device__ __forceinline__ unsigned f2bf(float f) { unsigned u = __builtin_bit_cast(unsigned, f); return (u + 0x7fffu + ((u >> 16) & 1u)) >> 16; }
__device__ __forceinline__ unsigned pk2(float lo, float hi) { unsigned r; asm("v_cvt_pk_bf16_f32 %0, %1, %2" : "=v"(r) : "v"(lo), "v"(hi)); return r; }
__device__ __forceinline__ float bflo(unsigned w) { return __uint_as_float(w << 16); }
__device__ __forceinline__ float bfhi(unsigned w) { return __uint_as_float(w & 0xffff0000u); }
__device__ __forceinline__ float bf2f(bf16 v) { return __uint_as_float(((unsigned)v) << 16); }
template <int O> __device__ __forceinline__ unsigned xshfl_u(unsigned v) {
    if constexpr (O == 32) { const auto t = __builtin_amdgcn_permlane32_swap(v, v, false, false); return (lane_id() & 32) ? t[0] : t[1]; }
    else return (unsigned)__builtin_amdgcn_ds_swizzle((int)v, (O << 10) | 0x1f);
}
template <int O> __device__ __forceinline__ float xshfl(float v) { return __uint_as_float(xshfl_u<O>(__float_as_uint(v))); }
template <int CTRL> __device__ __forceinline__ float dppf(float x) { return __builtin_bit_cast(float, __builtin_amdgcn_mov_dpp(__builtin_bit_cast(int, x), CTRL, 0xf, 0xf, true)); }
__device__ __forceinline__ float wave_sum(float x) {
    x += dppf<0xB1>(x); x += dppf<0x4E>(x); x += dppf<0x141>(x); x += dppf<0x128>(x);
    const auto s = __builtin_amdgcn_permlane16_swap(__float_as_uint(x), __float_as_uint(x), false, false); x = __uint_as_float(s[0]) + __uint_as_float(s[1]);
    const auto t = __builtin_amdgcn_permlane32_swap(__float_as_uint(x), __float_as_uint(x), false, false); return __uint_as_float(t[0]) + __uint_as_float(t[1]);
}
__device__ __forceinline__ float pair32_max(float x) { const auto t = __builtin_amdgcn_permlane32_swap(__float_as_uint(x), __float_as_uint(x), false, false); return fmaxf(__uint_as_float(t[0]), __uint_as_float(t[1])); }
__device__ __forceinline__ float pair32_sum(float x) { const auto t = __builtin_amdgcn_permlane32_swap(__float_as_uint(x), __float_as_uint(x), false, false); return __uint_as_float(t[0]) + __uint_as_float(t[1]); }
__device__ __forceinline__ float sigmoidf_(float x) { return 1.f / (1.f + __expf(-x)); }

namespace pg8 {
constexpr int BM = 256, BK = 64, HALF = 128, HTB = HALF * BK * 2, STAGE_BYTES = 8 * HTB, NXCD = 8, WGM = 8;
__host__ __device__ __forceinline__ int lds_byte(int r, int c) { const int st = (r >> 4) * 2 + (c >> 5), rr = r & 15, cc = c & 31, ob = rr * 64 + cc * 2; return st * 1024 + (ob ^ (((ob >> 9) & 1) << 5)); }
__host__ __device__ __forceinline__ void stage_rc(int b, int& R, int& C) { const int st = b / 1024, sb = b % 1024, swz = sb ^ (((sb >> 9) & 1) << 5); R = (st >> 1) * 16 + swz / 64; C = (st & 1) * 32 + (swz % 64) / 2; }

__host__ __device__ __forceinline__ int perm32(int rho) { const int n = rho >> 4, i = rho & 15; return 8 * (i >> 2) + 4 * n + (i & 3); }
struct Unit { int pm, pn, sg; };

template <int SEG> struct Order {
    int nM, nN, nwg, G, c, md;
    __device__ __forceinline__ void init(int nM_, int nN_, int G_, int c_, int md_ = 0) { nM = nM_; nN = nN_; nwg = nM * nN; G = G_; c = c_; md = md_; }
    __device__ __forceinline__ bool next(int i, Unit& u) const {
        const int it = i / SEG; u.sg = i - it * SEG;
        const long L = (long)it * G + c; if (L >= nwg) return false;
        int wgid = (int)L; { const int q = nwg / NXCD, r = nwg % NXCD, xcd = wgid % NXCD, off = wgid / NXCD; wgid = (xcd < r ? xcd * (q + 1) : r * (q + 1) + (xcd - r) * q) + off; }
        const int nig = WGM * nN, gid = wgid / nig, fm = gid * WGM, gsz = (nM - fm) < WGM ? (nM - fm) : WGM;
        u.pm = fm + ((wgid % nig) % gsz); u.pn = (wgid % nig) / gsz;
        if (md > 0) u.pm = (u.pm / md) * 18 + (u.pm % md);
        return true;
    }
};

template <class Prob, class Epi, class Sched>
__device__ __forceinline__ void gemm_phase(LAS unsigned char* lds, const Prob& P, const Sched& S, const Epi& E, int wid) {
    int lane_ = lane_id(); asm volatile("" : "+v"(lane_));
    const int lane = lane_, tid = wid * 64 + lane, wr = wid >> 2, wc = wid & 3, fr = lane & 15, fq = lane >> 4;
    const int K = P.K, nt = K / BK;
    unsigned voffA[2][2], voffN[2][2], voffB[2]; int stR[2], stC[2];
#pragma unroll
    for (int i = 0; i < 2; ++i) { stage_rc(tid * 16 + i * 8192, stR[i], stC[i]); const int Rb = (stR[i] & ~31) + perm32(stR[i] & 31); voffB[i] = (unsigned)(Rb * P.ldb + stC[i]) * 2u; }
    const size_t kstep = (size_t)(BK * 2);
    const size_t hstepB = (size_t)HALF * P.ldb * 2;
#define PG8_AOFF(dst, u) do { _Pragma("unroll") for (int h_ = 0; h_ < 2; ++h_) _Pragma("unroll") for (int i_ = 0; i_ < 2; ++i_) \
        dst[h_][i_] = (unsigned)(P.arow(u, h_ * HALF + stR[i_]) * P.lda + stC[i_]) * 2u; } while (0)
    const unsigned ldsw = (unsigned)wid * 1024u;
    const int aoff = lds_byte(wr * 64 + fr, fq * 8), boff = lds_byte(wc * 32 + fr, fq * 8);
#define PG8_SA(b, h) (((b) * 2 + (h)) * HTB)
#define PG8_SB(b, h) ((4 + (b) * 2 + (h)) * HTB)
#define PG8_STAGE(bufoff, gbase, voff) do { _Pragma("unroll") for (int _i = 0; _i < 2; ++_i) \
        __builtin_amdgcn_global_load_lds((const unsigned*)((const char*)(gbase) + (voff)[_i]), (LAS unsigned*)(lds + (bufoff) + ldsw + _i * 8192), 16, 0, 0); } while (0)
#define PG8_LDA(dst, b, h) do { _Pragma("unroll") for (int m = 0; m < 4; ++m) _Pragma("unroll") for (int k = 0; k < 2; ++k) dst[m][k] = *(const LAS bf16x8*)(lds + PG8_SA(b, h) + aoff + m * 2048 + k * 1024); } while (0)
#define PG8_LDB(dst, b, h) do { _Pragma("unroll") for (int n = 0; n < 2; ++n) _Pragma("unroll") for (int k = 0; k < 2; ++k) dst[n][k] = *(const LAS bf16x8*)(lds + PG8_SB(b, h) + boff + n * 2048 + k * 1024); } while (0)
#define PG8_MMA(ai, bj, At, Bt) do { __builtin_amdgcn_s_setprio(1); _Pragma("unroll") for (int m = 0; m < 4; ++m) _Pragma("unroll") for (int n = 0; n < 2; ++n) _Pragma("unroll") for (int k = 0; k < 2; ++k) \
        acc[ai][bj][m][n] = __builtin_amdgcn_mfma_f32_16x16x32_bf16(Bt[n][k], At[m][k], acc[ai][bj][m][n], 0, 0, 0); __builtin_amdgcn_s_setprio(0); } while (0)
#define PG8_WAIT_V(n) asm volatile("s_waitcnt vmcnt(" #n ")" ::: "memory")
#define PG8_WAIT_L(n) asm volatile("s_waitcnt lgkmcnt(" #n ")" ::: "memory")
#define PG8_BAR __builtin_amdgcn_s_barrier()
#define PG8_SCHED __builtin_amdgcn_sched_barrier(0)
    Unit cur, nxt; int ui = 0;
    if (!S.next(0, cur)) return;
    f32x4 acc[2][2][4][2];
#pragma unroll
    for (int a = 0; a < 2; ++a)
#pragma unroll
        for (int b = 0; b < 2; ++b)
#pragma unroll
            for (int m = 0; m < 4; ++m)
#pragma unroll
                for (int n = 0; n < 2; ++n) acc[a][b][m][n] = (f32x4){0.f, 0.f, 0.f, 0.f};
    bf16x8 At[4][2], B0[2][2], B1[2][2];
    const char* cA = P.ap(cur); const char* cB = P.bp(cur);
    PG8_AOFF(voffA, cur);
    PG8_STAGE(PG8_SB(0, 0), cB, voffB); PG8_STAGE(PG8_SB(0, 1), cB + hstepB, voffB); PG8_STAGE(PG8_SA(0, 0), cA, voffA[0]); PG8_STAGE(PG8_SA(0, 1), cA, voffA[1]);
    if (wr == 1) PG8_BAR;
    PG8_WAIT_V(2); PG8_BAR;
    PG8_STAGE(PG8_SB(1, 0), cB + kstep, voffB); PG8_STAGE(PG8_SA(1, 0), cA + kstep, voffA[0]); PG8_STAGE(PG8_SB(1, 1), cB + hstepB + kstep, voffB);
    PG8_WAIT_V(6); PG8_BAR;
    for (;;) {
        const bool has_next = S.next(ui + 1, nxt);
        const char* nA = has_next ? P.ap(nxt) : cA; const char* nB = has_next ? P.bp(nxt) : cB;
        if constexpr (Prob::GATHER) { if (has_next) PG8_AOFF(voffN, nxt); else { _Pragma("unroll") for (int h_ = 0; h_ < 2; ++h_) _Pragma("unroll") for (int i_ = 0; i_ < 2; ++i_) voffN[h_][i_] = voffA[h_][i_]; } }
        for (int t = 0; t < nt; t += 2) {
            const bool last = (t == nt - 2);
            const char* a1 = cA + (size_t)(t + 1) * kstep;
            const char* a2 = last ? nA : cA + (size_t)(t + 2) * kstep; const char* b2 = last ? nB : cB + (size_t)(t + 2) * kstep;
            const char* a3 = a2 + kstep; const char* b3 = b2 + kstep;
            unsigned vo2[2][2];
#pragma unroll
            for (int h_ = 0; h_ < 2; ++h_)
#pragma unroll
                for (int i_ = 0; i_ < 2; ++i_) vo2[h_][i_] = (Prob::GATHER && last) ? voffN[h_][i_] : voffA[h_][i_];
            PG8_LDB(B0, 0, 0); PG8_LDB(B1, 0, 1); PG8_SCHED; PG8_LDA(At, 0, 0); PG8_STAGE(PG8_SA(1, 1), a1, voffA[1]);
            PG8_WAIT_V(8); PG8_WAIT_L(0); PG8_BAR; PG8_MMA(0, 0, At, B0); PG8_MMA(0, 1, At, B1); PG8_BAR; PG8_SCHED;
            PG8_LDA(At, 0, 1); PG8_STAGE(PG8_SB(0, 0), b2, voffB); PG8_STAGE(PG8_SB(0, 1), b2 + hstepB, voffB); PG8_STAGE(PG8_SA(0, 0), a2, vo2[0]);
            PG8_WAIT_V(8); PG8_WAIT_L(0); PG8_BAR; PG8_MMA(1, 0, At, B0); PG8_MMA(1, 1, At, B1); PG8_BAR; PG8_SCHED;
            PG8_LDB(B0, 1, 0); PG8_LDB(B1, 1, 1); PG8_SCHED; PG8_LDA(At, 1, 0); PG8_STAGE(PG8_SA(0, 1), a2, vo2[1]);
            PG8_WAIT_V(8); PG8_WAIT_L(0); PG8_BAR; PG8_MMA(0, 0, At, B0); PG8_MMA(0, 1, At, B1); PG8_BAR; PG8_SCHED;
            PG8_LDA(At, 1, 1); PG8_STAGE(PG8_SB(1, 0), b3, voffB); PG8_STAGE(PG8_SB(1, 1), b3 + hstepB, voffB); PG8_STAGE(PG8_SA(1, 0), a3, vo2[0]);
            PG8_WAIT_V(8); PG8_WAIT_L(0); PG8_BAR; PG8_MMA(1, 0, At, B0); PG8_MMA(1, 1, At, B1); PG8_BAR; PG8_SCHED;
        }
        if (wr == 0) PG8_BAR;
        const bool z = E(acc, cur, wr, wc, fr, fq);
        if (!has_next) break;
        if (z) {
#pragma unroll
            for (int a = 0; a < 2; ++a)
#pragma unroll
                for (int b = 0; b < 2; ++b)
#pragma unroll
                    for (int m = 0; m < 4; ++m)
#pragma unroll
                        for (int n = 0; n < 2; ++n) acc[a][b][m][n] = (f32x4){0.f, 0.f, 0.f, 0.f};
        }
        cur = nxt; cA = nA; cB = nB; ++ui;
        if constexpr (Prob::GATHER) { _Pragma("unroll") for (int h_ = 0; h_ < 2; ++h_) _Pragma("unroll") for (int i_ = 0; i_ < 2; ++i_) voffA[h_][i_] = voffN[h_][i_]; }
        if (wr == 1) PG8_BAR;
    }
    PG8_WAIT_V(0);
    PG8_BAR;
#undef PG8_AOFF
#undef PG8_SA
#undef PG8_SB
#undef PG8_STAGE
#undef PG8_LDA
#undef PG8_LDB
#undef PG8_MMA
#undef PG8_WAIT_V
#undef PG8_WAIT_L
#undef PG8_BAR
#undef PG8_SCHED
}

struct ProbPlain { static constexpr bool GATHER = false; const bf16* A; const bf16* B; int K, lda, ldb;
    __device__ __forceinline__ const char* ap(const Unit& u) const { return (const char*)(A + (size_t)u.pm * 256 * lda); }
    __device__ __forceinline__ int arow(const Unit&, int rr) const { return rr; }
    __device__ __forceinline__ const char* bp(const Unit& u) const { return (const char*)(B + (size_t)u.pn * 256 * ldb); } };
struct ProbSeg3 { static constexpr bool GATHER = false; const bf16* A; const bf16* B; int K, lda, ldb; size_t sA, sB;
    __device__ __forceinline__ const char* ap(const Unit& u) const { return (const char*)(A + (size_t)u.sg * sA + (size_t)u.pm * 256 * lda); }
    __device__ __forceinline__ int arow(const Unit&, int rr) const { return rr; }
    __device__ __forceinline__ const char* bp(const Unit& u) const { return (const char*)(B + (size_t)u.sg * sB + (size_t)u.pn * 256 * ldb); } };
struct ProbUp2 { static constexpr bool GATHER = false; const bf16* A0; const bf16* A1; const bf16* B0; const bf16* B1; int K, lda, ldb;
    __device__ __forceinline__ const char* ap(const Unit& u) const { return (const char*)((u.sg ? A1 : A0) + (size_t)u.pm * 256 * lda); }
    __device__ __forceinline__ int arow(const Unit&, int rr) const { return rr; }
    __device__ __forceinline__ const char* bp(const Unit& u) const { return (const char*)((u.sg ? B1 : B0) + (size_t)u.pn * 256 * ldb); } };
struct OrderUp2 { int n0, nwg, G, c, nM0;
    __device__ __forceinline__ void init(int nM0_, int G_, int c_) { nM0 = nM0_; n0 = nM0_ * 3; nwg = n0 + (MT / 256) * 4; G = G_; c = c_; }
    __device__ __forceinline__ bool next(int i, Unit& u) const { const int L = i * G + c; if (L >= nwg) return false;
        if (L < n0) { u.sg = 0; u.pm = L / 3; u.pn = L - u.pm * 3; } else { const int r = L - n0; u.sg = 1; u.pm = r >> 2; u.pn = r & 3; } return true; } };
struct OrderWinLast { int G, c;
    __device__ __forceinline__ void init(int G_, int c_) { G = G_; c = c_; }
    __device__ __forceinline__ bool next(int i, Unit& u) const { const int L = i * G + c; u.sg = 0; if (L >= 128 * 24 + 16 * 5) return false;
        if (L < 128 * 24) { const int g = L / (8 * 24), q = L - g * 8 * 24; u.pm = g * 8 + (q & 7); u.pn = q >> 3; }
        else { const int r = L - 128 * 24, t = r % 5; u.pm = 128 + r / 5; u.pn = t < 4 ? 2 + t : 7; } return true; } };
struct ProbMoE { static constexpr bool GATHER = false; const bf16* A; const bf16* B; int K, lda, ldb; int nrowsB;
    __device__ __forceinline__ const char* ap(const Unit& u) const { return (const char*)(A + (size_t)u.pm * 256 * lda); }
    __device__ __forceinline__ int arow(const Unit&, int rr) const { return rr; }
    __device__ __forceinline__ const char* bp(const Unit& u) const { return (const char*)(B + ((size_t)(u.pm / 18) * nrowsB + (size_t)u.pn * 256) * ldb); } };
struct ProbMoEGather { static constexpr bool GATHER = true; const bf16* A; const bf16* B; const LAS int* lidx; int K, lda, ldb; int nrowsB;
    __device__ __forceinline__ const char* ap(const Unit&) const { return (const char*)A; }
    __device__ __forceinline__ int arow(const Unit& u, int rr) const { return lidx[u.sg * 256 + rr]; }
    __device__ __forceinline__ const char* bp(const Unit& u) const { return (const char*)(B + ((size_t)(u.pm / 18) * nrowsB + (size_t)u.pn * 256) * ldb); } };
struct OrderOrd { Order<1> o;
    __device__ __forceinline__ bool next(int i, Unit& u) const { const bool r = o.next(i, u); u.sg = i; return r; } };

#define EPI_ROWS(...) _Pragma("unroll") for (int ai = 0; ai < 2; ++ai) _Pragma("unroll") for (int m = 0; m < 4; ++m) { const int row = u.pm * 256 + ai * 128 + wr * 64 + m * 16 + fr; __VA_ARGS__ }
#define EPI_COLS8(...) _Pragma("unroll") for (int bj = 0; bj < 2; ++bj) { const int col = u.pn * 256 + bj * 128 + wc * 32 + 8 * fq; __VA_ARGS__ }
#define EPI_LANE() int t_ = lane_id(); asm volatile("" : "+v"(t_)); const int fr = t_ & 15, fq = t_ >> 4
__device__ __forceinline__ v4u pack8(const f32x4& a, const f32x4& b) { v4u w; w.x = pk2(a[0], a[1]); w.y = pk2(a[2], a[3]); w.z = pk2(b[0], b[1]); w.w = pk2(b[2], b[3]); return w; }
__device__ __forceinline__ f32x4 unpack4(v2u w) { return (f32x4){bflo(w.x), bfhi(w.x), bflo(w.y), bfhi(w.y)}; }
struct EpiBf16 { bf16* O; int ldc;
    __device__ __forceinline__ bool operator()(f32x4 (&acc)[2][2][4][2], const Unit& u, int wr, int wc, int fr_, int fq_) const {
        EPI_LANE();
        EPI_ROWS( bf16* rp = O + (size_t)row * ldc; EPI_COLS8( *(v4u*)(rp + col) = pack8(acc[ai][bj][m][0], acc[ai][bj][m][1]); ) )
        return true; } };
__device__ __forceinline__ f32x4 sigmoid4(const f32x4& v) { return (f32x4){__builtin_amdgcn_rcpf(1.f + __expf(-v[0])), __builtin_amdgcn_rcpf(1.f + __expf(-v[1])), __builtin_amdgcn_rcpf(1.f + __expf(-v[2])), __builtin_amdgcn_rcpf(1.f + __expf(-v[3]))}; }
struct EpiUp2 { bf16* O0; bf16* O1;
    __device__ __forceinline__ bool operator()(f32x4 (&acc)[2][2][4][2], const Unit& u, int wr, int wc, int fr_, int fq_) const {
        EPI_LANE();
        bf16* O = u.sg ? O1 : O0; const int ldc = u.sg ? 1024 : 768;
        EPI_ROWS( bf16* rp = O + (size_t)row * ldc; EPI_COLS8( *(v4u*)(rp + col) = pack8(acc[ai][bj][m][0], acc[ai][bj][m][1]); ) )
        return true; } };
struct EpiWin { bf16* O;
    __device__ __forceinline__ bool operator()(f32x4 (&acc)[2][2][4][2], const Unit& u, int wr, int wc, int fr_, int fq_) const {
        EPI_LANE();
        const bool sg = u.pn >= 10;
        EPI_ROWS( bf16* rp = O + (size_t)row * NP; EPI_COLS8( f32x4 v0 = acc[ai][bj][m][0], v1 = acc[ai][bj][m][1];
            if (sg) { v0 = sigmoid4(v0); v1 = sigmoid4(v1); }
            *(v4u*)(rp + col) = pack8(v0, v1); ) )
        return true; } };
__device__ __forceinline__ f32x4 gate_ratio(v2u a, v2u b, bool fin) { const f32x4 x = unpack4(a), y = unpack4(b);
    return (f32x4){x[0] * (fin ? 1.f : __builtin_amdgcn_rcpf(fmaxf(y[0], 1e-20f))), x[1] * (fin ? 1.f : __builtin_amdgcn_rcpf(fmaxf(y[1], 1e-20f))), x[2] * (fin ? 1.f : __builtin_amdgcn_rcpf(fmaxf(y[2], 1e-20f))), x[3] * (fin ? 1.f : __builtin_amdgcn_rcpf(fmaxf(y[3], 1e-20f)))}; }
struct EpiMerge { const bf16* PROJ; bf16* O;
    __device__ __forceinline__ bool operator()(f32x4 (&acc)[2][2][4][2], const Unit& u, int wr, int wc, int fr_, int fq_) const {
        EPI_LANE();
        const int sg = u.sg; const bool fin = sg == 2; const int sgb = fin ? 2 : sg + 1;
        _Pragma("unroll") for (int ai = 0; ai < 2; ++ai) {
            _Pragma("unroll") for (int m = 0; m < 4; ++m) { const int row = u.pm * 256 + ai * 128 + wr * 64 + m * 16 + fr;
                const bf16* gp = PROJ + (size_t)row * NP + C_GT; bf16* rp = O + (size_t)row * DM;
                EPI_COLS8( const v4u ga = *(const v4u*)(gp + sg * 1024 + col), gb = *(const v4u*)(gp + sgb * 1024 + col);
                    const f32x4 v0 = acc[ai][bj][m][0] * gate_ratio((v2u){ga.x, ga.y}, (v2u){gb.x, gb.y}, fin), v1 = acc[ai][bj][m][1] * gate_ratio((v2u){ga.z, ga.w}, (v2u){gb.z, gb.w}, fin);
                    acc[ai][bj][m][0] = v0; acc[ai][bj][m][1] = v1;
                    if (fin) *(v4u*)(rp + col) = pack8(v0, v1); ) }
            asm volatile("" ::: "memory"); }
        return fin; } };
struct EpiSwiGLU { bf16* HID;
    __device__ __forceinline__ bool operator()(f32x4 (&acc)[2][2][4][2], const Unit& u, int wr, int wc, int fr_, int fq_) const {
        EPI_LANE();
        EPI_ROWS( bf16* rp = HID + (size_t)row * 1024 + u.pn * 128 + wc * 32 + 8 * fq; f32x4 h[2];
            _Pragma("unroll") for (int n = 0; n < 2; ++n) { const f32x4 g = acc[ai][0][m][n], up = acc[ai][1][m][n];
                h[n] = (f32x4){g[0] * __builtin_amdgcn_rcpf(1.f + __expf(-g[0])) * up[0], g[1] * __builtin_amdgcn_rcpf(1.f + __expf(-g[1])) * up[1], g[2] * __builtin_amdgcn_rcpf(1.f + __expf(-g[2])) * up[2], g[3] * __builtin_amdgcn_rcpf(1.f + __expf(-g[3])) * up[3]}; }
            *(v4u*)rp = pack8(h[0], h[1]); )
        return true; } };
}

#define XB_TMO      128
#define XB_XCNT(j)  (256  + 64 * (j))
#define XB_XSUB(j)  (1280 + 64 * (j))
#define XB_XGEN(j)  (2304 + 64 * (j))
#define XB_TOP      3328
#define XB_TOPGEN   3392
#define XCD_BAR_WORDS 3456
#define XB_SPIN_CAP (1u << 22)
__device__ __forceinline__ unsigned xb_ld(unsigned* p)              { return __hip_atomic_load(p, __ATOMIC_RELAXED, __HIP_MEMORY_SCOPE_AGENT); }
__device__ __forceinline__ unsigned xb_add(unsigned* p, unsigned v) { return __hip_atomic_fetch_add(p, v, __ATOMIC_RELAXED, __HIP_MEMORY_SCOPE_AGENT); }
__device__ __forceinline__ unsigned xb_xcc_id() { return (unsigned)__builtin_amdgcn_s_getreg((3 << 11) | 20) & 0xFu; }
#define XB_SPIN(cond, bar) do { unsigned _sp = 0; while (cond) { __builtin_amdgcn_s_sleep(1); \
    if ((++_sp & 255u) == 0u) { if (xb_ld(&(bar)[XB_TMO])) break; if (_sp > XB_SPIN_CAP) { atomicAdd(&(bar)[XB_TMO], 1u); break; } } } } while (0)
struct XcdBarrier { unsigned* bar; unsigned x; volatile LAS unsigned* st; int wv; };
__device__ __forceinline__ XcdBarrier xcd_barrier_post(unsigned* bar, volatile LAS unsigned* st, int wv) {
    XcdBarrier b; b.bar = bar; b.x = xb_xcc_id(); b.st = st; b.wv = wv;
    if (wv == 0 && lane_id() == 0) (void)xb_add(&bar[XB_XCNT(b.x)], 1u);
    return b;
}
__device__ __forceinline__ void xcd_barrier_complete(unsigned* bar, unsigned x, unsigned& nloc, unsigned& nx) {
    const unsigned G = gridDim.x * gridDim.y * gridDim.z;
    unsigned sum, cnt, mine, sp = 0u;
    for (;;) {
        sum = 0u; cnt = 0u; mine = 0u;
#pragma unroll
        for (unsigned j = 0; j < 16; ++j) { const unsigned c = xb_ld(&bar[XB_XCNT(j)]); sum += c; cnt += (c > 0u) ? 1u : 0u; mine = (j == x) ? c : mine; }
        if (sum == G) break;
        __builtin_amdgcn_s_sleep(1);
        if ((++sp & 255u) == 0u) { if (xb_ld(&bar[XB_TMO])) break; if (sp > XB_SPIN_CAP) { atomicAdd(&bar[XB_TMO], 1u); break; } }
    }
    nloc = mine > 0u ? mine : 1u; nx = cnt > 0u ? cnt : 1u;
}
__device__ __forceinline__ void xcd_barrier(const XcdBarrier& b) {
    asm volatile("s_waitcnt vmcnt(0)" ::: "memory");
    __syncthreads();
    if (b.wv == 0 && lane_id() == 0) {
        unsigned* bar = b.bar; unsigned bx_ = b.x; asm volatile("" : "+s"(bx_)); asm volatile("" : "+s"(bar));
        __builtin_amdgcn_s_waitcnt(0);
        unsigned nloc = b.st[0], nx = b.st[1];
        if (nloc == 0u) { xcd_barrier_complete(bar, bx_, nloc, nx); b.st[0] = nloc; b.st[1] = nx; }
        const unsigned old = xb_add(&bar[XB_XSUB(bx_)], 1u);
        const unsigned gen = old / nloc;
        if (old + 1u == (gen + 1u) * nloc) {
            __builtin_amdgcn_fence(__ATOMIC_RELEASE, "agent");
            asm volatile("s_waitcnt vmcnt(0)" ::: "memory");
            const unsigned og = xb_add(&bar[XB_TOP], 1u);
            const unsigned tg = og / nx;
            if (og + 1u == (tg + 1u) * nx) xb_add(&bar[XB_TOPGEN], 1u);
            else XB_SPIN(xb_ld(&bar[XB_TOPGEN]) == tg, bar);
            __builtin_amdgcn_fence(__ATOMIC_ACQUIRE, "agent");
            xb_add(&bar[XB_XGEN(bx_)], 1u);
            asm volatile("s_waitcnt vmcnt(0)" ::: "memory");
        } else {
            XB_SPIN(xb_ld(&bar[XB_XGEN(bx_)]) == gen, bar);
            __builtin_amdgcn_fence(__ATOMIC_ACQUIRE, "agent");
            asm volatile("s_waitcnt vmcnt(0)" ::: "memory");
        }
    }
    __syncthreads();
}

struct Args { const float* in[28]; float* out; unsigned char* ws; };
enum { I_X = 0, I_C, I_CTX, I_CCTX, I_WADA, I_BADA, I_WIN, I_GQ, I_WUQ, I_GKV, I_WUKV, I_RPB, I_WDW, I_BDW, I_GCN, I_BCN, I_WPW2, I_WOA, I_WOB, I_WOUT, I_LN1G, I_LN1B, I_WROUTER, I_WGATE, I_WUP, I_WDOWN, I_LN2G, I_LN2B };

#define OPAQUE(v) asm volatile("" : "+v"(v))
struct Ctx {
    LAS unsigned char* lds;
    int tid, lane, wave, G, bid;
    const float* const* in;
    unsigned char* ws;
    float* out;
};
#define INP(i) ((const float*)(const GAS float*)C.in[i])
#define WSP(T, off) ((T*)(C.ws + (off)))
#define WSW(T, off, l) ((T*)(C.ws + (off) + (size_t)((l) & 1) * WS_WSET))

struct CwD { const float* src; bf16* db; int N, ld, kind, add, n0; };
__device__ __forceinline__ void cw_decode(const Ctx& C, int l, int it, CwD& d) {
    constexpr int I_IN = 16 * 189, I_UQ = 4 * 24, I_UKV = 2 * 32, I_PW = 8 * 32, I_OUT = 16 * 32, I_EX = 16 * 32;
    int r = it; d.kind = 0; d.add = 0;
    if (r < I_IN) { const int kb = r / 189, nb = r % 189; d.src = INP(I_WIN) + (size_t)l * 1024 * 6048 + (size_t)(kb * 64) * 6048 + nb * 32; d.N = 6048; d.db = WSW(bf16, WS_WIN, l) + kb * 64; d.ld = 1024; d.kind = 1; d.n0 = nb * 32; return; } r -= I_IN;
    if (r < I_UQ) { const int kb = r / 24, nb = r % 24; d.src = INP(I_WUQ) + (size_t)l * 256 * 768 + (size_t)(kb * 64) * 768 + nb * 32; d.N = 768; d.db = WSW(bf16, WS_WUQ, l) + kb * 64; d.ld = 256; d.n0 = nb * 32; return; } r -= I_UQ;
    if (r < I_UKV) { const int kb = r / 32, nb = r % 32; d.src = INP(I_WUKV) + (size_t)l * 128 * 1024 + (size_t)(kb * 64) * 1024 + nb * 32; d.N = 1024; d.db = WSW(bf16, WS_WUKV, l) + kb * 64; d.ld = 256; d.n0 = nb * 32; return; } r -= I_UKV;
    if (r < 3 * I_PW) { const int w = r / I_PW, q = r % I_PW, kb = q / 32, nb = q % 32;
        d.src = (w == 0 ? INP(I_WPW2) : (w == 1 ? INP(I_WOA) : INP(I_WOB))) + (size_t)l * 512 * 1024 + (size_t)(kb * 64) * 1024 + nb * 32; d.N = 1024;
        d.db = WSW(bf16, w == 0 ? WS_WPW2 : (w == 1 ? WS_WOA : WS_WOB), l) + kb * 64; d.ld = 512; d.n0 = nb * 32; return; } r -= 3 * I_PW;
    if (r < I_OUT) { const int kb = r / 32, nb = r % 32; d.src = INP(I_WOUT) + (size_t)l * 1024 * 1024 + (size_t)(kb * 64) * 1024 + nb * 32; d.N = 1024; d.db = WSW(bf16, WS_WOUT, l) + kb * 64; d.ld = 1024; d.n0 = nb * 32; return; } r -= I_OUT;
    { const int mat = r / I_EX, q = r % I_EX, kb = q / 32, nb = q % 32, w = mat / 16, e = mat % 16;
      d.src = (w == 0 ? INP(I_WGATE) : (w == 1 ? INP(I_WUP) : INP(I_WDOWN))) + ((size_t)l * 16 + e) * 1024 * 1024 + (size_t)(kb * 64) * 1024 + nb * 32; d.N = 1024; d.ld = 1024; d.n0 = nb * 32;
      if (w < 2) { d.db = WSW(bf16, WS_WGU, l) + (size_t)e * 2048 * 1024 + kb * 64; d.kind = 2; d.add = w * 128; }
      else d.db = WSW(bf16, WS_WD, l) + (size_t)e * 1024 * 1024 + kb * 64; }
}
__device__ __forceinline__ void cw_load(const CwD& d, int lane, f32x4 (&v)[8]) {
#pragma unroll
    for (int i = 0; i < 8; ++i) { const int kk = 8 * i + (lane >> 3), nn = (lane & 7) * 4; v[i] = __builtin_nontemporal_load((const f32x4*)(d.src + (size_t)kk * d.N + nn)); }
}
__device__ __forceinline__ void cw_store(const CwD& d, const f32x4 (&v)[8], LAS float* scr, int lane) {
#pragma unroll
    for (int i = 0; i < 8; ++i) { const int kk = 8 * i + (lane >> 3), nn = (lane & 7) * 4;
        scr[kk * 33 + nn] = v[i][0]; scr[kk * 33 + nn + 1] = v[i][1]; scr[kk * 33 + nn + 2] = v[i][2]; scr[kk * 33 + nn + 3] = v[i][3]; }
    LDS_WAIT(); asm volatile("" ::: "memory");
    const int c = lane & 7;
#pragma unroll
    for (int j = 0; j < 4; ++j) { const int nl = (lane >> 3) + 8 * j; const LAS float* s = scr + (8 * c) * 33 + nl;
        v4u o; o.x = pk2(s[0 * 33], s[1 * 33]); o.y = pk2(s[2 * 33], s[3 * 33]); o.z = pk2(s[4 * 33], s[5 * 33]); o.w = pk2(s[6 * 33], s[7 * 33]);
        const int n = d.n0 + nl; int row = n; if (d.kind == 1) row = n < 1952 ? n : n + 96; if (d.kind == 2) row = (n >> 7) * 256 + (n & 127) + d.add;
        __builtin_nontemporal_store(o, (v4u*)(d.db + (size_t)row * d.ld + 8 * c)); }
    LDS_WAIT(); asm volatile("" ::: "memory");
}

__device__ __forceinline__ void conv_weights(const Ctx& Cc, int l, int f0, int f1, int wg0, int nwg) {
    Ctx C = Cc; C.lane = lane_id(); C.tid = C.wave * 64 + C.lane;
    LAS float* scr = (LAS float*)(C.lds + C.wave * 16384);
    if (C.bid < wg0) return;
    const int gw = (C.bid - wg0) * NWAVES + C.wave, NGW = nwg * NWAVES;
    constexpr int NITEMS = 16 * 189 + 4 * 24 + 2 * 32 + 3 * 8 * 32 + 16 * 32 + 48 * 16 * 32;
    bf16* WinT = WSW(bf16, WS_WIN, l);
    const int it0 = (int)((long)NITEMS * f0 / 100), it1 = (int)((long)NITEMS * f1 / 100);
    {
        CwD cur, nxt; f32x4 buf[8]; int it = it0 + gw;
        if (it < it1) { cw_decode(C, l, it, cur); cw_load(cur, C.lane, buf); }
        for (; it < it1; it += NGW) {
            f32x4 v[8];
#pragma unroll
            for (int i = 0; i < 8; ++i) v[i] = buf[i];
            const bool more = it + NGW < it1;
            if (more) { cw_decode(C, l, it + NGW, nxt); cw_load(nxt, C.lane, buf); }
            cw_store(cur, v, scr, C.lane);
            if (more) cur = nxt;
        }
    }
    if (f0 != 0) return;
    const int gt = (C.bid - wg0) * NTHREADS + C.tid, NGT = nwg * NTHREADS;
    unsigned zz_ = 0u; asm volatile("" : "+v"(zz_)); const v4u z = (v4u){zz_, zz_, zz_, zz_};
    for (int i = gt; i < 96 * 128; i += NGT) *((v4u*)(WinT + (size_t)1952 * 1024) + i) = z;
    for (int i = gt; i < 1024 * 16; i += NGT) { const int n = i >> 4, c = i & 15; *((v4u*)(WSW(bf16, WS_WUKV, l) + (size_t)n * 256 + 128) + c) = z; }
}

__device__ __forceinline__ void phase_mods(const Ctx& Cc) {
    Ctx C = Cc; OPAQUE(C.lane); OPAQUE(C.tid);
    LAS float* sc = (LAS float*)C.lds;
    LAS float* red = (LAS float*)(C.lds + 69632);
    for (int idx = C.tid; idx < 17 * 1024; idx += NTHREADS) { const int r = idx >> 10, k = idx & 1023; const float v = r < 16 ? INP(I_C)[r * 1024 + k] : INP(I_CCTX)[k]; sc[idx] = v / (1.f + __expf(-v)); }
    __syncthreads();
    float* MODS = WSP(float, WS_MODS);
    for (int item = C.bid; item < NL * 96; item += C.G) {
        const int l = item / 96, cb = item % 96, col = cb * 64 + C.lane;
        const float* W = INP(I_WADA) + (size_t)l * 1024 * 6144;
        float acc[17];
#pragma unroll
        for (int r = 0; r < 17; ++r) acc[r] = 0.f;
        for (int k = C.wave * 128; k < C.wave * 128 + 128; k += 4) { const float w0 = W[(size_t)k * 6144 + col], w1 = W[(size_t)(k + 1) * 6144 + col], w2 = W[(size_t)(k + 2) * 6144 + col], w3 = W[(size_t)(k + 3) * 6144 + col];
#pragma unroll
            for (int r = 0; r < 17; ++r) { const f32x4 sv = *(const LAS f32x4*)(sc + r * 1024 + k); acc[r] += (sv[0] * w0 + sv[1] * w1) + (sv[2] * w2 + sv[3] * w3); } }
#pragma unroll
        for (int r = 0; r < 17; ++r) red[(C.wave * 17 + r) * 64 + C.lane] = acc[r];
        __syncthreads();
        for (int o = C.tid; o < 17 * 64; o += NTHREADS) { const int r = o >> 6, cl = o & 63; float s = INP(I_BADA)[l * 6144 + cb * 64 + cl];
#pragma unroll
            for (int w = 0; w < 8; ++w) s += red[(w * 17 + r) * 64 + cl];
            MODS[((size_t)l * 17 + r) * 6144 + cb * 64 + cl] = s; }
        __syncthreads();
    }
    float* TAB = WSP(float, WS_TAB);
    const int gt = C.bid * NTHREADS + C.tid, NGT = C.G * NTHREADS;
    for (int idx = gt; idx < 2048 * 16; idx += NGT) { const int t = idx >> 4, j = idx & 15, which = j >> 3, i = j & 7;
        const float pos = (float)(which ? (t & 63) : (t >> 6)), invf = exp2f(-(float)i * (13.287712379549449f / 8.f)), ang = pos * invf;
        TAB[t * 32 + which * 16 + i] = __cosf(ang); TAB[t * 32 + which * 16 + 8 + i] = __sinf(ang); }
}

__device__ __forceinline__ void phase_mod0(const Ctx& Cc) {
    Ctx C = Cc; OPAQUE(C.lane);
    const int gw = C.bid * NWAVES + C.wave, NGW = C.G * NWAVES;
    const float* MODS = WSP(float, WS_MODS); float* X = WSP(float, WS_X); bf16* H = WSP(bf16, WS_HB);
    for (int row = gw; row < MT; row += NGW) {
        const float* src = row < ML ? INP(I_X) + (size_t)row * DM : INP(I_CTX) + (size_t)(row - ML) * DM;
        const int mr = row < ML ? (row >> 11) : 16; const float* md = MODS + (size_t)mr * 6144;
#pragma unroll
        for (int j = 0; j < 2; ++j) { const int c0 = 8 * (C.lane + 64 * j); f32x4 h[2];
#pragma unroll
            for (int q = 0; q < 2; ++q) { const int c = c0 + 4 * q; const f32x4 xv = *(const f32x4*)(src + c), sh = *(const f32x4*)(md + c), scl = *(const f32x4*)(md + 1024 + c);
                h[q] = xv * (scl + 1.f) + sh; }
            *(v4u*)(H + (size_t)row * DM + c0) = pg8::pack8(h[0], h[1]); }
    }
}

__device__ __forceinline__ void phase_prep(const Ctx& C, int l) {
    int lane = C.lane; OPAQUE(lane); const int gw = C.bid * NWAVES + C.wave, NGW = C.G * NWAVES;
    const bf16* PROJ = WSP(bf16, WS_R); bf16* CQN = WSP(bf16, WS_CQN); bf16* CKVN = WSP(bf16, WS_CKVN); bf16* KR = WSP(bf16, WS_KR);
    const float* TAB = WSP(float, WS_TAB);
    const f32x4 gq = *(const f32x4*)(INP(I_GQ) + l * 256 + 4 * lane); const f32x2 gkv = *(const f32x2*)(INP(I_GKV) + l * 128 + 2 * lane);
    for (int row = gw; row < MT; row += NGW) {
        const bf16* p = PROJ + (size_t)row * NP;
        { const v2u w = *(const v2u*)(p + C_CQ + 4 * lane); const float x0 = bflo(w.x), x1 = bfhi(w.x), x2 = bflo(w.y), x3 = bfhi(w.y);
          const float ss = wave_sum(x0 * x0 + x1 * x1 + x2 * x2 + x3 * x3), r = 1.f / sqrtf(ss * (1.f / 256.f) + RMS_EPS);
          v2u o; o.x = pk2(x0 * r * gq[0], x1 * r * gq[1]); o.y = pk2(x2 * r * gq[2], x3 * r * gq[3]); *(v2u*)(CQN + (size_t)row * 256 + 4 * lane) = o; }
        { const unsigned w = *(const unsigned*)(p + C_CKV + 2 * lane); const float x0 = bflo(w), x1 = bfhi(w);
          const float ss = wave_sum(x0 * x0 + x1 * x1), r = 1.f / sqrtf(ss * (1.f / 128.f) + RMS_EPS);
          *(unsigned*)(CKVN + (size_t)row * 256 + 2 * lane) = pk2(x0 * r * gkv[0], x1 * r * gkv[1]); *(unsigned*)(CKVN + (size_t)row * 256 + 128 + 2 * lane) = 0u; }
        if (lane < 16) { const int gi = lane >> 3, i = lane & 7; const float x1 = bf2f(p[C_KR + gi * 16 + i]), x2 = bf2f(p[C_KR + gi * 16 + 8 + i]); float o1 = x1, o2 = x2;
          if (row < ML) { const int t = row & 2047; const float cs = TAB[t * 32 + gi * 16 + i], sn = TAB[t * 32 + gi * 16 + 8 + i]; o1 = x1 * cs - x2 * sn; o2 = x2 * cs + x1 * sn; }
          KR[(size_t)row * 32 + gi * 16 + i] = (bf16)f2bf(o1); KR[(size_t)row * 32 + gi * 16 + 8 + i] = (bf16)f2bf(o2); }
    }
}

__device__ __forceinline__ void phase_conv(const Ctx& C, int l) {
    int tid = C.tid; OPAQUE(tid); const int lane = tid & 63, w = C.wave;
    LAS float* Wt = (LAS float*)C.lds;
    LAS unsigned char* Xt = C.lds + 63488;
    const bf16* PROJ = WSP(bf16, WS_R); bf16* U = WSP(bf16, WS_U);
    { const float* wdw = INP(I_WDW) + (size_t)l * 31 * 512;
      for (int i = tid; i < 31 * 128; i += NTHREADS) { const int j = i >> 7, c4 = i & 127, ln = c4 >> 1, hf = c4 & 1; *(LAS f32x4*)(Wt + ((j * 2 + hf) * 64 + ln) * 4) = *(const f32x4*)(wdw + j * 512 + 4 * c4); } }
    const f32x4 bd0 = *(const f32x4*)(INP(I_BDW) + l * 512 + 8 * lane), bd1 = *(const f32x4*)(INP(I_BDW) + l * 512 + 8 * lane + 4);
    const f32x4 gc0 = *(const f32x4*)(INP(I_GCN) + l * 512 + 8 * lane), gc1 = *(const f32x4*)(INP(I_GCN) + l * 512 + 8 * lane + 4);
    const f32x4 bc0 = *(const f32x4*)(INP(I_BCN) + l * 512 + 8 * lane), bc1 = *(const f32x4*)(INP(I_BCN) + l * 512 + 8 * lane + 4);
    const int ntile = (l == NL - 1 ? ML : MT) / 32;
    for (int tile = C.bid; tile < ntile; tile += C.G) {
        const int r0 = tile * 32, t0 = r0 < ML ? (r0 & 2047) : ((r0 - ML) & 255), L = r0 < ML ? 2048 : 256;
#pragma unroll
        for (int it = 0; it < 8; ++it) { const int idx = tid + 512 * it, rr = idx >> 6, ch = idx & 63, tt = t0 - 15 + rr;
            if (rr < 62) { v4u o = (v4u){0u, 0u, 0u, 0u};
                if (tt >= 0 && tt < L) { const bf16* p = PROJ + (size_t)(r0 - 15 + rr) * NP + C_CIN + 8 * ch; const v4u a = *(const v4u*)p, g = *(const v4u*)(p + 512);
                    o.x = pk2(bflo(a.x) * bflo(g.x), bfhi(a.x) * bfhi(g.x)); o.y = pk2(bflo(a.y) * bflo(g.y), bfhi(a.y) * bfhi(g.y));
                    o.z = pk2(bflo(a.z) * bflo(g.z), bfhi(a.z) * bfhi(g.z)); o.w = pk2(bflo(a.w) * bflo(g.w), bfhi(a.w) * bfhi(g.w)); }
                *(LAS v4u*)(Xt + rr * 1024 + ch * 16) = o; } }
        __syncthreads();
        f32x4 a0[4], a1[4];
#pragma unroll
        for (int tk = 0; tk < 4; ++tk) { a0[tk] = bd0; a1[tk] = bd1; }
        f32x4 wq0[4], wq1[4];
#pragma unroll
        for (int d = 0; d < 4; ++d) { wq0[d] = (f32x4){0.f, 0.f, 0.f, 0.f}; wq1[d] = (f32x4){0.f, 0.f, 0.f, 0.f}; }
#pragma unroll
        for (int rr = 0; rr < 34; ++rr) {
            if (rr <= 30) { wq0[0] = *(const LAS f32x4*)(Wt + ((rr * 2 + 0) * 64 + lane) * 4); wq1[0] = *(const LAS f32x4*)(Wt + ((rr * 2 + 1) * 64 + lane) * 4); }
            else { wq0[0] = (f32x4){0.f, 0.f, 0.f, 0.f}; wq1[0] = (f32x4){0.f, 0.f, 0.f, 0.f}; }
            const v4u g = *(const LAS v4u*)(Xt + (4 * w + rr) * 1024 + lane * 16);
            const f32x4 x0 = (f32x4){bflo(g.x), bfhi(g.x), bflo(g.y), bfhi(g.y)}, x1 = (f32x4){bflo(g.z), bfhi(g.z), bflo(g.w), bfhi(g.w)};
#pragma unroll
            for (int tk = 0; tk < 4; ++tk) { const int j = rr - tk; if (j >= 0 && j <= 30) { a0[tk] = a0[tk] + x0 * wq0[tk]; a1[tk] = a1[tk] + x1 * wq1[tk]; } }
            wq0[3] = wq0[2]; wq0[2] = wq0[1]; wq0[1] = wq0[0]; wq1[3] = wq1[2]; wq1[2] = wq1[1]; wq1[1] = wq1[0];
        }
#pragma unroll
        for (int tk = 0; tk < 4; ++tk) { f32x4 x0 = a0[tk], x1 = a1[tk];
            const float mean = wave_sum((x0[0] + x0[1]) + (x0[2] + x0[3]) + (x1[0] + x1[1]) + (x1[2] + x1[3])) * (1.f / 512.f);
            x0 = x0 - mean; x1 = x1 - mean;
            const float var = wave_sum((x0[0] * x0[0] + x0[1] * x0[1]) + (x0[2] * x0[2] + x0[3] * x0[3]) + (x1[0] * x1[0] + x1[1] * x1[1]) + (x1[2] * x1[2] + x1[3] * x1[3])) * (1.f / 512.f);
            const float rstd = 1.f / sqrtf(var + LN_EPS);
            f32x4 y0 = x0 * rstd * gc0 + bc0, y1 = x1 * rstd * gc1 + bc1;
#pragma unroll
            for (int q = 0; q < 4; ++q) { y0[q] = y0[q] / (1.f + __expf(-y0[q])); y1[q] = y1[q] / (1.f + __expf(-y1[q])); }
            v4u o; o.x = pk2(y0[0], y0[1]); o.y = pk2(y0[2], y0[3]); o.z = pk2(y1[0], y1[1]); o.w = pk2(y1[2], y1[3]);
            *(v4u*)(U + (size_t)(r0 + 4 * w + tk) * 512 + 8 * lane) = o; }
        __syncthreads();
    }
}

typedef float f32x16 __attribute__((ext_vector_type(16)));
typedef short v4i16 __attribute__((ext_vector_type(4)));
#define MFMA32(a, b, c) __builtin_amdgcn_mfma_f32_32x32x16_bf16(a, b, c, 0, 0, 0)
constexpr int AT_KBUF = 13312, AT_VBUF = 8192;
constexpr int AT_K0 = 0, AT_V0 = 3 * AT_KBUF, AT_RPB = AT_V0 + 3 * AT_VBUF, AT_QR = AT_RPB + 15 * 128 * 4, AT_END = AT_QR + 8 * 4096;
static_assert(AT_END <= RING_BYTES, "attention LDS map");
template <int MODE> __device__ __forceinline__ void attn_unit(const Ctx& C, int l, int unit) {
    constexpr bool MLA = MODE < 2; constexpr int DQK = MLA ? 96 : 64, KC = DQK / 8, KS = DQK / 16, RS = DQK * 2 + 16, NCH = 64 * KC + 512;
    constexpr int QT = (MODE == 0 || MODE == 2) ? 2 : 1;
    const int w = C.wave, lane = lane_id(), tid = w * 64 + lane, r = lane & 31, hh = lane >> 5;
    const bf16* PROJ = WSP(bf16, WS_R); const bf16* QB = WSP(bf16, WS_QB); const bf16* KVB = WSP(bf16, WS_KVB); const bf16* KR = WSP(bf16, WS_KR); const float* TAB = WSP(float, WS_TAB);
    bf16* Yo = WSP(bf16, MLA ? WS_YB : WS_YA);
    LAS unsigned char* lds = C.lds;
    int b, hd, q0, T, NB = 0, rs_min = 0, gi = 0;
    if (MODE == 0) { hd = unit & 7; const int qb = (unit >> 3) & 3; b = unit >> 5; q0 = b * 2048 + qb * 512; T = 36; }
    else if (MODE == 2) { hd = unit & 7; const int ib = (unit >> 3) & 3; b = unit >> 5; q0 = b * 2048 + ib * 512; gi = ib * 8 + w;
        rs_min = min(max(ib * 8 - 4, 0), 24); const int rs_max = min(max(ib * 8 + 3, 0), 24); NB = rs_max - rs_min + 8; T = NB + 4; }
    else { hd = unit & 7; b = unit >> 3; q0 = ML + b * 256; T = 4; }
    const int qrow0 = q0 + 32 * QT * w + r;
    constexpr int NKQ = (64 * (KC + 1)) / 64, NQ = NKQ + 8;
    auto tile_row0 = [&](int t) -> int {
        if (MODE == 0) return t < 4 ? ML + b * 256 + 64 * t : b * 2048 + 64 * (t - 4);
        if (MODE == 2) return t < NB ? b * 2048 + (rs_min + t) * 64 : ML + b * 256 + 64 * (t - NB);
        return ML + b * 256 + 64 * t; };
    int goff[3]; bool gkr[3]; int dblk[3]; bool dk[3];
#pragma unroll
    for (int j = 0; j < 3; ++j) { int q_ = w + 8 * j; if (q_ >= NQ) q_ -= 8; gkr[j] = false; dk[j] = q_ < NKQ; dblk[j] = (q_ < NKQ ? q_ : q_ - NKQ) * 1024;
        if (q_ < NKQ) { const int p_ = 64 * q_ + lane, key_ = p_ / (KC + 1), kc0_ = p_ - key_ * (KC + 1), kc_ = kc0_ == KC ? 0 : kc0_;
            if (MLA) { if (kc_ < 8) goff[j] = key_ * 1024 + hd * 128 + 8 * kc_; else { goff[j] = key_ * 32 + 8 * (kc_ - 8); gkr[j] = true; } } else goff[j] = key_ * NP + C_KA + hd * 64 + 8 * kc_; }
        else { const int p_ = 64 * (q_ - NKQ) + lane, dh_ = p_ >> 8, key_ = (p_ >> 2) & 63, vc_ = dh_ * 4 + (p_ & 3);
            goff[j] = MLA ? key_ * 1024 + hd * 128 + 64 + 8 * vc_ : key_ * NP + C_VA + hd * 64 + 8 * vc_; } }
#define AT_ISSUE(t, slot) do { const int row0_ = tile_row0(t); const bf16* bm_ = MLA ? KVB + (size_t)row0_ * 1024 : PROJ + (size_t)row0_ * NP; const bf16* br_ = KR + (size_t)row0_ * 32; \
        _Pragma("unroll") for (int j = 0; j < 3; ++j) { const bf16* g_ = ((MLA && gkr[j]) ? br_ : bm_) + goff[j]; \
            LAS unsigned char* d_ = lds + (dk[j] ? AT_K0 + (slot) * AT_KBUF : AT_V0 + (slot) * AT_VBUF) + dblk[j]; \
            __builtin_amdgcn_global_load_lds((const unsigned*)g_, (LAS unsigned*)d_, 16, 0, 0); } } while (0)
    constexpr int KSR = (MODE == 0) ? 4 : KS;
    bf16x8 qf[QT][KSR];
    LAS unsigned char* qrl = lds + AT_QR + w * 4096 + lane * 16;
#pragma unroll
    for (int qt = 0; qt < QT; ++qt) { const int qrow = qrow0 + 32 * qt;
        const bf16* qp = MLA ? QB + (size_t)qrow * 768 + hd * 96 : PROJ + (size_t)qrow * NP + C_QA + hd * 64;
#pragma unroll
        for (int ks = 0; ks < KSR; ++ks) qf[qt][ks] = *(const bf16x8*)(qp + 16 * ks + 8 * hh);
        if (MODE == 0) {
            const float* tb = TAB + (size_t)(qrow & 2047) * 32;
#pragma unroll
            for (int g = 0; g < 2; ++g) { const v4u own = *(const v4u*)(qp + 16 * (4 + g) + 8 * hh); v4u oth; oth.x = xshfl_u<32>(own.x); oth.y = xshfl_u<32>(own.y); oth.z = xshfl_u<32>(own.z); oth.w = xshfl_u<32>(own.w);
                const f32x4 c0 = *(const f32x4*)(tb + g * 16), c1 = *(const f32x4*)(tb + g * 16 + 4), s0 = *(const f32x4*)(tb + g * 16 + 8), s1 = *(const f32x4*)(tb + g * 16 + 12);
                const float sg = hh ? 1.f : -1.f; v4u nw;
                nw.x = pk2(bflo(own.x) * c0[0] + sg * bflo(oth.x) * s0[0], bfhi(own.x) * c0[1] + sg * bfhi(oth.x) * s0[1]); nw.y = pk2(bflo(own.y) * c0[2] + sg * bflo(oth.y) * s0[2], bfhi(own.y) * c0[3] + sg * bfhi(oth.y) * s0[3]);
                nw.z = pk2(bflo(own.z) * c1[0] + sg * bflo(oth.z) * s1[0], bfhi(own.z) * c1[1] + sg * bfhi(oth.z) * s1[1]); nw.w = pk2(bflo(own.w) * c1[2] + sg * bflo(oth.w) * s1[2], bfhi(own.w) * c1[3] + sg * bfhi(oth.w) * s1[3]);
                *(LAS v4u*)(qrl + (qt * 2 + g) * 1024) = nw; }
        } }
    if (MODE == 2) {
        LAS float* rt = (LAS float*)(lds + AT_RPB); const float* rpb = INP(I_RPB) + ((size_t)l * 8 + hd) * 15 * 31;
        for (int i = tid; i < 15 * 128; i += NTHREADS) { const int dr = i >> 7, dc = (i & 127) - 64; rt[i] = (dc >= -15 && dc <= 15) ? rpb[dr * 31 + dc + 15] * 1.4426950408889634f : 0.f; }
        asm volatile("s_waitcnt vmcnt(0) lgkmcnt(0)" ::: "memory");
    }
    constexpr float C2 = (MLA ? 0.10206207261596577f : 0.125f) * 1.4426950408889634f;
    f32x16 o[QT][2]; float m_[QT], l_[QT];
#pragma unroll
    for (int qt = 0; qt < QT; ++qt) { m_[qt] = -1e30f; l_[qt] = 0.f;
#pragma unroll
        for (int i = 0; i < 16; ++i) { o[qt][0][i] = 0.f; o[qt][1][i] = 0.f; } }
    const int rs_w = min(max(gi - 4, 0), 24);
    const int kroff = r * RS + hh * 16;
    const int vroff = ((lane >> 4) & 1) * 32 + ((lane & 15) >> 2) * 64 + (lane & 3) * 8 + hh * 4 * 64;
    AT_ISSUE(0, 0); AT_ISSUE(1, 1);
    int buf = 0, nbuf = 2;
    for (int t = 0; t < T; ++t) {
        if (t + 1 < T) asm volatile("s_waitcnt vmcnt(3)" ::: "memory"); else asm volatile("s_waitcnt vmcnt(0)" ::: "memory");
        __builtin_amdgcn_s_barrier(); asm volatile("" ::: "memory");
        if (t + 2 < T) AT_ISSUE(t + 2, nbuf);
        bool active = true; int kr = 0;
        if (MODE == 2 && t < NB) { kr = rs_min + t; active = (kr >= rs_w) && (kr < rs_w + 8); }
        if (active) {
            const LAS unsigned char* kb = lds + AT_K0 + buf * AT_KBUF + kroff; const LAS unsigned char* vb = lds + AT_V0 + buf * AT_VBUF + vroff;
            const bool band = (MODE == 2) && (t < NB);
#pragma unroll
            for (int kt = 0; kt < 2; ++kt) {
                if constexpr (QT == 2) { if (!band) {
                    const LAS unsigned char* kbt = kb + kt * 32 * RS;
                    auto qfrag = [&](int qt, int ks) -> bf16x8 { if (ks < KSR) return qf[qt][ks < KSR ? ks : 0]; return *(const LAS bf16x8*)(qrl + (qt * 2 + (ks - 4)) * 1024); };
                    auto softmax_nb = [&](f32x16& sv, int qt, bf16x8 (&pfo)[2], float& alpha) {
                        float mx = -1e30f, ps = 0.f;
#pragma unroll
                        for (int i = 0; i < 16; ++i) mx = fmaxf(mx, sv[i]);
                        mx = pair32_max(mx) * C2;
                        const float mn = fmaxf(m_[qt], mx); alpha = __builtin_amdgcn_exp2f(m_[qt] - mn); m_[qt] = mn;
#pragma unroll
                        for (int sx = 0; sx < 2; ++sx) { unsigned a[4];
#pragma unroll
                            for (int jj = 0; jj < 4; ++jj) { const int i = 8 * sx + 2 * jj;
                                const float p0 = __builtin_amdgcn_exp2f(fmaf(sv[i], C2, -mn)), p1 = __builtin_amdgcn_exp2f(fmaf(sv[i + 1], C2, -mn));
                                ps += p0 + p1; a[jj] = pk2(p0, p1); }
                            pfo[sx] = __builtin_bit_cast(bf16x8, (v4u){a[0], a[1], a[2], a[3]}); }
                        l_[qt] = l_[qt] * alpha + ps; };
                    f32x16 sA, sB;
#pragma unroll
                    for (int i = 0; i < 16; ++i) { sA[i] = 0.f; sB[i] = 0.f; }
                    bf16x8 kfr[KS];
#pragma unroll
                    for (int ks = 0; ks < KS; ++ks) { kfr[ks & 3] = *(const LAS bf16x8*)(kbt + ks * 32); sA = MFMA32(kfr[ks & 3], qfrag(0, ks), sA); }
                    __builtin_amdgcn_sched_barrier(0);
                    bf16x8 pfA[2], pfB[2]; float alA, alB;
                    bf16x8 kq[KS]; bf16x8 qq[KS];
#pragma unroll
                    for (int ks = 0; ks < KS; ++ks) { kq[ks] = *(const LAS bf16x8*)(kbt + ks * 32); qq[ks] = qfrag(1, ks); }
                    __builtin_amdgcn_sched_barrier(0);
#pragma unroll
                    for (int ks = 0; ks < KS; ++ks) sB = MFMA32(kq[ks], qq[ks], sB);
                    softmax_nb(sA, 0, pfA, alA);
#pragma unroll
                    for (int g = 0; g < KS; ++g) { __builtin_amdgcn_sched_group_barrier(0x008, 1, 0); __builtin_amdgcn_sched_group_barrier(0x002, 14, 0); }
                    __builtin_amdgcn_sched_barrier(0);
                    if (!__all(alA == 1.f)) {
#pragma unroll
                        for (int i = 0; i < 16; ++i) { o[0][0][i] *= alA; o[0][1][i] *= alA; } }
                    bf16x8 va[2], vc[2];
#pragma unroll
                    for (int sx = 0; sx < 2; ++sx) { const int rowb = (32 * kt + 16 * sx) * 64;
                        const v4i16 a00 = __builtin_amdgcn_ds_read_tr16_b64_v4i16((LAS v4i16*)(vb + rowb)), a01 = __builtin_amdgcn_ds_read_tr16_b64_v4i16((LAS v4i16*)(vb + rowb + 8 * 64));
                        const v4i16 a10 = __builtin_amdgcn_ds_read_tr16_b64_v4i16((LAS v4i16*)(vb + 4096 + rowb)), a11 = __builtin_amdgcn_ds_read_tr16_b64_v4i16((LAS v4i16*)(vb + 4096 + rowb + 8 * 64));
                        va[sx] = __builtin_shufflevector(a00, a01, 0, 1, 2, 3, 4, 5, 6, 7); vc[sx] = __builtin_shufflevector(a10, a11, 0, 1, 2, 3, 4, 5, 6, 7); }
                    __builtin_amdgcn_sched_barrier(0);
#pragma unroll
                    for (int sx = 0; sx < 2; ++sx) { o[0][0] = MFMA32(va[sx], pfA[sx], o[0][0]); o[0][1] = MFMA32(vc[sx], pfA[sx], o[0][1]); }
                    softmax_nb(sB, 1, pfB, alB);
#pragma unroll
                    for (int g = 0; g < 4; ++g) { __builtin_amdgcn_sched_group_barrier(0x008, 1, 0); __builtin_amdgcn_sched_group_barrier(0x002, 20, 0); }
                    __builtin_amdgcn_sched_barrier(0);
                    if (!__all(alB == 1.f)) {
#pragma unroll
                        for (int i = 0; i < 16; ++i) { o[1][0][i] *= alB; o[1][1][i] *= alB; } }
#pragma unroll
                    for (int sx = 0; sx < 2; ++sx) { o[1][0] = MFMA32(va[sx], pfB[sx], o[1][0]); o[1][1] = MFMA32(vc[sx], pfB[sx], o[1][1]); }
                    continue;
                } }
                f32x16 sc[QT];
#pragma unroll
                for (int qt = 0; qt < QT; ++qt)
#pragma unroll
                    for (int i = 0; i < 16; ++i) sc[qt][i] = 0.f;
#pragma unroll
                for (int ks = 0; ks < KS; ++ks) { const bf16x8 ka = *(const LAS bf16x8*)(kb + kt * 32 * RS + ks * 32);
#pragma unroll
                    for (int qt = 0; qt < QT; ++qt) { bf16x8 qb_; if (ks < KSR) qb_ = qf[qt][ks < KSR ? ks : 0]; else qb_ = *(const LAS bf16x8*)(qrl + (qt * 2 + (ks - 4)) * 1024);
                        sc[qt] = MFMA32(ka, qb_, sc[qt]); } }
                bf16x8 pf[QT][2];
#pragma unroll
                for (int qt = 0; qt < QT; ++qt) {
                    f32x16& s0 = sc[qt]; float mx = -1e30f, ps = 0.f, alpha;
                    if ((MODE == 2) && band) {
                        const bool part = qt != kt;
                        const int ilo = part ? (qt == 0 ? 0 : 12) : 0, ihi = part ? ilo + 4 : 16, sxv = qt == 0 ? 0 : 1;
                        const int ccol = 32 * qt + r; int cs = min(max(ccol - 8, 0), 48); asm volatile("" : "+v"(cs));
                        const LAS float* rt = (const LAS float*)(lds + AT_RPB) + (kr - gi + 7) * 128 + 64 - ccol + 32 * kt;
                        float bv[16];
#pragma unroll
                        for (int i = 0; i < 16; ++i) if (i >= ilo && i < ihi) bv[i] = rt[(i & 3) + 8 * (i >> 2) + 4 * hh];
#pragma unroll
                        for (int i = 0; i < 16; ++i) if (i >= ilo && i < ihi) { const int k0 = 32 * kt + (i & 3) + 8 * (i >> 2) + 4 * hh; const bool v0 = (k0 >= cs) && (k0 < cs + 16);
                            s0[i] = v0 ? fmaf(s0[i], C2, bv[i]) : -__builtin_inff(); mx = fmaxf(mx, s0[i]); }
                        mx = pair32_max(mx);
                        const float mn = fmaxf(m_[qt], mx); alpha = __builtin_amdgcn_exp2f(m_[qt] - mn); m_[qt] = mn;
#pragma unroll
                        for (int sx = 0; sx < 2; ++sx) { if (part && sx != sxv) continue;
                            unsigned a[4];
#pragma unroll
                            for (int jj = 0; jj < 4; ++jj) { const int i = 8 * sx + 2 * jj;
                                if (!(i >= ilo && i < ihi)) { a[jj] = 0u; continue; }
                                const float p0 = __builtin_amdgcn_exp2f(s0[i] - mn), p1 = __builtin_amdgcn_exp2f(s0[i + 1] - mn);
                                ps += p0 + p1; a[jj] = pk2(p0, p1); }
                            pf[qt][sx] = __builtin_bit_cast(bf16x8, (v4u){a[0], a[1], a[2], a[3]}); }
                    } else {
#pragma unroll
                        for (int i = 0; i < 16; ++i) mx = fmaxf(mx, s0[i]);
                        mx = pair32_max(mx) * C2;
                        const float mn = fmaxf(m_[qt], mx); alpha = __builtin_amdgcn_exp2f(m_[qt] - mn); m_[qt] = mn;
#pragma unroll
                        for (int sx = 0; sx < 2; ++sx) { unsigned a[4];
#pragma unroll
                            for (int jj = 0; jj < 4; ++jj) { const int i = 8 * sx + 2 * jj;
                                const float p0 = __builtin_amdgcn_exp2f(fmaf(s0[i], C2, -mn)), p1 = __builtin_amdgcn_exp2f(fmaf(s0[i + 1], C2, -mn));
                                ps += p0 + p1; a[jj] = pk2(p0, p1); }
                            pf[qt][sx] = __builtin_bit_cast(bf16x8, (v4u){a[0], a[1], a[2], a[3]}); }
                    }
                    l_[qt] = l_[qt] * alpha + ps;
                    if (!__all(alpha == 1.f)) {
#pragma unroll
                        for (int i = 0; i < 16; ++i) { o[qt][0][i] *= alpha; o[qt][1][i] *= alpha; } }
                }
#pragma unroll
                for (int sx = 0; sx < 2; ++sx) {
                    const int rowb = (32 * kt + 16 * sx) * 64;
                    const v4i16 a00 = __builtin_amdgcn_ds_read_tr16_b64_v4i16((LAS v4i16*)(vb + rowb)), a01 = __builtin_amdgcn_ds_read_tr16_b64_v4i16((LAS v4i16*)(vb + rowb + 8 * 64));
                    const v4i16 a10 = __builtin_amdgcn_ds_read_tr16_b64_v4i16((LAS v4i16*)(vb + 4096 + rowb)), a11 = __builtin_amdgcn_ds_read_tr16_b64_v4i16((LAS v4i16*)(vb + 4096 + rowb + 8 * 64));
                    const bf16x8 va = __builtin_shufflevector(a00, a01, 0, 1, 2, 3, 4, 5, 6, 7), vc = __builtin_shufflevector(a10, a11, 0, 1, 2, 3, 4, 5, 6, 7);
#pragma unroll
                    for (int qt = 0; qt < QT; ++qt) { if ((MODE == 2) && band && (qt != kt) && sx != (qt == 0 ? 0 : 1)) continue;
                        o[qt][0] = MFMA32(va, pf[qt][sx], o[qt][0]); o[qt][1] = MFMA32(vc, pf[qt][sx], o[qt][1]); } }
            }
        }
        buf = buf == 2 ? 0 : buf + 1; nbuf = nbuf == 2 ? 0 : nbuf + 1;
    }
#pragma unroll
    for (int qt = 0; qt < QT; ++qt) {
        const float lt = pair32_sum(l_[qt]), inv = 1.f / lt;
        bf16* op = Yo + (size_t)(qrow0 + 32 * qt) * 512 + hd * 64 + 4 * hh;
#pragma unroll
        for (int g4 = 0; g4 < 4; ++g4) { v2u w0, w1; w0.x = pk2(o[qt][0][4 * g4] * inv, o[qt][0][4 * g4 + 1] * inv); w0.y = pk2(o[qt][0][4 * g4 + 2] * inv, o[qt][0][4 * g4 + 3] * inv);
            w1.x = pk2(o[qt][1][4 * g4] * inv, o[qt][1][4 * g4 + 1] * inv); w1.y = pk2(o[qt][1][4 * g4 + 2] * inv, o[qt][1][4 * g4 + 3] * inv);
            *(v2u*)(op + 8 * g4) = w0; *(v2u*)(op + 32 + 8 * g4) = w1; } }
    __syncthreads();
#undef AT_ISSUE
}
__device__ __forceinline__ void phase_attn(const Ctx& C, int l) {
    { int b_ = C.bid; asm volatile("" : "+s"(b_)); if (l < NL - 1 && (b_ & 3) == 0) { conv_weights(C, l + 1, 0, 100, 0, C.G); __syncthreads(); } }
    for (int u = C.bid; u < 512; u += C.G) attn_unit<0>(C, l, u);
    { int b_ = C.bid; asm volatile("" : "+s"(b_)); if (l < NL - 1 && (b_ & 3) == 1) { conv_weights(C, l + 1, 0, 100, 0, C.G); __syncthreads(); } }
    for (int u = C.bid; u < 512; u += C.G) attn_unit<2>(C, l, u);
    { int b_ = C.bid; asm volatile("" : "+s"(b_)); if (l < NL - 1 && (b_ & 3) == 2) { conv_weights(C, l + 1, 0, 100, 0, C.G); __syncthreads(); } }
    if (l < NL - 1) for (int u = C.bid; u < 256; u += C.G) { if (u < 128) attn_unit<1>(C, l, u); else attn_unit<3>(C, l, u - 128); }
    { int b_ = C.bid; asm volatile("" : "+s"(b_)); if (l < NL - 1 && (b_ & 3) == 3) { conv_weights(C, l + 1, 0, 100, 0, C.G); __syncthreads(); } }
}

__device__ __forceinline__ float reduce16(float (&v)[16], int lane) {
#pragma unroll
    for (int i = 0; i < 8; ++i) { const bool hi = lane & 32; const float keep = hi ? v[i + 8] : v[i], send = hi ? v[i] : v[i + 8]; v[i] = keep + xshfl<32>(send); }
#pragma unroll
    for (int i = 0; i < 4; ++i) { const bool hi = lane & 16; const float keep = hi ? v[i + 4] : v[i], send = hi ? v[i] : v[i + 4]; v[i] = keep + xshfl<16>(send); }
#pragma unroll
    for (int i = 0; i < 2; ++i) { const bool hi = lane & 8; const float keep = hi ? v[i + 2] : v[i], send = hi ? v[i] : v[i + 2]; v[i] = keep + xshfl<8>(send); }
    { const bool hi = lane & 4; const float keep = hi ? v[1] : v[0], send = hi ? v[0] : v[1]; v[0] = keep + xshfl<4>(send); }
    v[0] += xshfl<2>(v[0]); v[0] += xshfl<1>(v[0]);
    return v[0];
}
__device__ __forceinline__ void phase_ln1(const Ctx& C, int l) {
    int lane = C.lane; OPAQUE(lane); const int gw = C.bid * NWAVES + C.wave, NGW = C.G * NWAVES;
    LAS float* Wr = (LAS float*)C.lds;
    const float* wr = INP(I_WROUTER) + (size_t)l * 1024 * 16;
    for (int idx = C.tid; idx < 16384; idx += NTHREADS) { const int c = idx >> 4, e = idx & 15; Wr[e * 1024 + c] = wr[idx]; }
    __syncthreads();
    const bf16* Yb = WSP(bf16, WS_YP); const float* X = WSP(float, WS_X); bf16* H2 = WSP(bf16, WS_HB); float* AFF = WSP(float, WS_AFF); float* STAT = WSP(float, WS_STAT);
    const float* XI = INP(I_X); const float* XC = INP(I_CTX) - (size_t)ML * DM;
    const float* MODS = WSP(float, WS_MODS) + (size_t)l * 17 * 6144;
    const float* lg = INP(I_LN1G) + l * 1024; const float* lb = INP(I_LN1B) + l * 1024;
    const int myexp = ((lane >> 5) & 1) * 8 + ((lane >> 4) & 1) * 4 + ((lane >> 3) & 1) * 2 + ((lane >> 2) & 1);
    const int nrp = (l == NL - 1 ? ML : MT) / 2;
    f32x4 nx[2][4]; v4u ny[2][2];
#define LN1_LOAD(rp_) do { const int r_ = 2 * (rp_); const float* xs_ = (l == 0 ? (r_ < ML ? XI : XC) : X) + (size_t)r_ * DM; _Pragma("unroll") for (int j = 0; j < 2; ++j) { const int c = 8 * (lane + 64 * j); \
        nx[0][2 * j] = *(const f32x4*)(xs_ + c); nx[0][2 * j + 1] = *(const f32x4*)(xs_ + c + 4); nx[1][2 * j] = *(const f32x4*)(xs_ + DM + c); nx[1][2 * j + 1] = *(const f32x4*)(xs_ + DM + c + 4); \
        ny[0][j] = *(const v4u*)(Yb + (size_t)r_ * DM + c); ny[1][j] = *(const v4u*)(Yb + (size_t)(r_ + 1) * DM + c); } } while (0)
    if (gw < nrp) LN1_LOAD(gw);
    for (int rp = gw; rp < nrp; rp += NGW) {
        const int row = 2 * rp; const int mr = row < ML ? (row >> 11) : 16; const float* md = MODS + (size_t)mr * 6144;
        f32x4 v[2][4]; float sa = 0.f, sb = 0.f;
#pragma unroll
        for (int j = 0; j < 2; ++j) { const int c = 8 * (lane + 64 * j); const f32x4 g1a = *(const f32x4*)(md + 2048 + c), g1b = *(const f32x4*)(md + 2048 + c + 4);
            v[0][2 * j] = nx[0][2 * j] * DN_ALPHA + g1a * pg8::unpack4((v2u){ny[0][j].x, ny[0][j].y}); v[0][2 * j + 1] = nx[0][2 * j + 1] * DN_ALPHA + g1b * pg8::unpack4((v2u){ny[0][j].z, ny[0][j].w});
            v[1][2 * j] = nx[1][2 * j] * DN_ALPHA + g1a * pg8::unpack4((v2u){ny[1][j].x, ny[1][j].y}); v[1][2 * j + 1] = nx[1][2 * j + 1] * DN_ALPHA + g1b * pg8::unpack4((v2u){ny[1][j].z, ny[1][j].w}); }
        if (rp + NGW < nrp) LN1_LOAD(rp + NGW);
#pragma unroll
        for (int j = 0; j < 4; ++j) { sa += (v[0][j][0] + v[0][j][1]) + (v[0][j][2] + v[0][j][3]); sb += (v[1][j][0] + v[1][j][1]) + (v[1][j][2] + v[1][j][3]); }
        const float mean0 = wave_sum(sa) * (1.f / 1024.f), mean1 = wave_sum(sb) * (1.f / 1024.f); float qa = 0.f, qb = 0.f;
#pragma unroll
        for (int j = 0; j < 4; ++j) { v[0][j] = v[0][j] - mean0; v[1][j] = v[1][j] - mean1;
            qa += (v[0][j][0] * v[0][j][0] + v[0][j][1] * v[0][j][1]) + (v[0][j][2] * v[0][j][2] + v[0][j][3] * v[0][j][3]);
            qb += (v[1][j][0] * v[1][j][0] + v[1][j][1] * v[1][j][1]) + (v[1][j][2] * v[1][j][2] + v[1][j][3] * v[1][j][3]); }
        const float rstd0 = 1.f / sqrtf(wave_sum(qa) * (1.f / 1024.f) + LN_EPS), rstd1 = 1.f / sqrtf(wave_sum(qb) * (1.f / 1024.f) + LN_EPS);
        if (lane == 0) *(f32x4*)(STAT + (size_t)row * 2) = (f32x4){mean0, rstd0, mean1, rstd1};
        float lg0[16], lg1[16];
#pragma unroll
        for (int e = 0; e < 16; ++e) { lg0[e] = 0.f; lg1[e] = 0.f; }
#pragma unroll
        for (int j = 0; j < 2; ++j) { const int c0 = 8 * (lane + 64 * j); f32x4 ha[2], hb[2];
#pragma unroll
            for (int h = 0; h < 2; ++h) { const int c = c0 + 4 * h;
                const f32x4 gg = *(const f32x4*)(lg + c), bb = *(const f32x4*)(lb + c), scl = *(const f32x4*)(md + 4096 + c) + 1.f, shf = *(const f32x4*)(md + 3072 + c);
                const f32x4 xa = v[0][2 * j + h] * rstd0 * gg + bb, xb = v[1][2 * j + h] * rstd1 * gg + bb;
                ha[h] = xa * scl + shf; hb[h] = xb * scl + shf; }
            *(v4u*)(H2 + (size_t)row * DM + c0) = pg8::pack8(ha[0], ha[1]); *(v4u*)(H2 + (size_t)(row + 1) * DM + c0) = pg8::pack8(hb[0], hb[1]);
#pragma unroll
            for (int h = 0; h < 2; ++h) {
#pragma unroll
                for (int e = 0; e < 16; ++e) { const f32x4 wv = *(const LAS f32x4*)(Wr + e * 1024 + c0 + 4 * h);
                    lg0[e] += (ha[h][0] * wv[0] + ha[h][1] * wv[1]) + (ha[h][2] * wv[2] + ha[h][3] * wv[3]); lg1[e] += (hb[h][0] * wv[0] + hb[h][1] * wv[1]) + (hb[h][2] * wv[2] + hb[h][3] * wv[3]); }
                asm volatile("" ::: "memory"); } }
        const float t0 = reduce16(lg0, lane), t1 = reduce16(lg1, lane);
        float m0 = t0, m1 = t1;
        m0 = fmaxf(m0, xshfl<4>(m0)); m1 = fmaxf(m1, xshfl<4>(m1)); m0 = fmaxf(m0, xshfl<8>(m0)); m1 = fmaxf(m1, xshfl<8>(m1)); m0 = fmaxf(m0, xshfl<16>(m0)); m1 = fmaxf(m1, xshfl<16>(m1)); m0 = pair32_max(m0); m1 = pair32_max(m1);
        const float p0 = expf(t0 - m0), p1 = expf(t1 - m1); float d0 = p0, d1 = p1;
        d0 += xshfl<4>(d0); d1 += xshfl<4>(d1); d0 += xshfl<8>(d0); d1 += xshfl<8>(d1); d0 += xshfl<16>(d0); d1 += xshfl<16>(d1); d0 = pair32_sum(d0); d1 = pair32_sum(d1);
        if ((lane & 3) == 0) { AFF[(size_t)row * 16 + myexp] = p0 / d0; AFF[(size_t)(row + 1) * 16 + myexp] = p1 / d1; }
    }
#undef LN1_LOAD
}

__device__ __forceinline__ void phase_topk(const Ctx& Cc, int l) {
    Ctx C = Cc; OPAQUE(C.tid);
    LAS unsigned long long* a = (LAS unsigned long long*)C.lds;
    const float* AFF = WSP(float, WS_AFF); int* SEL = WSP(int, WS_SEL); int* IDX = WSP(int, WS_IDX);
    const int nitem = l == NL - 1 ? 256 : 512;
    for (int item = C.bid; item < nitem; item += C.G) {
        const bool lat = item < 256; const int it = lat ? item : item - 256, b = it >> 4, e = it & 15;
        const int N = lat ? 2048 : 256, cap = lat ? CAPL : CAPC, base = lat ? b * 2048 : ML + b * 256, slotbase = lat ? b * CAPL : NBATCH * CAPL + b * CAPC;
        for (int t = C.tid; t < N; t += NTHREADS) a[t] = ((unsigned long long)__float_as_uint(AFF[(size_t)(base + t) * 16 + e]) << 32) | (unsigned long long)(0xFFFFFFFFu - (unsigned)t);
        __syncthreads();
        for (int k = 2; k <= N; k <<= 1)
            for (int j = k >> 1; j > 0; j >>= 1) {
                for (int p = C.tid; p < N / 2; p += NTHREADS) {
                    const int i = ((p & ~(j - 1)) << 1) | (p & (j - 1)), ij = i | j;
                    const unsigned long long x = a[i], y = a[ij];
                    const bool desc = (i & k) == 0;
                    if (desc ? (x < y) : (x > y)) { a[i] = y; a[ij] = x; }
                }
                __syncthreads();
            }
        for (int p = C.tid; p < N; p += NTHREADS) { const int tok = (int)(0xFFFFFFFFu - (unsigned)a[p]);
            SEL[(size_t)(base + tok) * 16 + e] = p < cap ? p : -1;
            if (p < cap) IDX[e * ROWS_E + slotbase + p] = base + tok; }
        __syncthreads();
    }
}

__device__ __forceinline__ void phase_gather(const Ctx& C) {
    int lane = C.lane; OPAQUE(lane); const int gw = C.bid * NWAVES + C.wave, NGW = C.G * NWAVES;
    const int* IDX = WSP(int, WS_IDX); const bf16* H2 = WSP(bf16, WS_HB); bf16* XG = WSP(bf16, WS_XG);
    for (int r = gw; r < MG; r += NGW) { const int src = IDX[r]; const v4u* s = (const v4u*)(H2 + (size_t)src * DM); v4u* d = (v4u*)(XG + (size_t)r * DM);
        const v4u a = s[lane], b = s[lane + 64]; d[lane] = a; d[lane + 64] = b; }
}

__device__ __forceinline__ void phase_combine(const Ctx& C, int l) {
    int lane = C.lane; OPAQUE(lane); const int gw = C.bid * NWAVES + C.wave, NGW = C.G * NWAVES;
    const bf16* Y = WSP(bf16, WS_Y); float* X = WSP(float, WS_X); bf16* H = WSP(bf16, WS_HB); const float* AFF = WSP(float, WS_AFF); const int* SEL = WSP(int, WS_SEL);
    const bf16* Yp = WSP(bf16, WS_YP); const float* STAT = WSP(float, WS_STAT); const float* l1g = INP(I_LN1G) + l * 1024; const float* l1b = INP(I_LN1B) + l * 1024;
    const float* XI = INP(I_X); const float* XC = INP(I_CTX) - (size_t)ML * DM;
    const float* MODS = WSP(float, WS_MODS) + (size_t)l * 17 * 6144; const float* MODN = MODS + 17 * 6144;
    const float* lg = INP(I_LN2G) + l * 1024; const float* lb = INP(I_LN2B) + l * 1024;
    const int nrp = (l == NL - 1 ? ML : MT) / 2;
    f32x4 nxa[4], nxb[4]; v4u nya[2], nyb[2]; f32x4 nst = (f32x4){0.f, 0.f, 0.f, 0.f}; int nsel = 0; float naff = 0.f;
#define CMB_LOAD(rp_) do { const int r_ = 2 * (rp_); nsel = SEL[(size_t)r_ * 16 + (lane & 31)]; naff = AFF[(size_t)r_ * 16 + (lane & 31)]; nst = *(const f32x4*)(STAT + (size_t)r_ * 2); \
        const float* xs_ = (l == 0 ? (r_ < ML ? XI : XC) : (const float*)X) + (size_t)r_ * DM; \
        _Pragma("unroll") for (int j = 0; j < 2; ++j) { nya[j] = *(const v4u*)(Yp + (size_t)r_ * DM + 8 * (lane + 64 * j)); nyb[j] = *(const v4u*)(Yp + (size_t)(r_ + 1) * DM + 8 * (lane + 64 * j)); \
            _Pragma("unroll") for (int h = 0; h < 2; ++h) { const int c = 8 * (lane + 64 * j) + 4 * h; nxa[2 * j + h] = *(const f32x4*)(xs_ + c); nxb[2 * j + h] = *(const f32x4*)(xs_ + DM + c); } } } while (0)
    if (gw < nrp) CMB_LOAD(gw);
    for (int rp = gw; rp < nrp; rp += NGW) {
        const int row = 2 * rp; const bool lat = row < ML; const int mr = lat ? (row >> 11) : 16; const float* md = MODS + (size_t)mr * 6144;
        const int rb = lat ? (row >> 11) * CAPL : NBATCH * CAPL + ((row - ML) >> 8) * CAPC;
        const int selv = nsel; const float affv = naff;
        f32x4 xa[4], xb[4];
        {
            const f32x4 st = nst;
#pragma unroll
            for (int j = 0; j < 2; ++j) { const int c = 8 * (lane + 64 * j); const f32x4 g1a = *(const f32x4*)(md + 2048 + c), g1b = *(const f32x4*)(md + 2048 + c + 4);
                const f32x4 gga = *(const f32x4*)(l1g + c), ggb = *(const f32x4*)(l1g + c + 4), bba = *(const f32x4*)(l1b + c), bbb = *(const f32x4*)(l1b + c + 4);
                xa[2 * j] = ((nxa[2 * j] * DN_ALPHA + g1a * pg8::unpack4((v2u){nya[j].x, nya[j].y})) - st[0]) * st[1] * gga + bba; xa[2 * j + 1] = ((nxa[2 * j + 1] * DN_ALPHA + g1b * pg8::unpack4((v2u){nya[j].z, nya[j].w})) - st[0]) * st[1] * ggb + bbb;
                xb[2 * j] = ((nxb[2 * j] * DN_ALPHA + g1a * pg8::unpack4((v2u){nyb[j].x, nyb[j].y})) - st[2]) * st[3] * gga + bba; xb[2 * j + 1] = ((nxb[2 * j + 1] * DN_ALPHA + g1b * pg8::unpack4((v2u){nyb[j].z, nyb[j].w})) - st[2]) * st[3] * ggb + bbb; }
        }
        if (rp + NGW < nrp) CMB_LOAD(rp + NGW);
        unsigned long long bal = __ballot(selv >= 0);
        unsigned ma = (unsigned)(bal & 0xffffu), mb = (unsigned)((bal >> 16) & 0xffffu);
        f32x4 acca[4], accb[4];
#pragma unroll
        for (int j = 0; j < 4; ++j) { acca[j] = (f32x4){0.f, 0.f, 0.f, 0.f}; accb[j] = (f32x4){0.f, 0.f, 0.f, 0.f}; }
        while (ma | mb) {
            const int ea = ma ? __builtin_ctz(ma) : 0, eb = mb ? __builtin_ctz(mb) : 0;
            const int sa = __builtin_amdgcn_readlane(selv, ea), sb = __builtin_amdgcn_readlane(selv, 16 + eb); float fa = __uint_as_float(__builtin_amdgcn_readlane(__float_as_uint(affv), ea)), fb = __uint_as_float(__builtin_amdgcn_readlane(__float_as_uint(affv), 16 + eb));
            if (!ma) fa = 0.f; if (!mb) fb = 0.f;
            const bf16* ya = Y + ((size_t)ea * ROWS_E + rb + (ma ? sa : 0)) * DM; const bf16* yb = Y + ((size_t)eb * ROWS_E + rb + (mb ? sb : 0)) * DM;
            v4u wa[2], wb[2];
#pragma unroll
            for (int j = 0; j < 2; ++j) { wa[j] = *(const v4u*)(ya + 8 * (lane + 64 * j)); wb[j] = *(const v4u*)(yb + 8 * (lane + 64 * j)); }
#pragma unroll
            for (int j = 0; j < 2; ++j) { acca[2 * j] = acca[2 * j] + pg8::unpack4((v2u){wa[j].x, wa[j].y}) * fa; acca[2 * j + 1] = acca[2 * j + 1] + pg8::unpack4((v2u){wa[j].z, wa[j].w}) * fa;
                accb[2 * j] = accb[2 * j] + pg8::unpack4((v2u){wb[j].x, wb[j].y}) * fb; accb[2 * j + 1] = accb[2 * j + 1] + pg8::unpack4((v2u){wb[j].z, wb[j].w}) * fb; }
            ma &= ma - 1; mb &= mb - 1;
        }
        float sma = 0.f, smb = 0.f;
#pragma unroll
        for (int j = 0; j < 2; ++j)
#pragma unroll
            for (int h = 0; h < 2; ++h) { const int q = 2 * j + h; const f32x4 g2 = *(const f32x4*)(md + 5120 + 8 * (lane + 64 * j) + 4 * h); xa[q] = xa[q] * DN_ALPHA + g2 * acca[q]; xb[q] = xb[q] * DN_ALPHA + g2 * accb[q];
                sma += (xa[q][0] + xa[q][1]) + (xa[q][2] + xa[q][3]); smb += (xb[q][0] + xb[q][1]) + (xb[q][2] + xb[q][3]); }
        const float mean0 = wave_sum(sma) * (1.f / 1024.f), mean1 = wave_sum(smb) * (1.f / 1024.f); float qa = 0.f, qb = 0.f;
#pragma unroll
        for (int j = 0; j < 4; ++j) { xa[j] = xa[j] - mean0; xb[j] = xb[j] - mean1;
            qa += (xa[j][0] * xa[j][0] + xa[j][1] * xa[j][1]) + (xa[j][2] * xa[j][2] + xa[j][3] * xa[j][3]); qb += (xb[j][0] * xb[j][0] + xb[j][1] * xb[j][1]) + (xb[j][2] * xb[j][2] + xb[j][3] * xb[j][3]); }
        const float rstd0 = 1.f / sqrtf(wave_sum(qa) * (1.f / 1024.f) + LN_EPS), rstd1 = 1.f / sqrtf(wave_sum(qb) * (1.f / 1024.f) + LN_EPS);
#pragma unroll
        for (int j = 0; j < 2; ++j) { const int c0 = 8 * (lane + 64 * j); f32x4 ya[2], yb[2];
#pragma unroll
            for (int h = 0; h < 2; ++h) { const int c = c0 + 4 * h; const f32x4 gg = *(const f32x4*)(lg + c), bb = *(const f32x4*)(lb + c);
                ya[h] = xa[2 * j + h] * rstd0 * gg + bb; yb[h] = xb[2 * j + h] * rstd1 * gg + bb; }
            if (l < NL - 1) { const float* mn = MODN + (size_t)mr * 6144; f32x4 ha[2], hb[2];
#pragma unroll
                for (int h = 0; h < 2; ++h) { const int c = c0 + 4 * h; *(f32x4*)(X + (size_t)row * DM + c) = ya[h]; *(f32x4*)(X + (size_t)(row + 1) * DM + c) = yb[h];
                    const f32x4 scl = *(const f32x4*)(mn + 1024 + c) + 1.f, shf = *(const f32x4*)(mn + c); ha[h] = ya[h] * scl + shf; hb[h] = yb[h] * scl + shf; }
                *(v4u*)(H + (size_t)row * DM + c0) = pg8::pack8(ha[0], ha[1]); *(v4u*)(H + (size_t)(row + 1) * DM + c0) = pg8::pack8(hb[0], hb[1]); }
            else if (lat) {
#pragma unroll
                for (int h = 0; h < 2; ++h) { const int c = c0 + 4 * h; *(f32x4*)(C.out + (size_t)row * DM + c) = ya[h]; *(f32x4*)(C.out + (size_t)(row + 1) * DM + c) = yb[h]; } } }
    }
#undef CMB_LOAD
}

enum { PH_MODS = 0, PH_MOD0, PH_WIN, PH_PREP, PH_CONV, PH_UQ, PH_UKV, PH_ATTN, PH_MERGE, PH_WOUT, PH_LN1, PH_TOPK, PH_GATHER, PH_GU, PH_DOWN, PH_COMB, PH_COUNT };
template <int PH> __device__ __forceinline__ void run_phase(const Ctx& C, int l) {
    if constexpr (PH == PH_MODS) { phase_mods(C); __syncthreads(); conv_weights(C, 0, 0, 100, 0, C.G); }
    if constexpr (PH == PH_MOD0) { phase_mod0(C); }
    if constexpr (PH == PH_WIN) { pg8::ProbPlain P{WSP(bf16, WS_HB), WSW(bf16, WS_WIN, l), 1024, 1024, 1024}; pg8::EpiWin E{WSP(bf16, WS_R)};
        if (l == NL - 1) { pg8::OrderWinLast S; S.init(C.G, C.bid); pg8::gemm_phase(C.lds, P, S, E, C.wave); }
        else { pg8::Order<1> S; S.init(MT / 256, NP / 256, C.G, C.bid); pg8::gemm_phase(C.lds, P, S, E, C.wave); } }
    if constexpr (PH == PH_PREP) { phase_prep(C, l); }
    if constexpr (PH == PH_CONV) { phase_conv(C, l); }
    if constexpr (PH == PH_UQ) { pg8::ProbUp2 P{WSP(bf16, WS_CQN), WSP(bf16, WS_CKVN), WSW(bf16, WS_WUQ, l), WSW(bf16, WS_WUKV, l), 256, 256, 256};
        pg8::OrderUp2 S; S.init((l == NL - 1 ? ML : MT) / 256, C.G, C.bid); pg8::EpiUp2 E{WSP(bf16, WS_QB), WSP(bf16, WS_KVB)}; pg8::gemm_phase(C.lds, P, S, E, C.wave); }
    if constexpr (PH == PH_ATTN) { phase_attn(C, l); }
    if constexpr (PH == PH_MERGE) { pg8::ProbSeg3 P{WSP(bf16, WS_YA), WSW(bf16, WS_WOA, l), 512, 512, 512, (size_t)(36 * MiB / 2), (size_t)(1 * MiB / 2)};
        pg8::Order<3> S; S.init((l == NL - 1 ? ML : MT) / 256, 4, C.G, C.bid); pg8::EpiMerge E{WSP(bf16, WS_R), WSP(bf16, WS_HB)}; pg8::gemm_phase(C.lds, P, S, E, C.wave); }
    if constexpr (PH == PH_WOUT) { pg8::ProbPlain P{WSP(bf16, WS_HB), WSW(bf16, WS_WOUT, l), 1024, 1024, 1024}; pg8::Order<1> S; S.init((l == NL - 1 ? ML : MT) / 256, 4, C.G, C.bid);
        pg8::EpiBf16 E{WSP(bf16, WS_YP), 1024}; pg8::gemm_phase(C.lds, P, S, E, C.wave); }
    if constexpr (PH == PH_LN1) { phase_ln1(C, l); }
    if constexpr (PH == PH_TOPK) { phase_topk(C, l); }
    if constexpr (PH == PH_GATHER) { phase_gather(C); }
    if constexpr (PH == PH_GU) { pg8::OrderOrd S; S.o.init(l == NL - 1 ? 256 : 288, 8, C.G, C.bid, l == NL - 1 ? 16 : 0);
        LAS int* lidx = (LAS int*)(C.lds + LIDX_OFF); const int* IDXg = WSP(int, WS_IDX);
        { pg8::Unit uu; for (int i = 0; i < 10 && S.next(i, uu); ++i) if (C.tid < 256) lidx[i * 256 + C.tid] = IDXg[uu.pm * 256 + C.tid]; }
        __syncthreads();
        pg8::ProbMoEGather P{WSP(bf16, WS_HB), WSW(bf16, WS_WGU, l), lidx, 1024, 1024, 1024, 2048};
        pg8::EpiSwiGLU E{WSP(bf16, WS_HID)}; pg8::gemm_phase(C.lds, P, S, E, C.wave); }
    if constexpr (PH == PH_DOWN) { pg8::ProbMoE P{WSP(bf16, WS_HID), WSW(bf16, WS_WD, l), 1024, 1024, 1024, 1024}; pg8::Order<1> S; S.init(l == NL - 1 ? 256 : 288, 4, C.G, C.bid, l == NL - 1 ? 16 : 0);
        pg8::EpiBf16 E{WSP(bf16, WS_Y), 1024}; pg8::gemm_phase(C.lds, P, S, E, C.wave); }
    if constexpr (PH == PH_COMB) { phase_combine(C, l); }
}
template <int PH> __device__ __forceinline__ void call_phase(const Ctx& Cin, int l) { Ctx C = Cin; C.lane = lane_id(); OPAQUE(C.lane); asm volatile("" : "+s"(C.wave)); C.tid = C.wave * 64 + C.lane; asm volatile("" : "+s"(l)); asm volatile("" : "+s"(C.G)); asm volatile("" : "+s"(C.bid)); { unsigned long long w_ = (unsigned long long)C.ws; unsigned lo_ = (unsigned)w_, hi_ = (unsigned)(w_ >> 32); asm volatile("" : "+s"(lo_)); asm volatile("" : "+s"(hi_)); C.ws = (unsigned char*)(GAS unsigned char*)(((unsigned long long)hi_ << 32) | lo_); } run_phase<PH>(C, l); }
__global__ void __launch_bounds__(NTHREADS, 2) mega_fwd(Args args) {
    extern __shared__ __attribute__((aligned(16))) unsigned char lds_raw[];
    Ctx C;
    C.lds = (LAS unsigned char*)lds_raw;
    C.tid = threadIdx.x; C.lane = C.tid & 63; C.wave = __builtin_amdgcn_readfirstlane(C.tid >> 6);
    C.G = gridDim.x; C.bid = blockIdx.x;
    C.in = args.in; C.ws = (unsigned char*)(GAS unsigned char*)args.ws; C.out = (float*)(GAS float*)args.out;
    volatile LAS unsigned* MISC = (volatile LAS unsigned*)(C.lds + MISC_OFF);
    for (int u = C.tid; u < (LDS_BYTES - LDSCTL_OFF) / 4; u += NTHREADS) ((LAS unsigned*)(C.lds + LDSCTL_OFF))[u] = 0u;
    __syncthreads();
    XcdBarrier bar = xcd_barrier_post((unsigned*)(C.ws + WS_CTL) + 4096, MISC + 8, C.wave);
    call_phase<PH_MODS>(C, 0); xcd_barrier(bar);
    call_phase<PH_MOD0>(C, 0); xcd_barrier(bar);
    for (int l = 0; l < NL; ++l) {
        call_phase<PH_WIN>(C, l); xcd_barrier(bar);
        call_phase<PH_PREP>(C, l); xcd_barrier(bar);
        call_phase<PH_CONV>(C, l); __syncthreads(); call_phase<PH_UQ>(C, l); xcd_barrier(bar);
        call_phase<PH_ATTN>(C, l); xcd_barrier(bar);
        call_phase<PH_MERGE>(C, l); xcd_barrier(bar);
        call_phase<PH_WOUT>(C, l); xcd_barrier(bar);
        call_phase<PH_LN1>(C, l); xcd_barrier(bar);
        call_phase<PH_TOPK>(C, l); xcd_barrier(bar);
        call_phase<PH_GU>(C, l); xcd_barrier(bar);
        call_phase<PH_DOWN>(C, l); xcd_barrier(bar);
        call_phase<PH_COMB>(C, l); if (l < NL - 1) xcd_barrier(bar);
    }
}

extern "C" void kernel_launch(void* const* d_in, const int* in_sizes, int n_in, void* d_out, int out_size, void* d_ws, size_t ws_size, hipStream_t stream) {
    static int grid = 0;
    if (grid == 0) {
        if (n_in != 28 || out_size != ML * DM || ws_size < WS_END) { fprintf(stderr, "kernel_launch: unexpected shapes: n_in %d out %d ws %zu (need %zu)\n", n_in, out_size, ws_size, (size_t)WS_END); grid = -1; return; }
        int dev = 0, cus = 0, per_cu = 0;
        if (hipGetDevice(&dev) != hipSuccess || hipDeviceGetAttribute(&cus, hipDeviceAttributeMultiprocessorCount, dev) != hipSuccess) { grid = -1; return; }
        if (hipFuncSetAttribute((const void*)mega_fwd, hipFuncAttributeMaxDynamicSharedMemorySize, LDS_BYTES) != hipSuccess) { fprintf(stderr, "kernel_launch: hipFuncSetAttribute failed\n"); grid = -1; return; }
        if (hipOccupancyMaxActiveBlocksPerMultiprocessor(&per_cu, (const void*)mega_fwd, NTHREADS, LDS_BYTES) != hipSuccess || per_cu < 1) { fprintf(stderr, "kernel_launch: occupancy query says %d\n", per_cu); grid = -1; return; }
        (void)hipGetLastError();
        grid = cus;
    }
    if (grid < 0) return;
    (void)hipMemsetAsync((char*)d_ws + WS_CTL, 0, CTL_ZERO_BYTES, stream);
    Args a{};
    for (int i = 0; i < 28; ++i) a.in[i] = (const float*)d_in[i];
    a.out = (float*)d_out; a.ws = (unsigned char*)d_ws;
    hipLaunchKernelGGL(mega_fwd, dim3(grid), dim3(NTHREADS), LDS_BYTES, stream, a);
}
```
